# Optimizing an MI355X kernel written in HIP

```python
import math
import jax, jax.numpy as jnp
from jax import lax
import numpy as np

D_MODEL = 1024
BATCH = 32
SEQ = 2048
DEPTH = 2

GRID_W = 64
CTX_LEN = 256

NA_HEADS = 4
NA_DIM = 64
NA_WIN_H = 8
NA_WIN_W = 16
NA_QBLK_W = 16
NA_KBAND_W = NA_QBLK_W + NA_WIN_W
RET_HEADS = 4
RET_DK = 64
RET_DV = 64
RET_CHUNK = 128
GQA_HEADS = 4
GQA_KV_HEADS = 2
GQA_DIM = 64
DIFF_HEADS = 4
DIFF_QK_DIM = 32
DIFF_V_DIM = 64
Q_BLOCK = 128
N_BRANCH = 4
BRANCH_W = 256
ROPE_THETA = 10000.0
EPS = 1e-6
NEG_INF = -1e30
N_EXPERTS = 16
N_GROUPS = 4
EXPERTS_PER_GROUP = N_EXPERTS // N_GROUPS
TOP_K = 2
D_EXPERT = 512
MOE_BLOCK = 512

NA_COLS = 3 * NA_HEADS * NA_DIM
RET_COLS = RET_HEADS * (2 * RET_DK + 2 * RET_DV)
GQA_COLS = (GQA_HEADS + 2 * GQA_KV_HEADS) * GQA_DIM
DIFF_COLS = DIFF_HEADS * (4 * DIFF_QK_DIM + DIFF_V_DIM)
MIX_COLS = NA_COLS + RET_COLS + GQA_COLS + DIFF_COLS
MIX_SPLITS = (NA_COLS, NA_COLS + RET_COLS, NA_COLS + RET_COLS + GQA_COLS)
IN_COLS = MIX_COLS + N_BRANCH * D_MODEL

kernel_name = 'hybrid_grid_diffusion_block'


def rms_norm(x, g):
    xf = x.astype(jnp.float32)
    y = xf * lax.rsqrt(jnp.mean(xf * xf, axis=-1, keepdims=True) + EPS)
    return (y * g.astype(jnp.float32)).astype(x.dtype)


def modulate(h, shift, scale):
    return h * (1.0 + scale) + shift


def split_heads(t, n):
    b, l, _ = t.shape
    return t.reshape(b, l, n, -1).transpose(0, 2, 1, 3)


def merge_heads(t):
    b, n, l, d = t.shape
    return t.transpose(0, 2, 1, 3).reshape(b, l, n * d)


def grid_positions(length):
    t = jnp.arange(length, dtype=jnp.int32)
    return t // GRID_W, t % GRID_W


def axial_rope(x, rows, cols):
    d = x.shape[-1]
    half = d // 2
    nf = half // 2
    inv = 1.0 / (ROPE_THETA ** (jnp.arange(nf, dtype=jnp.float32) / nf))

    def rot(xp, pos):
        ang = pos.astype(jnp.float32)[:, None] * inv[None, :]
        cos, sin = jnp.cos(ang), jnp.sin(ang)
        x1 = xp[..., :nf].astype(jnp.float32)
        x2 = xp[..., nf:].astype(jnp.float32)
        return jnp.concatenate([x1 * cos - x2 * sin, x2 * cos + x1 * sin], axis=-1)

    return jnp.concatenate([rot(x[..., :half], rows), rot(x[..., half:], cols)], axis=-1).astype(x.dtype)


def blocked_attention(q, k, v, scale):
    b, hk, g, lq, d = q.shape
    nb = lq // Q_BLOCK
    qb = q.reshape(b, hk, g, nb, Q_BLOCK, d).transpose(3, 0, 1, 2, 4, 5)

    def one_block(qi):
        s = jnp.einsum('bhgqd,bhkd->bhgqk', qi, k).astype(jnp.float32) * scale
        p = jax.nn.softmax(s, axis=-1).astype(v.dtype)
        return jnp.einsum('bhgqk,bhkd->bhgqd', p, v)

    o = lax.map(one_block, qb)
    return o.transpose(1, 2, 3, 0, 4, 5).reshape(b, hk, g, lq, v.shape[-1])


def blocked_diff_attention(q, k, v, lam, scale):
    b, h, _, lq, dq = q.shape
    nb = lq // Q_BLOCK
    qb = q.reshape(b, h, 2, nb, Q_BLOCK, dq).transpose(3, 0, 1, 2, 4, 5)

    def one_block(qi):
        s = jnp.einsum('bhmqd,bhmkd->bhmqk', qi, k).astype(jnp.float32) * scale
        p = jax.nn.softmax(s, axis=-1)
        a = (p[:, :, 0] - lam * p[:, :, 1]).astype(v.dtype)
        return jnp.einsum('bhqk,bhkd->bhqd', a, v)

    o = lax.map(one_block, qb)
    return o.transpose(1, 2, 0, 3, 4).reshape(b, h, lq, v.shape[-1])


def neighbourhood_attention(p_lat, p_ctx, rpb, need_ctx):
    b, l, _ = p_lat.shape
    rows = l // GRID_W
    win_h = min(NA_WIN_H, rows)
    n_cb = GRID_W // NA_QBLK_W
    n_win = win_h * NA_KBAND_W
    scale = NA_DIM ** -0.5
    q, k, v = (split_heads(t, NA_HEADS) for t in jnp.split(p_lat, 3, axis=-1))
    qc, kc, vc = (split_heads(t, NA_HEADS) for t in jnp.split(p_ctx, 3, axis=-1))
    qg = (q * scale).reshape(b, NA_HEADS, rows, GRID_W, NA_DIM)
    kg = k.reshape(b, NA_HEADS, rows, GRID_W, NA_DIM)
    vg = v.reshape(b, NA_HEADS, rows, GRID_W, NA_DIM)
    band_start = np.clip(np.arange(n_cb) * NA_QBLK_W - NA_WIN_W // 2, 0, GRID_W - NA_KBAND_W)
    band_cols = band_start[:, None] + np.arange(NA_KBAND_W)[None, :]
    q_cols = np.arange(GRID_W).reshape(n_cb, NA_QBLK_W)
    win_start = np.clip(q_cols - NA_WIN_W // 2, 0, GRID_W - NA_WIN_W)
    col_ok = ((band_cols[:, None, :] >= win_start[:, :, None])
              & (band_cols[:, None, :] < win_start[:, :, None] + NA_WIN_W))
    col_idx = np.clip(band_cols[:, None, :] - q_cols[:, :, None], -(NA_WIN_W - 1), NA_WIN_W - 1) + NA_WIN_W - 1
    key_ok = np.broadcast_to(col_ok[:, :, None, :], (n_cb, NA_QBLK_W, win_h, NA_KBAND_W)).reshape(n_cb, NA_QBLK_W, n_win)

    def attend_row(r):
        r0 = jnp.clip(r - win_h // 2, 0, rows - win_h)
        k_band = lax.dynamic_slice_in_dim(kg, r0, win_h, axis=2)[:, :, :, band_cols]
        v_band = lax.dynamic_slice_in_dim(vg, r0, win_h, axis=2)[:, :, :, band_cols]
        k_blk = k_band.transpose(0, 1, 3, 2, 4, 5).reshape(b, NA_HEADS, n_cb, n_win, NA_DIM)
        v_blk = v_band.transpose(0, 1, 3, 2, 4, 5).reshape(b, NA_HEADS, n_cb, n_win, NA_DIM)
        q_row = lax.dynamic_index_in_dim(qg, r, axis=2, keepdims=False).reshape(b, NA_HEADS, n_cb, NA_QBLK_W, NA_DIM)
        row_idx = r0 + jnp.arange(win_h) - r + NA_WIN_H - 1
        bias = rpb[:, row_idx][:, :, col_idx]
        bias = bias.transpose(0, 2, 3, 1, 4).reshape(NA_HEADS, n_cb, NA_QBLK_W, n_win)
        s_win = jnp.einsum('bhcqd,bhckd->bhcqk', q_row, k_blk).astype(jnp.float32) + bias.astype(jnp.float32)
        s_win = jnp.where(key_ok, s_win, NEG_INF)
        s_ctx = jnp.einsum('bhcqd,bhkd->bhcqk', q_row, kc).astype(jnp.float32)
        p = jax.nn.softmax(jnp.concatenate([s_win, s_ctx], axis=-1), axis=-1).astype(v.dtype)
        o = (jnp.einsum('bhcqk,bhckd->bhcqd', p[..., :n_win], v_blk)
             + jnp.einsum('bhcqk,bhkd->bhcqd', p[..., n_win:], vc))
        return o.reshape(b, NA_HEADS, GRID_W, NA_DIM)

    o = lax.map(attend_row, jnp.arange(rows, dtype=jnp.int32))
    y_lat = o.transpose(1, 0, 3, 2, 4).reshape(b, l, NA_HEADS * NA_DIM)
    y_ctx = None
    if need_ctx:
        y_ctx = merge_heads(blocked_attention(qc[:, :, None], kc, vc, scale)[:, :, 0])
    return y_lat, y_ctx


def retention_scan(q, k, v, log_gamma, state0):
    b, h, l, _ = q.shape
    dv = v.shape[-1]
    n = l // RET_CHUNK

    def to_chunks(t):
        return t.reshape(b, h, n, RET_CHUNK, t.shape[-1]).transpose(2, 0, 1, 3, 4)

    pos = jnp.arange(RET_CHUNK, dtype=jnp.float32)
    lag = pos[:, None] - pos[None, :]
    lower = lag >= 0
    intra = jnp.where(lower, jnp.exp(jnp.where(lower, lag, 0.0)[None] * log_gamma[:, None, None]), 0.0)
    q_dec = jnp.exp((pos + 1.0)[None, :] * log_gamma[:, None])
    k_dec = jnp.exp((RET_CHUNK - 1.0 - pos)[None, :] * log_gamma[:, None])
    chunk_dec = jnp.exp(RET_CHUNK * log_gamma)

    def step(state, inp):
        qi, ki, vi = inp
        inner = jnp.einsum('bhqd,bhkd->bhqk', qi, ki) * intra
        o = (jnp.einsum('bhqk,bhke->bhqe', inner, vi)
             + jnp.einsum('bhqd,bhde->bhqe', qi * q_dec[..., None], state))
        state = state * chunk_dec[:, None, None] + jnp.einsum('bhkd,bhke->bhde', ki * k_dec[..., None], vi)
        return state, o

    state, o = lax.scan(step, state0, (to_chunks(q), to_chunks(k), to_chunks(v)))
    return o.transpose(1, 2, 0, 3, 4).reshape(b, h, l, dv), state


def retention_mixer(p_lat, p_ctx, log_decay_param, rows_pos, cols_pos, need_ctx):
    splits = [RET_HEADS * RET_DK, 2 * RET_HEADS * RET_DK, 2 * RET_HEADS * RET_DK + RET_HEADS * RET_DV]

    def prep(p, rope):
        q, k, v, g = jnp.split(p, splits, axis=-1)
        q, k, v = (split_heads(t, RET_HEADS).astype(jnp.float32) for t in (q, k, v))
        if rope:
            q = axial_rope(q, rows_pos, cols_pos)
            k = axial_rope(k, rows_pos, cols_pos)
        return q, k * RET_DK ** -0.5, v, g

    ql, kl, vl, gl = prep(p_lat, True)
    qc, kc, vc, gc = prep(p_ctx, False)
    log_gamma = jnp.log1p(-jnp.exp(log_decay_param.astype(jnp.float32)))
    zero = jnp.zeros((p_lat.shape[0], RET_HEADS, RET_DK, RET_DV), jnp.float32)

    def flip(t):
        return jnp.flip(t, axis=2)

    oc_f, s_f = retention_scan(qc, kc, vc, log_gamma[0], zero)
    oc_b, s_b = retention_scan(flip(qc), flip(kc), flip(vc), log_gamma[1], zero)
    ol_f, _ = retention_scan(ql, kl, vl, log_gamma[0], s_f)
    ol_b, _ = retention_scan(flip(ql), flip(kl), flip(vl), log_gamma[1], s_b)

    def finish(o, g):
        mu = jnp.mean(o, axis=-1, keepdims=True)
        var = jnp.mean(jnp.square(o - mu), axis=-1, keepdims=True)
        o = (o - mu) * lax.rsqrt(var + EPS)
        return jax.nn.silu(g) * merge_heads(o).astype(g.dtype)

    y_lat = finish(ol_f + flip(ol_b), gl)
    y_ctx = finish(oc_f + flip(oc_b), gc) if need_ctx else None
    return y_lat, y_ctx


def gqa_mixer(p_lat, p_ctx, q_gain, k_gain, rows_pos, cols_pos, need_ctx):
    nq = GQA_HEADS * GQA_DIM
    nkv = GQA_KV_HEADS * GQA_DIM
    group = GQA_HEADS // GQA_KV_HEADS
    scale = GQA_DIM ** -0.5

    def prep(p):
        q, k, v = jnp.split(p, [nq, nq + nkv], axis=-1)
        return (rms_norm(split_heads(q, GQA_HEADS), q_gain),
                rms_norm(split_heads(k, GQA_KV_HEADS), k_gain),
                split_heads(v, GQA_KV_HEADS))

    def grouped(q):
        b, _, l, d = q.shape
        return q.reshape(b, GQA_KV_HEADS, group, l, d)

    def ungroup(o):
        b, hk, g, l, d = o.shape
        return merge_heads(o.reshape(b, hk * g, l, d))

    ql, kl, vl = prep(p_lat)
    qc, kc, vc = prep(p_ctx)
    ql = axial_rope(ql, rows_pos, cols_pos)
    kl = axial_rope(kl, rows_pos, cols_pos)
    k_all = jnp.concatenate([kl, kc], axis=2)
    v_all = jnp.concatenate([vl, vc], axis=2)
    y_lat = ungroup(blocked_attention(grouped(ql), k_all, v_all, scale))
    y_ctx = ungroup(blocked_attention(grouped(qc), kc, vc, scale)) if need_ctx else None
    return y_lat, y_ctx


def diff_mixer(p_lat, p_ctx, lam_params, subln_gain, layer_idx, rows_pos, cols_pos, need_ctx):
    nqk = DIFF_HEADS * 2 * DIFF_QK_DIM
    scale = DIFF_QK_DIM ** -0.5

    def prep(p):
        b, l, _ = p.shape
        q, k, v = jnp.split(p, [nqk, 2 * nqk], axis=-1)
        q = q.reshape(b, l, DIFF_HEADS, 2, DIFF_QK_DIM).transpose(0, 2, 3, 1, 4)
        k = k.reshape(b, l, DIFF_HEADS, 2, DIFF_QK_DIM).transpose(0, 2, 3, 1, 4)
        return q, k, split_heads(v, DIFF_HEADS)

    ql, kl, vl = prep(p_lat)
    qc, kc, vc = prep(p_ctx)
    ql = axial_rope(ql, rows_pos, cols_pos)
    kl = axial_rope(kl, rows_pos, cols_pos)
    lam_init = 0.8 - 0.6 * math.exp(-0.3 * layer_idx)
    lp = lam_params.astype(jnp.float32)
    lam = jnp.exp(jnp.sum(lp[0] * lp[1])) - jnp.exp(jnp.sum(lp[2] * lp[3])) + lam_init

    def finish(o):
        return merge_heads(rms_norm(o, subln_gain) * (1.0 - lam_init))

    k_all = jnp.concatenate([kl, kc], axis=3)
    v_all = jnp.concatenate([vl, vc], axis=2)
    y_lat = finish(blocked_diff_attention(ql, k_all, v_all, lam, scale))
    y_ctx = finish(blocked_diff_attention(qc, kc, vc, lam, scale)) if need_ctx else None
    return y_lat, y_ctx


def token_mixers(h_lat, h_ctx, w_in, na_rpb, ret_log_decay, gqa_q_gain, gqa_k_gain,
                 diff_lambda, diff_subln, w_branch, w_out, layer_idx, need_ctx):
    d = h_lat.shape[-1]
    rows_pos, cols_pos = grid_positions(h_lat.shape[1])
    w_mix = w_in[:, :MIX_COLS]
    a_l, b_l, c_l, d_l = jnp.split(h_lat @ w_mix, MIX_SPLITS, axis=-1)
    a_c, b_c, c_c, d_c = jnp.split(h_ctx @ w_mix, MIX_SPLITS, axis=-1)
    ya = neighbourhood_attention(a_l, a_c, na_rpb, need_ctx)
    yb = retention_mixer(b_l, b_c, ret_log_decay, rows_pos, cols_pos, need_ctx)
    yc = gqa_mixer(c_l, c_c, gqa_q_gain, gqa_k_gain, rows_pos, cols_pos, need_ctx)
    yd = diff_mixer(d_l, d_c, diff_lambda, diff_subln, layer_idx, rows_pos, cols_pos, need_ctx)

    def merge(h, ys):
        acc = None
        for n, y in enumerate(ys):
            gate = jax.nn.sigmoid(h @ w_in[:, MIX_COLS + n * d: MIX_COLS + (n + 1) * d])
            term = gate * (y @ w_branch[n])
            acc = term if acc is None else acc + term
        return acc @ w_out

    y_lat = merge(h_lat, (ya[0], yb[0], yc[0], yd[0]))
    y_ctx = merge(h_ctx, (ya[1], yb[1], yc[1], yd[1])) if need_ctx else None
    return y_lat, y_ctx


def expert_dispatch(h, e_idx, e_w, w_gate, w_up, w_down):
    n, d = h.shape
    a = n * TOP_K
    flat_e = e_idx.reshape(a)
    flat_tok = jnp.repeat(jnp.arange(n, dtype=jnp.int32), TOP_K)
    flat_w = e_w.reshape(a)
    order = jnp.argsort(flat_e)
    se = flat_e[order]
    counts = jnp.bincount(flat_e, length=N_EXPERTS)
    padded = (counts + MOE_BLOCK - 1) // MOE_BLOCK * MOE_BLOCK
    pad_end = jnp.cumsum(padded)
    pad_start = pad_end - padded
    grp_start = jnp.cumsum(counts) - counts
    dest = pad_start[se] + jnp.arange(a, dtype=jnp.int32) - grp_start[se]
    n_blocks = -(-a // MOE_BLOCK) + N_EXPERTS
    total = n_blocks * MOE_BLOCK
    slot_tok = jnp.full((total,), n, jnp.int32).at[dest].set(flat_tok[order])
    slot_w = jnp.zeros((total,), flat_w.dtype).at[dest].set(flat_w[order])
    blk_e = jnp.minimum(jnp.searchsorted(pad_end, jnp.arange(n_blocks, dtype=jnp.int32) * MOE_BLOCK, side='right'),
                        N_EXPERTS - 1)
    h_pad = jnp.concatenate([h, jnp.zeros((1, d), h.dtype)], axis=0)
    xb = h_pad[slot_tok].reshape(n_blocks, MOE_BLOCK, d)

    def run(args):
        xi, e = args
        return (jax.nn.silu(xi @ w_gate[e]) * (xi @ w_up[e])) @ w_down[e]

    yb = lax.map(run, (xb, blk_e)).reshape(total, d)
    out = jnp.zeros((n + 1, d), h.dtype).at[slot_tok].add(yb * slot_w[:, None].astype(yb.dtype))
    return out[:n]


def routed_moe(h, w_router, router_bias, w_gate, w_up, w_down):
    n = h.shape[0]
    s = jax.nn.sigmoid((h @ w_router).astype(jnp.float32))
    sel = (s + router_bias.astype(jnp.float32)).reshape(n, N_GROUPS, EXPERTS_PER_GROUP)
    group_score = jnp.sum(lax.top_k(sel, TOP_K)[0], axis=-1)
    g_idx = jnp.argmax(group_score, axis=-1).astype(jnp.int32)
    in_group = jnp.take_along_axis(sel, g_idx[:, None, None], axis=1)[:, 0]
    _, local = lax.top_k(in_group, TOP_K)
    e_idx = g_idx[:, None] * EXPERTS_PER_GROUP + local.astype(jnp.int32)
    w = jnp.take_along_axis(s, e_idx, axis=1)
    w = w / jnp.sum(w, axis=-1, keepdims=True)
    return expert_dispatch(h, e_idx, w, w_gate, w_up, w_down)


def setup_inputs(seed: int = 0) -> dict:
    key = jax.random.key(seed)
    ks = jax.random.split(key, 23)
    d = D_MODEL

    def normal(k, shape, std):
        return jax.random.normal(k, shape, jnp.float32) * std

    ret_base = -(5.0 + jnp.arange(RET_HEADS, dtype=jnp.float32)) * math.log(2.0)
    return {
        'x': normal(ks[0], (BATCH, SEQ, d), 1.0),
        'c': normal(ks[1], (BATCH, d), 1.0),
        'ctx': normal(ks[2], (BATCH, CTX_LEN, d), 1.0),
        'c_ctx': normal(ks[3], (d,), 1.0),
        'w_mod': normal(ks[4], (DEPTH, d, 6 * d), 0.5 * d ** -0.5),
        'b_mod': normal(ks[5], (DEPTH, 6 * d), 0.02),
        'g_norm1': 1.0 + normal(ks[6], (DEPTH, d), 0.02),
        'g_norm2': 1.0 + normal(ks[7], (DEPTH, d), 0.02),
        'w_in': normal(ks[8], (DEPTH, d, IN_COLS), d ** -0.5),
        'na_rpb': normal(ks[9], (DEPTH, NA_HEADS, 2 * NA_WIN_H - 1, 2 * NA_WIN_W - 1), 0.02),
        'ret_log_decay': ret_base + normal(ks[10], (DEPTH, 2, RET_HEADS), 0.05),
        'gqa_q_gain': 1.0 + normal(ks[11], (DEPTH, GQA_DIM), 0.02),
        'gqa_k_gain': 1.0 + normal(ks[12], (DEPTH, GQA_DIM), 0.02),
        'diff_lambda': normal(ks[13], (DEPTH, 4, DIFF_QK_DIM), 0.1),
        'diff_subln': 1.0 + normal(ks[14], (DEPTH, DIFF_V_DIM), 0.02),
        'w_branch': normal(ks[15], (DEPTH, N_BRANCH, BRANCH_W, d), BRANCH_W ** -0.5),
        'w_out': normal(ks[16], (DEPTH, d, d), d ** -0.5),
        'w_router': normal(ks[17], (d, N_EXPERTS), d ** -0.5),
        'router_bias': normal(ks[18], (N_EXPERTS,), 0.01),
        'w_gate_e': normal(ks[19], (DEPTH, N_EXPERTS, d, D_EXPERT), d ** -0.5),
        'w_up_e': normal(ks[20], (DEPTH, N_EXPERTS, d, D_EXPERT), d ** -0.5),
        'w_down_e': normal(ks[21], (DEPTH, N_EXPERTS, D_EXPERT, d), D_EXPERT ** -0.5),
        'g_final': 1.0 + normal(ks[22], (d,), 0.02),
    }


def reference(x, c, ctx, c_ctx, w_mod, b_mod, g_norm1, g_norm2, w_in, na_rpb, ret_log_decay,
              gqa_q_gain, gqa_k_gain, diff_lambda, diff_subln, w_branch, w_out, w_router,
              router_bias, w_gate_e, w_up_e, w_down_e, g_final):
    b, l, d = x.shape
    n_ctx = ctx.shape[1]
    hc = ctx
    for layer in range(DEPTH):
        need_ctx = layer < DEPTH - 1
        mod_lat = (jax.nn.silu(c) @ w_mod[layer] + b_mod[layer])[:, None, :]
        mod_ctx = (jax.nn.silu(c_ctx) @ w_mod[layer] + b_mod[layer])[None, None, :]
        sh1, sc1, gt1, sh2, sc2, gt2 = jnp.split(mod_lat, 6, axis=-1)
        sh1c, sc1c, gt1c, sh2c, sc2c, gt2c = jnp.split(mod_ctx, 6, axis=-1)
        h_lat = modulate(rms_norm(x, g_norm1[layer]), sh1, sc1)
        h_ctx = modulate(rms_norm(hc, g_norm1[layer]), sh1c, sc1c)
        y_lat, y_ctx = token_mixers(h_lat, h_ctx, w_in[layer], na_rpb[layer], ret_log_decay[layer],
                                    gqa_q_gain[layer], gqa_k_gain[layer], diff_lambda[layer],
                                    diff_subln[layer], w_branch[layer], w_out[layer], layer, need_ctx)
        x = x + gt1 * y_lat
        m_lat = modulate(rms_norm(x, g_norm2[layer]), sh2, sc2).reshape(b * l, d)
        if need_ctx:
            hc = hc + gt1c * y_ctx
            m_ctx = modulate(rms_norm(hc, g_norm2[layer]), sh2c, sc2c).reshape(b * n_ctx, d)
            f = routed_moe(jnp.concatenate([m_lat, m_ctx], axis=0), w_router, router_bias,
                           w_gate_e[layer], w_up_e[layer], w_down_e[layer])
            x = x + gt2 * f[:b * l].reshape(b, l, d)
            hc = hc + gt2c * f[b * l:].reshape(b, n_ctx, d)
        else:
            f = routed_moe(m_lat, w_router, router_bias, w_gate_e[layer], w_up_e[layer], w_down_e[layer])
            x = x + gt2 * f.reshape(b, l, d)
    return rms_norm(x, g_final)
```

```cpp
#include <hip/hip_runtime.h>
#include <stdint.h>
#include <stdio.h>
#include <math.h>
#include <stddef.h>

#ifndef MK_ONE_LAUNCH
#define MK_ONE_LAUNCH 0
#endif

#define LAS __attribute__((address_space(3)))
typedef unsigned short bf16_t;
typedef short bf16x8 __attribute__((ext_vector_type(8)));
typedef short s16x4 __attribute__((ext_vector_type(4)));
typedef float f32x4 __attribute__((ext_vector_type(4)));
typedef float f32x16 __attribute__((ext_vector_type(16)));
typedef unsigned u32x4 __attribute__((ext_vector_type(4)));
typedef unsigned u32x2 __attribute__((ext_vector_type(2)));

constexpr int D = 1024, NBATCH = 32, SEQ = 2048, CTXL = 256, GRIDW = 64;
constexpr int TLAT = NBATCH * SEQ;
constexpr int TCTX = NBATCH * CTXL;
constexpr int T = TLAT + TCTX;
constexpr int PW = 3072;
constexpr int INW = 7168;
constexpr int NE = 16, DE = 512;
constexpr int SLOTS_MAX = 2 * T + NE * 256;
constexpr int NCHUNK = 18;
constexpr float EPS = 1e-6f;
constexpr float LOG2E = 1.4426950408889634f;
constexpr int C_NAQ = 0, C_NAK = 256, C_NAV = 512, C_RQ = 768, C_RK = 1024, C_RV = 1280, C_RG = 1536, C_GQ = 1792, C_GK = 2048, C_GV = 2176, C_DQ = 2304, C_DK = 2560, C_DV = 2816;

constexpr size_t MiB = 1u << 20;
constexpr size_t WS_CTL = 0, CTL_BYTES = 1 * MiB;
constexpr size_t WS_MOD = 1 * MiB;
constexpr size_t WS_TAB = 3 * MiB;
constexpr size_t WS_TOKLIST = 4 * MiB;
constexpr size_t WS_TOKSLOT = 9 * MiB;
constexpr size_t WS_TOKW = 10 * MiB;
constexpr size_t WS_RETKV = 12 * MiB;
constexpr size_t WS_WIN = 88 * MiB;
constexpr size_t WS_WBR = 116 * MiB;
constexpr size_t WS_WOUT = 120 * MiB;
constexpr size_t WS_WGU = 124 * MiB;
constexpr size_t WS_WD = 188 * MiB;
constexpr size_t WS_X1CTX = 220 * MiB;
constexpr size_t WS_XH = 252 * MiB;
constexpr size_t WS_Y = 396 * MiB;
constexpr size_t WS_P = 540 * MiB;
constexpr size_t WS_U = WS_P;
constexpr size_t WS_DN = WS_P + 148 * MiB;
constexpr size_t WS_END = 988 * MiB;
static_assert((size_t)SLOTS_MAX * DE * 2 <= 148 * MiB && (size_t)SLOTS_MAX * D * 2 <= 296 * MiB, "moe buffers");
constexpr int CW_ECNT = 64;
constexpr int CW_BAR = 4096;
constexpr int TB_R64C = 0, TB_R64S = 1024, TB_R32C = 2048, TB_R32S = 2560, TB_SC = 3072;

constexpr int LDS_BYTES = 147456;
constexpr int LDS_MISC = 145408;
constexpr int HTB = 16384;

__device__ __forceinline__ unsigned cvt_pk_bf16(float lo, float hi) { unsigned r; asm volatile("v_cvt_pk_bf16_f32 %0, %1, %2" : "=v"(r) : "v"(lo), "v"(hi)); return r; }
__device__ __forceinline__ float bf_lo(unsigned u) { return __uint_as_float(u << 16); }
__device__ __forceinline__ float bf_hi(unsigned u) { return __uint_as_float(u & 0xffff0000u); }
__device__ __forceinline__ float bf2f(bf16_t b) { return __uint_as_float(((unsigned)b) << 16); }
__device__ __forceinline__ float wave_sum(float v) {
#pragma unroll
    for (int o = 1; o < 64; o <<= 1) v += __shfl_xor(v, o);
    return v;
}
__device__ __forceinline__ float sigmoidf_(float x) { return 1.0f / (1.0f + __expf(-x)); }
__device__ __forceinline__ float siluf_(float x) { return x / (1.0f + __expf(-x)); }
#define VG(x) asm volatile("" : "+v"(x))
#define WAIT_V(n) asm volatile("s_waitcnt vmcnt(" #n ")" ::: "memory")
#define WAIT_L(n) asm volatile("s_waitcnt lgkmcnt(" #n ")" ::: "memory")
#define BAR() __builtin_amdgcn_s_barrier()
#define SYNC() do { asm volatile("s_waitcnt vmcnt(0) lgkmcnt(0)" ::: "memory"); __builtin_amdgcn_s_barrier(); asm volatile("" ::: "memory"); } while (0)

#define XB_TMO      128
#define XB_XCNT(j)  (256  + 64 * (j))
#define XB_XSUB(j)  (1280 + 64 * (j))
#define XB_XGEN(j)  (2304 + 64 * (j))
#define XB_TOP      3328
#define XB_TOPGEN   3392
#define XCD_BAR_WORDS 3456
#define XB_SPIN_CAP (1u << 18)
__device__ __forceinline__ unsigned xb_ld(unsigned* p)              { return __hip_atomic_load(p, __ATOMIC_RELAXED, __HIP_MEMORY_SCOPE_AGENT); }
__device__ __forceinline__ unsigned xb_add(unsigned* p, unsigned v) { return __hip_atomic_fetch_add(p, v, __ATOMIC_RELAXED, __HIP_MEMORY_SCOPE_AGENT); }
__device__ __forceinline__ unsigned xb_xcc_id() { return (unsigned)__builtin_amdgcn_s_getreg((3 << 11) | 20) & 0xFu; }
#define XB_SPIN(cond, bar) do { unsigned _sp = 0; while (cond) { __builtin_amdgcn_s_sleep(1); \
    if ((++_sp & 255u) == 0u) { if (xb_ld(&(bar)[XB_TMO])) break; if (_sp > XB_SPIN_CAP) { atomicAdd(&(bar)[XB_TMO], 1u); break; } } } } while (0)
struct XcdBarrier { unsigned* bar; unsigned x; volatile LAS unsigned* st; };
__device__ __forceinline__ XcdBarrier xcd_barrier_post(unsigned* bar, volatile LAS unsigned* st) {
    XcdBarrier b; b.bar = bar; b.x = xb_xcc_id(); b.st = st;
    if (threadIdx.x == 0) (void)xb_add(&bar[XB_XCNT(b.x)], 1u);
    return b;
}
__device__ __forceinline__ void xcd_barrier_complete(unsigned* bar, unsigned x, unsigned& nloc, unsigned& nx) {
    const unsigned G = gridDim.x * gridDim.y * gridDim.z;
    unsigned sum, cnt, mine, sp = 0u;
    for (;;) {
        sum = 0u; cnt = 0u; mine = 0u;
#pragma unroll
        for (unsigned j = 0; j < 16; ++j) { const unsigned c = xb_ld(&bar[XB_XCNT(j)]); sum += c; cnt += (c > 0u) ? 1u : 0u; mine = (j == x) ? c : mine; }
        if (sum == G) break;
        __builtin_amdgcn_s_sleep(1);
        if ((++sp & 255u) == 0u) { if (xb_ld(&bar[XB_TMO])) break; if (sp > XB_SPIN_CAP) { atomicAdd(&bar[XB_TMO], 1u); break; } }
    }
    nloc = mine > 0u ? mine : 1u; nx = cnt > 0u ? cnt : 1u;
}
__device__ __forceinline__ void xcd_barrier(const XcdBarrier& b) {
    asm volatile("s_waitcnt vmcnt(0)" ::: "memory");
    __syncthreads();
    if (threadIdx.x == 0) {
        unsigned* bar = b.bar;
        __builtin_amdgcn_s_waitcnt(0);
        unsigned nloc = b.st[0], nx = b.st[1];
        if (nloc == 0u) { xcd_barrier_complete(bar, b.x, nloc, nx); b.st[0] = nloc; b.st[1] = nx; }
        const unsigned old = xb_add(&bar[XB_XSUB(b.x)], 1u);
        const unsigned gen = old / nloc;
        if (old + 1u == (gen + 1u) * nloc) {
            __builtin_amdgcn_fence(__ATOMIC_RELEASE, "agent");
            asm volatile("s_waitcnt vmcnt(0)" ::: "memory");
            const unsigned og = xb_add(&bar[XB_TOP], 1u);
            const unsigned tg = og / nx;
            if (og + 1u == (tg + 1u) * nx) xb_add(&bar[XB_TOPGEN], 1u);
            else XB_SPIN(xb_ld(&bar[XB_TOPGEN]) == tg, bar);
            __builtin_amdgcn_fence(__ATOMIC_ACQUIRE, "agent");
            xb_add(&bar[XB_XGEN(b.x)], 1u);
            asm volatile("s_waitcnt vmcnt(0)" ::: "memory");
        } else {
            XB_SPIN(xb_ld(&bar[XB_XGEN(b.x)]) == gen, bar);
            __builtin_amdgcn_fence(__ATOMIC_ACQUIRE, "agent");
            asm volatile("s_waitcnt vmcnt(0)" ::: "memory");
        }
    }
    __syncthreads();
}

struct Args { const float* in[23]; float* out; unsigned char* ws; int ph_lo, ph_hi; };
struct Frame {
    LAS unsigned char* lds;
    int tid, lane, wave, G;
    const float* const* in; float* out; unsigned char* ws;
};
enum { I_X = 0, I_C, I_CTX, I_CCTX, I_WMOD, I_BMOD, I_G1, I_G2, I_WIN, I_RPB, I_RLD, I_QG, I_KG, I_DLAM, I_DSUB, I_WBR, I_WOUT, I_WR, I_RB, I_WG, I_WU, I_WD, I_GF };

__device__ __forceinline__ int lds_byte(int r, int c) { const int st = (r >> 4) * 2 + (c >> 5), rr = r & 15, cc = c & 31, ob = rr * 64 + cc * 2; return st * 1024 + (ob ^ (((ob >> 9) & 1) << 5)); }
__device__ __forceinline__ void stage_rc(int b, int& R, int& C) { const int st = b / 1024, sb = b % 1024, swz = sb ^ (((sb >> 9) & 1) << 5); R = (st >> 1) * 16 + swz / 64; C = (st & 1) * 32 + (swz % 64) / 2; }

template <int NBH>
__device__ __forceinline__ void gemm_kloop(LAS unsigned char* lds, const char* aBase, const unsigned (&aoff)[2][2], const char* bBase, const unsigned (&boff)[2][2], int nk,
                                           f32x4 (&acc)[2][NBH][4][2], int wid, int aoffl, int boffl) {
    const unsigned ldsw = (unsigned)wid * 1024u;
#define GE_STAGE(buf, kt) do { const unsigned _ko = (unsigned)(kt) * 128u; \
        _Pragma("unroll") for (int _h = 0; _h < 2; ++_h) _Pragma("unroll") for (int _i = 0; _i < 2; ++_i) \
            __builtin_amdgcn_global_load_lds((const unsigned*)(aBase + aoff[_h][_i] + _ko), (LAS unsigned*)(lds + (buf) * 65536 + _h * HTB + ldsw + _i * 8192), 16, 0, 0); \
        _Pragma("unroll") for (int _h = 0; _h < NBH; ++_h) _Pragma("unroll") for (int _i = 0; _i < 2; ++_i) \
            __builtin_amdgcn_global_load_lds((const unsigned*)(bBase + boff[_h][_i] + _ko), (LAS unsigned*)(lds + (buf) * 65536 + 32768 + _h * HTB + ldsw + _i * 8192), 16, 0, 0); } while (0)
    GE_STAGE(0, 0);
#pragma unroll 1
    for (int kt = 0; kt < nk; ++kt) {
        const int buf = kt & 1;
        WAIT_V(0); BAR();
        if (kt + 1 < nk) GE_STAGE(buf ^ 1, kt + 1);
        const LAS unsigned char* la = lds + buf * 65536 + aoffl;
        const LAS unsigned char* lb = lds + buf * 65536 + 32768 + boffl;
        bf16x8 Bf[NBH][2][2];
#pragma unroll
        for (int bj = 0; bj < NBH; ++bj)
#pragma unroll
            for (int n = 0; n < 2; ++n)
#pragma unroll
                for (int k = 0; k < 2; ++k) Bf[bj][n][k] = *(const LAS bf16x8*)(lb + bj * HTB + n * 2048 + k * 1024);
#pragma unroll
        for (int ai = 0; ai < 2; ++ai)
#pragma unroll
            for (int mh = 0; mh < 2; ++mh) {
                bf16x8 Af[2][2];
#pragma unroll
                for (int mm = 0; mm < 2; ++mm)
#pragma unroll
                    for (int k = 0; k < 2; ++k) Af[mm][k] = *(const LAS bf16x8*)(la + ai * HTB + (2 * mh + mm) * 2048 + k * 1024);
#pragma unroll
                for (int bj = 0; bj < NBH; ++bj)
#pragma unroll
                    for (int mm = 0; mm < 2; ++mm)
#pragma unroll
                        for (int n = 0; n < 2; ++n)
#pragma unroll
                            for (int k = 0; k < 2; ++k)
                                acc[ai][bj][2 * mh + mm][n] = __builtin_amdgcn_mfma_f32_16x16x32_bf16(Bf[bj][n][k], Af[mm][k], acc[ai][bj][2 * mh + mm][n], 0, 0, 0);
            }
    }
    WAIT_L(0); BAR();
#undef GE_STAGE
}
template <int NBH> __device__ __forceinline__ void acc_zero(f32x4 (&acc)[2][NBH][4][2]) {
#pragma unroll
    for (int a = 0; a < 2; ++a)
#pragma unroll
        for (int b = 0; b < NBH; ++b)
#pragma unroll
            for (int m = 0; m < 4; ++m)
#pragma unroll
                for (int n = 0; n < 2; ++n) acc[a][b][m][n] = (f32x4){0.f, 0.f, 0.f, 0.f};
}
struct GeoT { int wid, lane, wr, wc, fr, fq, aoffl, boffl; int R[2], C[2]; };
__device__ __forceinline__ GeoT make_geo() {
    GeoT g; int tid = threadIdx.x; asm volatile("" : "+v"(tid)); g.wid = __builtin_amdgcn_readfirstlane(tid >> 6); g.lane = tid & 63; g.wr = g.wid >> 2; g.wc = g.wid & 3; g.fr = g.lane & 15; g.fq = g.lane >> 4;
    g.aoffl = lds_byte(g.wr * 64 + g.fr, g.fq * 8); g.boffl = lds_byte(g.wc * 32 + g.fr, g.fq * 8);
#pragma unroll
    for (int i = 0; i < 2; ++i) stage_rc(tid * 16 + i * 8192, g.R[i], g.C[i]);
    return g;
}
__device__ __forceinline__ void rows_contig(unsigned (&off)[2][2], const GeoT& g, int row0, unsigned pitch_bytes) {
#pragma unroll
    for (int h = 0; h < 2; ++h)
#pragma unroll
        for (int i = 0; i < 2; ++i) off[h][i] = (unsigned)(row0 + 128 * h + g.R[i]) * pitch_bytes + (unsigned)g.C[i] * 2u;
}

__device__ __forceinline__ void tr_item(const float* W, int N, bf16_t* WT, int Kd, int k0, int n0, int mode, LAS float* scr, int lane) {
#pragma unroll 8
    for (int i = 0; i < 32; ++i) { const int kk = 2 * i + (lane >> 5); scr[kk * 33 + (lane & 31)] = W[(size_t)(k0 + kk) * N + n0 + (lane & 31)]; }
    WAIT_L(0); asm volatile("" ::: "memory");
    const int c = lane & 7;
#pragma unroll
    for (int j = 0; j < 4; ++j) {
        const int nl = (lane >> 3) + 8 * j; const LAS float* s = scr + (8 * c) * 33 + nl;
        u32x4 o; o.x = cvt_pk_bf16(s[0 * 33], s[1 * 33]); o.y = cvt_pk_bf16(s[2 * 33], s[3 * 33]); o.z = cvt_pk_bf16(s[4 * 33], s[5 * 33]); o.w = cvt_pk_bf16(s[6 * 33], s[7 * 33]);
        const int n = n0 + nl;
        const int drow = (mode == 0) ? n : (256 * (n >> 7) + (n & 127) + (mode == 2 ? 128 : 0));
        *(u32x4*)(WT + (size_t)drow * Kd + k0 + 8 * c) = o;
    }
    WAIT_L(0); asm volatile("" ::: "memory");
}
__device__ __forceinline__ void mod_unit(Frame& F, int u) {
    const int l = u / 96, cb = u % 96;
    LAS float* sl = (LAS float*)F.lds;
    const float* c = F.in[I_C]; const float* cc = F.in[I_CCTX];
    for (int idx = F.tid; idx < 33 * 1024; idx += 512) { const int r = idx >> 10, k = idx & 1023; const float cv = (r < 32) ? c[r * 1024 + k] : cc[k]; sl[idx] = cv / (1.0f + expf(-cv)); }
    SYNC();
    float acc[33];
#pragma unroll
    for (int r = 0; r < 33; ++r) acc[r] = 0.f;
    const float* W = F.in[I_WMOD] + (size_t)l * 1024 * 6144 + 64 * cb + F.lane;
    const int kb = F.wave * 128;
#pragma unroll 4
    for (int k = 0; k < 128; ++k) {
        const float wv = W[(size_t)(kb + k) * 6144];
#pragma unroll
        for (int r = 0; r < 33; ++r) acc[r] += sl[r * 1024 + kb + k] * wv;
    }
    SYNC();
#pragma unroll
    for (int r = 0; r < 33; ++r) sl[(F.wave * 33 + r) * 64 + F.lane] = acc[r];
    SYNC();
    float* MOD = (float*)(F.ws + WS_MOD);
    for (int idx = F.tid; idx < 33 * 64; idx += 512) {
        const int r = idx >> 6, cl = idx & 63; float s = 0.f;
#pragma unroll
        for (int w = 0; w < 8; ++w) s += sl[(w * 33 + r) * 64 + cl];
        MOD[(size_t)(l * 33 + r) * 6144 + 64 * cb + cl] = s + F.in[I_BMOD][l * 6144 + 64 * cb + cl];
    }
    SYNC();
}
__device__ __forceinline__ void phase_pro(Frame& F) {
    for (int u = blockIdx.x; u < 192; u += F.G) mod_unit(F, u);
    if (blockIdx.x == F.G - 1) {
        float* TB = (float*)(F.ws + WS_TAB);
        for (int idx = F.tid; idx < 1024; idx += 512) { const int pos = idx >> 4, i = idx & 15; const float inv = 1.0f / powf(10000.0f, (float)i / 16.0f); const float a = (float)pos * inv; TB[TB_R64C + idx] = cosf(a); TB[TB_R64S + idx] = sinf(a); }
        for (int idx = F.tid; idx < 512; idx += 512) { const int pos = idx >> 3, i = idx & 7; const float inv = 1.0f / powf(10000.0f, (float)i / 8.0f); const float a = (float)pos * inv; TB[TB_R32C + idx] = cosf(a); TB[TB_R32S + idx] = sinf(a); }
        if (F.tid < 2) {
            const int l = F.tid; const float* lp = F.in[I_DLAM] + l * 128; float s1 = 0.f, s2 = 0.f;
            for (int i = 0; i < 32; ++i) { s1 += lp[i] * lp[32 + i]; s2 += lp[64 + i] * lp[96 + i]; }
            const float lam_init = 0.8f - 0.6f * expf(-0.3f * (float)l);
            float* sc = TB + TB_SC + 16 * l;
            sc[0] = expf(s1) - expf(s2) + lam_init; sc[1] = 1.0f - lam_init;
            for (int d = 0; d < 2; ++d) for (int h = 0; h < 4; ++h) sc[2 + 4 * d + h] = log1pf(-expf(F.in[I_RLD][l * 8 + d * 4 + h])) * LOG2E;
        }
    }
    LAS float* scr = (LAS float*)(F.lds + F.wave * 16384);
    const int gw = blockIdx.x * 8 + F.wave, NGW = F.G * 8;
    constexpr int I_IN = 16 * 224, I_BRN = 4 * 32, I_OUT = 16 * 32, I_GE = 16 * 16, I_DE = 8 * 32;
    constexpr int PER_LAYER = I_IN + 4 * I_BRN + I_OUT + 16 * (2 * I_GE + I_DE);
    for (int it = gw; it < 2 * PER_LAYER; it += NGW) {
        const int l = it / PER_LAYER; int r = it % PER_LAYER;
        if (r < I_IN) { tr_item(F.in[I_WIN] + (size_t)l * 1024 * INW, INW, (bf16_t*)(F.ws + WS_WIN) + (size_t)l * INW * 1024, 1024, 64 * (r / 224), 32 * (r % 224), 0, scr, F.lane); continue; } r -= I_IN;
        if (r < 4 * I_BRN) { const int n = r / I_BRN; r %= I_BRN; tr_item(F.in[I_WBR] + (size_t)(l * 4 + n) * 256 * 1024, 1024, (bf16_t*)(F.ws + WS_WBR) + (size_t)(l * 4 + n) * 1024 * 256, 256, 64 * (r / 32), 32 * (r % 32), 0, scr, F.lane); continue; } r -= 4 * I_BRN;
        if (r < I_OUT) { tr_item(F.in[I_WOUT] + (size_t)l * 1024 * 1024, 1024, (bf16_t*)(F.ws + WS_WOUT) + (size_t)l * 1024 * 1024, 1024, 64 * (r / 32), 32 * (r % 32), 0, scr, F.lane); continue; } r -= I_OUT;
        const int e = r / (2 * I_GE + I_DE); r %= (2 * I_GE + I_DE);
        const size_t le = (size_t)(l * 16 + e);
        if (r < I_GE) { tr_item(F.in[I_WG] + le * 1024 * 512, 512, (bf16_t*)(F.ws + WS_WGU) + le * 1024 * 1024, 1024, 64 * (r / 16), 32 * (r % 16), 1, scr, F.lane); continue; } r -= I_GE;
        if (r < I_GE) { tr_item(F.in[I_WU] + le * 1024 * 512, 512, (bf16_t*)(F.ws + WS_WGU) + le * 1024 * 1024, 1024, 64 * (r / 16), 32 * (r % 16), 2, scr, F.lane); continue; } r -= I_GE;
        tr_item(F.in[I_WD] + le * 512 * 1024, 1024, (bf16_t*)(F.ws + WS_WD) + le * 1024 * 512, 512, 64 * (r / 32), 32 * (r % 32), 0, scr, F.lane);
    }
}

__device__ __forceinline__ void row_load(const float* xrow, int lane, f32x4 (&v)[4]) {
    const f32x4* xr = (const f32x4*)xrow + lane;
#pragma unroll
    for (int j = 0; j < 4; ++j) v[j] = xr[64 * j];
}
__device__ __forceinline__ float row_rstd(const f32x4 (&v)[4]) {
    float s = 0.f;
#pragma unroll
    for (int j = 0; j < 4; ++j) s += (v[j].x * v[j].x + v[j].y * v[j].y) + (v[j].z * v[j].z + v[j].w * v[j].w);
    return 1.0f / sqrtf(wave_sum(s) * (1.0f / D) + EPS);
}
__device__ __forceinline__ void row_modulate(f32x4 (&v)[4], float rstd, const float* g, const float* shift, const float* scale, int lane) {
#pragma unroll
    for (int j = 0; j < 4; ++j) {
        const f32x4 gg = ((const f32x4*)g)[lane + 64 * j], sh = ((const f32x4*)shift)[lane + 64 * j], sc = ((const f32x4*)scale)[lane + 64 * j];
        v[j] = v[j] * rstd * gg * (sc + 1.0f) + sh;
    }
}
__device__ __forceinline__ void row_store_bf16(bf16_t* orow, int lane, const f32x4 (&v)[4]) {
    u32x2* o8 = (u32x2*)orow + lane;
#pragma unroll
    for (int j = 0; j < 4; ++j) { u32x2 w; w.x = cvt_pk_bf16(v[j].x, v[j].y); w.y = cvt_pk_bf16(v[j].z, v[j].w); o8[64 * j] = w; }
}
__device__ __forceinline__ const float* mod_ptr(Frame& F, int layer, int row) {
    const int b = (row < TLAT) ? (row >> 11) : 32;
    return (const float*)(F.ws + WS_MOD) + (size_t)(layer * 33 + b) * 6144;
}
__device__ __forceinline__ void phase_norm1_l0(Frame& F) {
    const int gw = blockIdx.x * 8 + F.wave, NGW = F.G * 8;
    bf16_t* XH = (bf16_t*)(F.ws + WS_XH);
    for (int row = gw; row < T; row += NGW) {
        const float* xrow = (row < TLAT) ? F.in[I_X] + (size_t)row * D : F.in[I_CTX] + (size_t)(row - TLAT) * D;
        f32x4 v[4]; row_load(xrow, F.lane, v);
        const float rstd = row_rstd(v);
        const float* mp = mod_ptr(F, 0, row);
        row_modulate(v, rstd, F.in[I_G1], mp, mp + 1024, F.lane);
        row_store_bf16(XH + (size_t)row * D, F.lane, v);
    }
}

__device__ __forceinline__ void epi_inproj(Frame& F, const f32x4 (&acc)[2][2][4][2], const GeoT& g, int pm, int pn, int layer) {
    bf16_t* P = (bf16_t*)(F.ws + WS_P);
    const float* TB = (const float*)(F.ws + WS_TAB);
    const bool lat = pm < 256;
    int mode = 0; float scale = 1.0f; const float* gain = nullptr;
    switch (pn) {
        case 0: scale = 0.125f * LOG2E; break;
        case 3: mode = 2; break;
        case 4: mode = 2; scale = 0.125f; break;
        case 6: mode = 4; break;
        case 7: mode = 5; scale = 0.125f * LOG2E; gain = F.in[I_QG] + layer * 64; break;
        case 8: if (g.wc < 2) { mode = 5; gain = F.in[I_KG] + layer * 64; } break;
        case 9: mode = 7; scale = 0.17677669529663687f * LOG2E; break;
        case 10: mode = 7; break;
        default: break;
    }
#pragma unroll
    for (int ai = 0; ai < 2; ++ai)
#pragma unroll
        for (int m = 0; m < 4; ++m) {
            const int row = pm * 256 + ai * 128 + g.wr * 64 + m * 16 + g.fr;
            const int t = row & 2047, gr = t >> 6, gc = t & 63;
            float v[2][2][4];
#pragma unroll
            for (int bj = 0; bj < 2; ++bj)
#pragma unroll
                for (int n = 0; n < 2; ++n)
#pragma unroll
                    for (int j = 0; j < 4; ++j) v[bj][n][j] = acc[ai][bj][m][n][j];
            if (mode == 5) {
                float ss = 0.f;
#pragma unroll
                for (int bj = 0; bj < 2; ++bj)
#pragma unroll
                    for (int n = 0; n < 2; ++n)
#pragma unroll
                        for (int j = 0; j < 4; ++j) ss += v[bj][n][j] * v[bj][n][j];
                ss += __shfl_xor(ss, 16); ss += __shfl_xor(ss, 32);
                const float r = 1.0f / sqrtf(ss * (1.0f / 64.0f) + EPS);
#pragma unroll
                for (int bj = 0; bj < 2; ++bj)
#pragma unroll
                    for (int n = 0; n < 2; ++n) { const f32x4 gg = *(const f32x4*)(gain + 32 * bj + 16 * n + 4 * g.fq);
#pragma unroll
                        for (int j = 0; j < 4; ++j) v[bj][n][j] = v[bj][n][j] * r * gg[j]; }
            }
            if ((mode == 2 || mode == 5) && lat) {
#pragma unroll
                for (int bj = 0; bj < 2; ++bj) {
                    const int pos = bj ? gc : gr;
                    const f32x4 cs = *(const f32x4*)(TB + TB_R64C + pos * 16 + 4 * g.fq), sn = *(const f32x4*)(TB + TB_R64S + pos * 16 + 4 * g.fq);
#pragma unroll
                    for (int j = 0; j < 4; ++j) { const float x1 = v[bj][0][j], x2 = v[bj][1][j]; v[bj][0][j] = x1 * cs[j] - x2 * sn[j]; v[bj][1][j] = x2 * cs[j] + x1 * sn[j]; }
                }
            }
            if (mode == 7) {
#pragma unroll
                for (int bj = 0; bj < 2; ++bj)
#pragma unroll
                    for (int n = 0; n < 2; ++n) {
                        const int pos = n ? gc : gr;
                        const f32x4 cs = *(const f32x4*)(TB + TB_R32C + pos * 8 + 4 * (g.fq & 1)), sn = *(const f32x4*)(TB + TB_R32S + pos * 8 + 4 * (g.fq & 1));
#pragma unroll
                        for (int j = 0; j < 4; ++j) {
                            const float xs = v[bj][n][j], xo = __shfl_xor(xs, 32);
                            const float rot = (g.fq >> 1) ? (xs * cs[j] + xo * sn[j]) : (xs * cs[j] - xo * sn[j]);
                            v[bj][n][j] = lat ? rot : xs;
                        }
                    }
            }
            bf16_t* prow = P + (size_t)row * PW + pn * 256 + g.wc * 64 + 4 * g.fq;
#pragma unroll
            for (int bj = 0; bj < 2; ++bj)
#pragma unroll
                for (int n = 0; n < 2; ++n) {
                    float o[4];
#pragma unroll
                    for (int j = 0; j < 4; ++j) { float x = v[bj][n][j] * scale; if (mode == 4) x = siluf_(x); o[j] = x; }
                    u32x2 w; w.x = cvt_pk_bf16(o[0], o[1]); w.y = cvt_pk_bf16(o[2], o[3]);
                    *(u32x2*)(prow + 32 * bj + 16 * n) = w;
                }
        }
}
__device__ __forceinline__ void phase_inproj(Frame& F, int layer) {
    const GeoT g = make_geo();
    const char* A = (const char*)(F.ws + WS_XH);
    const char* B = (const char*)(F.ws + WS_WIN) + (size_t)layer * INW * 1024 * 2;
    constexpr int NUN = (T / 256) * 12;
    for (int u = blockIdx.x; u < NUN; u += F.G) {
        const int pm = u / 12, pn = u % 12;
        unsigned aoff[2][2], boff[2][2];
        rows_contig(aoff, g, pm * 256, 2048u);
#pragma unroll
        for (int h = 0; h < 2; ++h)
#pragma unroll
            for (int i = 0; i < 2; ++i) { const int rho = g.R[i]; const int col = 256 * pn + 64 * (rho >> 5) + 32 * h + (rho & 31); boff[h][i] = (unsigned)col * 2048u + (unsigned)g.C[i] * 2u; }
        f32x4 acc[2][2][4][2]; acc_zero<2>(acc);
        gemm_kloop<2>(F.lds, A, aoff, B, boff, 16, acc, g.wid, g.aoffl, g.boffl);
        epi_inproj(F, acc, g, pm, pn, layer);
    }
}

constexpr int AL_K = 0, AL_V = 16384, AL_WSF = 32768, AL_OST = 36864, AL_TAB = 102400;
typedef short v4i16_t __attribute__((ext_vector_type(4)));
__device__ __forceinline__ int crow(int r, int hi) { return (r & 3) + 8 * (r >> 2) + 4 * hi; }
__device__ __forceinline__ f32x16 mfma32(bf16x8 a, bf16x8 b, f32x16 c) { return __builtin_amdgcn_mfma_f32_32x32x16_bf16(a, b, c, 0, 0, 0); }
__device__ __forceinline__ s16x4 vtr(const LAS unsigned char* p) { return __builtin_bit_cast(s16x4, __builtin_amdgcn_ds_read_tr16_b64_v4i16((LAS v4i16_t*)p)); }
__device__ __forceinline__ f32x16 f16zero() { f32x16 z;
#pragma unroll
    for (int r = 0; r < 16; ++r) z[r] = 0.f;
    return z; }

template <int D0LO, int D0HI>
__device__ __forceinline__ void qk_tile(f32x16& p0, f32x16& p1, const LAS unsigned char* Kb, const bf16x8 (&qr)[4], int r32, int hi) {
    const LAS unsigned char* kb = Kb + hi * 1024 + r32 * 16;
    p0 = f16zero(); p1 = f16zero();
#pragma unroll
    for (int d0 = D0LO; d0 < D0HI; ++d0) {
        const bf16x8 b0 = *(const LAS bf16x8*)(kb + d0 * 2048), b1 = *(const LAS bf16x8*)(kb + d0 * 2048 + 512);
        p0 = mfma32(b0, qr[d0], p0); p1 = mfma32(b1, qr[d0], p1);
    }
}
__device__ __forceinline__ float sm_tile(f32x16& p0, f32x16& p1, float& m, float& l) {
    float mx = fmaxf(p0[0], p1[0]);
#pragma unroll
    for (int r = 1; r < 16; ++r) mx = fmaxf(mx, fmaxf(p0[r], p1[r]));
    mx = fmaxf(mx, __shfl_xor(mx, 32));
    const float mn = fmaxf(m, mx), alpha = __builtin_amdgcn_exp2f(m - mn);
    m = mn; float s = 0.f;
#pragma unroll
    for (int r = 0; r < 16; ++r) { p0[r] = __builtin_amdgcn_exp2f(p0[r] - mn); p1[r] = __builtin_amdgcn_exp2f(p1[r] - mn); s += p0[r] + p1[r]; }
    l = l * alpha + s;
    return alpha;
}
__device__ __forceinline__ void o_scale(f32x16 (&o)[2], float f, LAS float* wsf, int r32, int hi) {
    asm volatile("" ::: "memory");
    if (hi == 0) wsf[r32] = f;
    asm volatile("s_waitcnt lgkmcnt(0)" ::: "memory");
#pragma unroll
    for (int r = 0; r < 16; ++r) { const float g = wsf[crow(r, hi)]; o[0][r] *= g; o[1][r] *= g; }
    asm volatile("s_waitcnt lgkmcnt(0)" ::: "memory");
}
__device__ __forceinline__ void pack_p(const f32x16& p0, const f32x16& p1, bf16x8 (&pw)[4]) {
    u32x4 w;
    w.x = cvt_pk_bf16(p0[0], p0[1]); w.y = cvt_pk_bf16(p0[2], p0[3]); w.z = cvt_pk_bf16(p0[4], p0[5]); w.w = cvt_pk_bf16(p0[6], p0[7]); pw[0] = __builtin_bit_cast(bf16x8, w);
    w.x = cvt_pk_bf16(p0[8], p0[9]); w.y = cvt_pk_bf16(p0[10], p0[11]); w.z = cvt_pk_bf16(p0[12], p0[13]); w.w = cvt_pk_bf16(p0[14], p0[15]); pw[1] = __builtin_bit_cast(bf16x8, w);
    w.x = cvt_pk_bf16(p1[0], p1[1]); w.y = cvt_pk_bf16(p1[2], p1[3]); w.z = cvt_pk_bf16(p1[4], p1[5]); w.w = cvt_pk_bf16(p1[6], p1[7]); pw[2] = __builtin_bit_cast(bf16x8, w);
    w.x = cvt_pk_bf16(p1[8], p1[9]); w.y = cvt_pk_bf16(p1[10], p1[11]); w.z = cvt_pk_bf16(p1[12], p1[13]); w.w = cvt_pk_bf16(p1[14], p1[15]); pw[3] = __builtin_bit_cast(bf16x8, w);
}
__device__ __forceinline__ void pv_tile(f32x16 (&o)[2], const LAS unsigned char* Vb, const bf16x8 (&pw)[4], int lane, int hi) {
    const LAS unsigned char* vp = Vb + ((lane >> 4) & 1) * 32 + (lane & 3) * 8 + (4 * hi + ((lane & 15) >> 2)) * 64;
#pragma unroll
    for (int d0 = 0; d0 < 2; ++d0)
#pragma unroll
        for (int ks = 0; ks < 4; ++ks) {
            const s16x4 lo = vtr(vp + d0 * 4096 + ks * 1024), hh = vtr(vp + d0 * 4096 + ks * 1024 + 512);
            const bf16x8 vf = (bf16x8){lo[0], lo[1], lo[2], lo[3], hh[0], hh[1], hh[2], hh[3]};
            o[d0] = mfma32(pw[ks], vf, o[d0]);
        }
}
__device__ __forceinline__ void o_stage(const f32x16 (&o)[2], LAS float* ost, int r32, int hi) {
#pragma unroll
    for (int r = 0; r < 16; ++r) { const int q = crow(r, hi); ost[q * 64 + r32] = o[0][r]; ost[q * 64 + 32 + r32] = o[1][r]; }
    asm volatile("s_waitcnt lgkmcnt(0)" ::: "memory");
}
__device__ __forceinline__ void stage_row_read(const LAS float* ost, int lane, float (&x)[32]) {
    const LAS f32x4* s = (const LAS f32x4*)(ost + (lane >> 1) * 64 + (lane & 1) * 32);
#pragma unroll
    for (int i = 0; i < 8; ++i) { const f32x4 v = s[i]; x[4 * i] = v.x; x[4 * i + 1] = v.y; x[4 * i + 2] = v.z; x[4 * i + 3] = v.w; }
    asm volatile("s_waitcnt lgkmcnt(0)" ::: "memory");
}
__device__ __forceinline__ void store_row32(bf16_t* dst, const float (&x)[32]) {
#pragma unroll
    for (int i = 0; i < 4; ++i) { u32x4 w; w.x = cvt_pk_bf16(x[8 * i], x[8 * i + 1]); w.y = cvt_pk_bf16(x[8 * i + 2], x[8 * i + 3]); w.z = cvt_pk_bf16(x[8 * i + 4], x[8 * i + 5]); w.w = cvt_pk_bf16(x[8 * i + 6], x[8 * i + 7]); ((u32x4*)dst)[i] = w; }
}

struct SmUnit {
    int qrow, qcol, kcol, vcol, ycol;
    int n1, row1, n2, row2;
    int na_r, na_c, na_kr0;
};
#define AT_LOADKV(t) do { const int _r0 = ((t) < U.n1) ? U.row1 + 64 * (t) : U.row2 + 64 * ((t) - U.n1); \
        kreg = *(const u32x4*)(Pb + (size_t)(_r0 + lane) * (PW * 2) + (U.kcol + 8 * wid) * 2); \
        vreg = *(const u32x4*)(Pb + (size_t)(_r0 + 16 * (wid & 3) + (lane >> 2)) * (PW * 2) + (U.vcol + 32 * (wid >> 2) + 8 * (lane & 3)) * 2); } while (0)
#define AT_COMMIT(buf) do { *(LAS u32x4*)(lds + AL_K + (buf) * 8192 + wid * 1024 + lane * 16) = kreg; *(LAS u32x4*)(lds + AL_V + (buf) * 8192 + wid * 1024 + lane * 16) = vreg; } while (0)

template <bool NA>
__device__ __forceinline__ void sm_unit(Frame& F, const SmUnit& U_) {
    SmUnit U = U_; VG(U.qcol); VG(U.kcol); VG(U.vcol); VG(U.ycol); VG(U.row1); VG(U.row2);
    const char* Pb = (const char*)(F.ws + WS_P);
    LAS unsigned char* lds = F.lds;
    const int lane = F.lane, r32 = lane & 31, hi = lane >> 5, wid = F.wave;
    bf16x8 qr[4];
    { const char* qp = Pb + (size_t)U.qrow * (PW * 2) + (U.qcol + 8 * hi) * 2;
#pragma unroll
      for (int d0 = 0; d0 < 4; ++d0) qr[d0] = *(const bf16x8*)(qp + d0 * 32); }
    const int NT = U.n1 + U.n2;
    u32x4 kreg, vreg;
    AT_LOADKV(0); AT_COMMIT(0); SYNC();
    float m = -1e30f, l = 0.f; f32x16 o[2]; o[0] = f16zero(); o[1] = f16zero();
    LAS float* wsf = (LAS float*)(lds + AL_WSF) + wid * 128;
    const LAS float* tab = (const LAS float*)(lds + AL_TAB);
    const int na_r0 = min(max(U.na_r - 4, 0), 24), na_ws = min(max(U.na_c - 8, 0), 48);
    for (int t = 0; t < NT; ++t) {
        const int buf = t & 1;
        if (t + 1 < NT) AT_LOADKV(t + 1);
        bool active = true; int kr = 0;
        if (NA && t >= U.n1) { kr = U.na_kr0 + (t - U.n1); active = (kr >= na_r0) && (kr < na_r0 + 8); }
        if (active) {
            f32x16 p0, p1; qk_tile<0, 4>(p0, p1, lds + AL_K + buf * 8192, qr, r32, hi);
            if (NA && t >= U.n1) {
                const LAS float* trow = tab + (kr - U.na_r + 7) * 31 + 15 - U.na_c;
#pragma unroll
                for (int r = 0; r < 16; ++r) {
                    const int kc0 = crow(r, hi), kc1 = kc0 + 32;
                    const bool v0 = (unsigned)(kc0 - na_ws) < 16u, v1 = (unsigned)(kc1 - na_ws) < 16u;
                    const float b0 = trow[v0 ? kc0 : U.na_c], b1 = trow[v1 ? kc1 : U.na_c];
                    p0[r] = v0 ? p0[r] + b0 : -1e30f; p1[r] = v1 ? p1[r] + b1 : -1e30f;
                }
            }
            const float alpha = sm_tile(p0, p1, m, l);
            o_scale(o, alpha, wsf, r32, hi);
            bf16x8 pw[4]; pack_p(p0, p1, pw);
            pv_tile(o, lds + AL_V + buf * 8192, pw, lane, hi);
        }
        if (t + 1 < NT) AT_COMMIT(buf ^ 1);
        SYNC();
    }
    l += __shfl_xor(l, 32);
    o_scale(o, 1.0f / l, wsf, r32, hi);
    LAS float* ost = (LAS float*)(lds + AL_OST) + wid * 2048;
    o_stage(o, ost, r32, hi);
    float x[32]; stage_row_read(ost, lane, x);
    const int trow_q = __shfl(U.qrow, lane >> 1);
    store_row32((bf16_t*)(F.ws + WS_Y) + (size_t)trow_q * D + U.ycol + 32 * (lane & 1), x);
}

__device__ __forceinline__ void diff_unit(Frame& F, const SmUnit& U_, int layer) {
    SmUnit U = U_; VG(U.qcol); VG(U.kcol); VG(U.vcol); VG(U.ycol); VG(U.row1); VG(U.row2);
    const char* Pb = (const char*)(F.ws + WS_P);
    LAS unsigned char* lds = F.lds;
    const int lane = F.lane, r32 = lane & 31, hi = lane >> 5, wid = F.wave;
    bf16x8 qr[4];
    { const char* qp = Pb + (size_t)U.qrow * (PW * 2) + (U.qcol + 8 * hi) * 2;
#pragma unroll
      for (int d0 = 0; d0 < 4; ++d0) qr[d0] = *(const bf16x8*)(qp + d0 * 32); }
    const int NT = U.n1 + U.n2;
    u32x4 kreg, vreg;
    AT_LOADKV(0); AT_COMMIT(0); SYNC();
    float m0 = -1e30f, l0 = 0.f, m1 = -1e30f, l1 = 0.f; f32x16 oa[2], ob[2]; oa[0] = f16zero(); oa[1] = f16zero(); ob[0] = f16zero(); ob[1] = f16zero();
    LAS float* wsf = (LAS float*)(lds + AL_WSF) + wid * 128;
    for (int t = 0; t < NT; ++t) {
        const int buf = t & 1;
        if (t + 1 < NT) AT_LOADKV(t + 1);
        {
            f32x16 p0, p1; bf16x8 pw[4];
            qk_tile<0, 2>(p0, p1, lds + AL_K + buf * 8192, qr, r32, hi);
            float alpha = sm_tile(p0, p1, m0, l0);
            o_scale(oa, alpha, wsf, r32, hi);
            pack_p(p0, p1, pw);
            pv_tile(oa, lds + AL_V + buf * 8192, pw, lane, hi);
            qk_tile<2, 4>(p0, p1, lds + AL_K + buf * 8192, qr, r32, hi);
            alpha = sm_tile(p0, p1, m1, l1);
            o_scale(ob, alpha, wsf, r32, hi);
            pack_p(p0, p1, pw);
            pv_tile(ob, lds + AL_V + buf * 8192, pw, lane, hi);
        }
        if (t + 1 < NT) AT_COMMIT(buf ^ 1);
        SYNC();
    }
    const float* SC = (const float*)(F.ws + WS_TAB) + TB_SC + 16 * layer;
    const float lam = SC[0], post = SC[1];
    l0 += __shfl_xor(l0, 32); l1 += __shfl_xor(l1, 32);
    o_scale(oa, 1.0f / l0, wsf, r32, hi);
    o_scale(ob, -lam / l1, wsf, r32, hi);
#pragma unroll
    for (int r = 0; r < 16; ++r) { oa[0][r] += ob[0][r]; oa[1][r] += ob[1][r]; }
    LAS float* ost = (LAS float*)(lds + AL_OST) + wid * 2048;
    o_stage(oa, ost, r32, hi);
    float x[32]; stage_row_read(ost, lane, x);
    float ss = 0.f;
#pragma unroll
    for (int i = 0; i < 32; ++i) ss += x[i] * x[i];
    ss += __shfl_xor(ss, 1);
    const float rn = post / sqrtf(ss * (1.0f / 64.0f) + EPS);
    const float* gain = F.in[I_DSUB] + layer * 64 + 32 * (lane & 1);
#pragma unroll
    for (int i = 0; i < 32; ++i) x[i] = x[i] * rn * gain[i];
    const int trow_q = __shfl(U.qrow, lane >> 1);
    store_row32((bf16_t*)(F.ws + WS_Y) + (size_t)trow_q * D + U.ycol + 32 * (lane & 1), x);
}

__device__ __forceinline__ int ret_chunk_row(int b, int ci) { return (ci < 2) ? TLAT + b * 256 + 128 * ci : b * 2048 + 128 * (ci - 2); }
__device__ __forceinline__ int ret_bpos(int ci) { return ci == 0 ? 1 : (ci == 1 ? 0 : 19 - ci); }
__device__ __forceinline__ void ret_unit(Frame& F, int layer, int b, int h, int cp) {
    const char* Pb = (const char*)(F.ws + WS_P);
    LAS unsigned char* lds = F.lds;
    const int lane = F.lane, r32 = lane & 31, hi = lane >> 5, wid = F.wave;
    const float* SC = (const float*)(F.ws + WS_TAB) + TB_SC + 16 * layer;
    const float lgf = SC[2 + h], lgb = SC[6 + h];
    const int ccw = wid >> 2, ciw = 2 * cp + ccw, tq = 32 * (wid & 3) + r32;
    const int qrow = ret_chunk_row(b, ciw) + tq;
    bf16x8 qr[4];
    { const char* qp = Pb + (size_t)qrow * (PW * 2) + (C_RQ + 64 * h + 8 * hi) * 2;
#pragma unroll
      for (int d0 = 0; d0 < 4; ++d0) qr[d0] = *(const bf16x8*)(qp + d0 * 32); }
    const float* KV = (const float*)(F.ws + WS_RETKV) + (size_t)((b * 4 + h) * NCHUNK) * 2 * 4096;
    u32x4 kreg, vreg;
    const int sd = 16 * (wid & 3) + (lane >> 2), se = 32 * (wid >> 2) + 8 * (lane & 3);
#define RT_LOAD(t) do { const int _cc = (t) >> 2, _kind = (t) & 3, _c2 = 2 * cp + _cc; \
        if (_kind < 2) { const int _r0 = ret_chunk_row(b, _c2) + 64 * _kind; \
            kreg = *(const u32x4*)(Pb + (size_t)(_r0 + lane) * (PW * 2) + (C_RK + 64 * h + 8 * wid) * 2); \
            vreg = *(const u32x4*)(Pb + (size_t)(_r0 + sd) * (PW * 2) + (C_RV + 64 * h + se) * 2); \
        } else { \
            const int _e = lane - 8 * wid; kreg = (u32x4){0u, 0u, 0u, 0u}; \
            if (_e >= 0 && _e < 8) { const unsigned _one = (_e & 1) ? 0x3F800000u : 0x00003F80u; if ((_e >> 1) == 0) kreg.x = _one; else if ((_e >> 1) == 1) kreg.y = _one; else if ((_e >> 1) == 2) kreg.z = _one; else kreg.w = _one; } \
            float _s[8]; _Pragma("unroll") for (int _i = 0; _i < 8; ++_i) _s[_i] = 0.f; \
            const int _dir = _kind - 2; const float _lg = _dir ? lgb : lgf; const int _mypos = _dir ? ret_bpos(_c2) : _c2; \
            for (int _j = 0; _j < NCHUNK; ++_j) { const int _jp = _dir ? ret_bpos(_j) : _j; if (_jp < _mypos) { \
                const float _cf = __builtin_amdgcn_exp2f(_lg * 128.0f * (float)(_mypos - 1 - _jp)); const f32x4* _p = (const f32x4*)(KV + (size_t)(_j * 2 + _dir) * 4096 + sd * 64 + se); \
                const f32x4 _a = _p[0], _b = _p[1]; _s[0] += _cf * _a.x; _s[1] += _cf * _a.y; _s[2] += _cf * _a.z; _s[3] += _cf * _a.w; _s[4] += _cf * _b.x; _s[5] += _cf * _b.y; _s[6] += _cf * _b.z; _s[7] += _cf * _b.w; } } \
            vreg.x = cvt_pk_bf16(_s[0], _s[1]); vreg.y = cvt_pk_bf16(_s[2], _s[3]); vreg.z = cvt_pk_bf16(_s[4], _s[5]); vreg.w = cvt_pk_bf16(_s[6], _s[7]); } } while (0)
    RT_LOAD(0); AT_COMMIT(0); SYNC();
    f32x16 o[2]; o[0] = f16zero(); o[1] = f16zero();
    for (int t = 0; t < 8; ++t) {
        const int buf = t & 1;
        if (t + 1 < 8) RT_LOAD(t + 1);
        const int cc = t >> 2, kind = t & 3;
        if (cc == ccw) {
            f32x16 p0, p1; qk_tile<0, 4>(p0, p1, lds + AL_K + buf * 8192, qr, r32, hi);
            if (kind < 2) {
#pragma unroll
                for (int r = 0; r < 16; ++r) {
                    const int tk0 = 64 * kind + crow(r, hi), d0 = tq - tk0, d1 = d0 - 32;
                    const float f0 = d0 > 0 ? __builtin_amdgcn_exp2f(lgf * (float)d0) : (d0 < 0 ? __builtin_amdgcn_exp2f(lgb * (float)(-d0)) : 2.0f);
                    const float f1 = d1 > 0 ? __builtin_amdgcn_exp2f(lgf * (float)d1) : (d1 < 0 ? __builtin_amdgcn_exp2f(lgb * (float)(-d1)) : 2.0f);
                    p0[r] *= f0; p1[r] *= f1;
                }
            } else {
                const float f = (kind == 2) ? __builtin_amdgcn_exp2f(lgf * (float)(tq + 1)) : __builtin_amdgcn_exp2f(lgb * (float)(128 - tq));
#pragma unroll
                for (int r = 0; r < 16; ++r) { p0[r] *= f; p1[r] *= f; }
            }
            bf16x8 pw[4]; pack_p(p0, p1, pw);
            pv_tile(o, lds + AL_V + buf * 8192, pw, lane, hi);
        }
        if (t + 1 < 8) AT_COMMIT(buf ^ 1);
        SYNC();
    }
#undef RT_LOAD
    LAS float* ost = (LAS float*)(lds + AL_OST) + wid * 2048;
    o_stage(o, ost, r32, hi);
    float x[32]; stage_row_read(ost, lane, x);
    float s = 0.f;
#pragma unroll
    for (int i = 0; i < 32; ++i) s += x[i];
    s += __shfl_xor(s, 1);
    const float mu = s * (1.0f / 64.0f); float q = 0.f;
#pragma unroll
    for (int i = 0; i < 32; ++i) { x[i] -= mu; q += x[i] * x[i]; }
    q += __shfl_xor(q, 1);
    const float rs = 1.0f / sqrtf(q * (1.0f / 64.0f) + EPS);
    const int trow_q = __shfl(qrow, lane >> 1);
    const bf16_t* gp = (const bf16_t*)Pb + (size_t)trow_q * PW + C_RG + 64 * h + 32 * (lane & 1);
#pragma unroll
    for (int i = 0; i < 4; ++i) { const u32x4 gw = ((const u32x4*)gp)[i];
        x[8 * i + 0] *= rs * bf_lo(gw.x); x[8 * i + 1] *= rs * bf_hi(gw.x); x[8 * i + 2] *= rs * bf_lo(gw.y); x[8 * i + 3] *= rs * bf_hi(gw.y);
        x[8 * i + 4] *= rs * bf_lo(gw.z); x[8 * i + 5] *= rs * bf_hi(gw.z); x[8 * i + 6] *= rs * bf_lo(gw.w); x[8 * i + 7] *= rs * bf_hi(gw.w); }
    store_row32((bf16_t*)(F.ws + WS_Y) + (size_t)trow_q * D + 256 + 64 * h + 32 * (lane & 1), x);
}

__device__ __forceinline__ void phase_retkv(Frame& F, int layer) {
    const char* Pb = (const char*)(F.ws + WS_P);
    const float* SC = (const float*)(F.ws + WS_TAB) + TB_SC + 16 * layer;
    LAS bf16_t* kl = (LAS bf16_t*)F.lds;
    LAS bf16_t* vl = (LAS bf16_t*)(F.lds + 16384);
    LAS float* wf = (LAS float*)(F.lds + 32768);
    const int tid = F.tid;
    for (int u = blockIdx.x; u < NBATCH * 4 * NCHUNK; u += F.G) {
        const int j = u % NCHUNK, bh = u / NCHUNK, h = bh & 3, b = bh >> 2;
        const int r0 = ret_chunk_row(b, j);
        const float lgf = SC[2 + h], lgb = SC[6 + h];
        for (int i = tid; i < 1024; i += 512) { const int s = i >> 3, c = i & 7;
            *(LAS u32x4*)(kl + s * 64 + 8 * c) = *(const u32x4*)(Pb + (size_t)(r0 + s) * (PW * 2) + (C_RK + 64 * h + 8 * c) * 2);
            *(LAS u32x4*)(vl + s * 64 + 8 * c) = *(const u32x4*)(Pb + (size_t)(r0 + s) * (PW * 2) + (C_RV + 64 * h + 8 * c) * 2); }
        if (tid < 128) { wf[tid] = exp2f(lgf * (float)(127 - tid)); wf[128 + tid] = exp2f(lgb * (float)tid); }
        SYNC();
        const int d = tid >> 3, e0 = 8 * (tid & 7);
        float af[8], ab[8];
#pragma unroll
        for (int i = 0; i < 8; ++i) { af[i] = 0.f; ab[i] = 0.f; }
        for (int s = 0; s < 128; ++s) {
            const float kd = bf2f(kl[s * 64 + d]); const float kf = kd * wf[s], kb = kd * wf[128 + s];
            const u32x4 vv = *(const LAS u32x4*)(vl + s * 64 + e0);
            const float v[8] = {bf_lo(vv.x), bf_hi(vv.x), bf_lo(vv.y), bf_hi(vv.y), bf_lo(vv.z), bf_hi(vv.z), bf_lo(vv.w), bf_hi(vv.w)};
#pragma unroll
            for (int i = 0; i < 8; ++i) { af[i] += kf * v[i]; ab[i] += kb * v[i]; }
        }
        float* KV = (float*)(F.ws + WS_RETKV) + (size_t)(bh * NCHUNK + j) * 2 * 4096 + d * 64 + e0;
        ((f32x4*)KV)[0] = (f32x4){af[0], af[1], af[2], af[3]}; ((f32x4*)KV)[1] = (f32x4){af[4], af[5], af[6], af[7]};
        ((f32x4*)(KV + 4096))[0] = (f32x4){ab[0], ab[1], ab[2], ab[3]}; ((f32x4*)(KV + 4096))[1] = (f32x4){ab[4], ab[5], ab[6], ab[7]};
        SYNC();
    }
}

__device__ __forceinline__ void phase_mixers(Frame& F, int layer) {
    const bool ctx = (layer == 0);
    const int lane = F.lane, r32 = lane & 31, wid = F.wave;
    for (int u = blockIdx.x; u < 1024 + (ctx ? 128 : 0); u += F.G) {
        SmUnit U{};
        if (u < 1024) { const int qb = u & 7, h = (u >> 3) & 3, b = u >> 5;
            U.qrow = b * 2048 + 256 * qb + 32 * wid + r32; U.qcol = C_DQ + 64 * h; U.kcol = C_DK + 64 * h; U.vcol = C_DV + 64 * h; U.ycol = 768 + 64 * h;
            U.n1 = 32; U.row1 = b * 2048; U.n2 = 4; U.row2 = TLAT + b * 256;
        } else { const int v = u - 1024, h = v & 3, b = v >> 2;
            U.qrow = TLAT + b * 256 + 32 * wid + r32; U.qcol = C_DQ + 64 * h; U.kcol = C_DK + 64 * h; U.vcol = C_DV + 64 * h; U.ycol = 768 + 64 * h;
            U.n1 = 4; U.row1 = TLAT + b * 256; U.n2 = 0; U.row2 = 0; }
        diff_unit(F, U, layer);
    }
    for (int u = blockIdx.x; u < 1024 + (ctx ? 256 : 0); u += F.G) {
        SmUnit U{};
        if (u < 1024) { const int qb = u & 15, kvh = (u >> 4) & 1, b = u >> 5, head = 2 * kvh + (wid >> 2);
            U.qrow = b * 2048 + 128 * qb + 32 * (wid & 3) + r32; U.qcol = C_GQ + 64 * head; U.kcol = C_GK + 64 * kvh; U.vcol = C_GV + 64 * kvh; U.ycol = 512 + 64 * head;
            U.n1 = 32; U.row1 = b * 2048; U.n2 = 4; U.row2 = TLAT + b * 256;
        } else if (u < 1152) { const int v = u - 1024, qb = v & 1, kvh = (v >> 1) & 1, b = v >> 2, head = 2 * kvh + (wid >> 2);
            U.qrow = TLAT + b * 256 + 128 * qb + 32 * (wid & 3) + r32; U.qcol = C_GQ + 64 * head; U.kcol = C_GK + 64 * kvh; U.vcol = C_GV + 64 * kvh; U.ycol = 512 + 64 * head;
            U.n1 = 4; U.row1 = TLAT + b * 256; U.n2 = 0; U.row2 = 0;
        } else { const int v = u - 1152, h = v & 3, b = v >> 2;
            U.qrow = TLAT + b * 256 + 32 * wid + r32; U.qcol = C_NAQ + 64 * h; U.kcol = C_NAK + 64 * h; U.vcol = C_NAV + 64 * h; U.ycol = 64 * h;
            U.n1 = 4; U.row1 = TLAT + b * 256; U.n2 = 0; U.row2 = 0; }
        sm_unit<false>(F, U);
    }
    for (int u = blockIdx.x; u < 1024; u += F.G) {
        const int g = u & 7, h = (u >> 3) & 3, b = u >> 5;
        { LAS float* tab = (LAS float*)(F.lds + AL_TAB); const float* rpb = F.in[I_RPB] + (size_t)(layer * 4 + h) * 465;
          for (int i = F.tid; i < 465; i += 512) tab[i] = rpb[i] * LOG2E; }
        SmUnit U{}; U.na_r = 4 * g + (wid >> 1); U.na_c = 32 * (wid & 1) + r32;
        U.qrow = b * 2048 + 64 * U.na_r + U.na_c; U.qcol = C_NAQ + 64 * h; U.kcol = C_NAK + 64 * h; U.vcol = C_NAV + 64 * h; U.ycol = 64 * h;
        U.n1 = 4; U.row1 = TLAT + b * 256;
        const int kr0 = min(max(4 * g - 4, 0), 24), krl = min(max(4 * g + 3 - 4, 0), 24) + 7;
        U.na_kr0 = kr0; U.n2 = krl - kr0 + 1; U.row2 = b * 2048 + 64 * kr0;
        sm_unit<true>(F, U);
    }
    { const int npair = ctx ? 9 : 8;
      for (int u = blockIdx.x; u < NBATCH * 4 * npair; u += F.G) { const int cp = (u % npair) + (ctx ? 0 : 1), bh = u / npair; ret_unit(F, layer, bh >> 2, bh & 3, cp); } }
}


__device__ __forceinline__ void phase_merge(Frame& F, int layer) {
    const GeoT g = make_geo();
    const char* XH = (const char*)(F.ws + WS_XH);
    const char* Yb = (const char*)(F.ws + WS_Y);
    const char* Wg = (const char*)(F.ws + WS_WIN) + ((size_t)layer * INW + PW) * 1024 * 2;
    const char* Wb = (const char*)(F.ws + WS_WBR) + (size_t)layer * 4 * 1024 * 256 * 2;
    bf16_t* ACC = (bf16_t*)(F.ws + WS_P);
    const int nrow_tiles = (layer == 0) ? T / 256 : TLAT / 256;
    for (int u = blockIdx.x; u < nrow_tiles * 8; u += F.G) {
        const int pm = u >> 3, jt = u & 7;
        unsigned aoffx[2][2], boffg[2][2], boffb[2][2];
        rows_contig(aoffx, g, pm * 256, 2048u);
#pragma unroll
        for (int i = 0; i < 2; ++i) { boffg[0][i] = (unsigned)(128 * jt + g.R[i]) * 2048u + (unsigned)g.C[i] * 2u; boffg[1][i] = 0u;
                                      boffb[0][i] = (unsigned)(128 * jt + g.R[i]) * 512u + (unsigned)g.C[i] * 2u; boffb[1][i] = 0u; }
        unsigned outp[2][4][2][2];
#pragma unroll
        for (int a = 0; a < 2; ++a)
#pragma unroll
            for (int m = 0; m < 4; ++m)
#pragma unroll
                for (int nn = 0; nn < 2; ++nn) { outp[a][m][nn][0] = 0u; outp[a][m][nn][1] = 0u; }
        for (int n = 0; n < 4; ++n) {
            f32x4 acc[2][1][4][2]; acc_zero<1>(acc);
            gemm_kloop<1>(F.lds, Yb + n * 512, aoffx, Wb + (size_t)n * 1024 * 256 * 2, boffb, 4, acc, g.wid, g.aoffl, g.boffl);
            unsigned yb[2][4][2][2];
#pragma unroll
            for (int a = 0; a < 2; ++a)
#pragma unroll
                for (int m = 0; m < 4; ++m)
#pragma unroll
                    for (int nn = 0; nn < 2; ++nn) { yb[a][m][nn][0] = cvt_pk_bf16(acc[a][0][m][nn][0], acc[a][0][m][nn][1]); yb[a][m][nn][1] = cvt_pk_bf16(acc[a][0][m][nn][2], acc[a][0][m][nn][3]); }
            acc_zero<1>(acc);
            gemm_kloop<1>(F.lds, XH, aoffx, Wg + (size_t)n * 1024 * 1024 * 2, boffg, 16, acc, g.wid, g.aoffl, g.boffl);
#pragma unroll
            for (int a = 0; a < 2; ++a)
#pragma unroll
                for (int m = 0; m < 4; ++m)
#pragma unroll
                    for (int nn = 0; nn < 2; ++nn) {
                        const float o0 = bf_lo(outp[a][m][nn][0]) + sigmoidf_(acc[a][0][m][nn][0]) * bf_lo(yb[a][m][nn][0]);
                        const float o1 = bf_hi(outp[a][m][nn][0]) + sigmoidf_(acc[a][0][m][nn][1]) * bf_hi(yb[a][m][nn][0]);
                        const float o2 = bf_lo(outp[a][m][nn][1]) + sigmoidf_(acc[a][0][m][nn][2]) * bf_lo(yb[a][m][nn][1]);
                        const float o3 = bf_hi(outp[a][m][nn][1]) + sigmoidf_(acc[a][0][m][nn][3]) * bf_hi(yb[a][m][nn][1]);
                        outp[a][m][nn][0] = cvt_pk_bf16(o0, o1); outp[a][m][nn][1] = cvt_pk_bf16(o2, o3);
                    }
        }
#pragma unroll
        for (int a = 0; a < 2; ++a)
#pragma unroll
            for (int m = 0; m < 4; ++m) {
                const int row = pm * 256 + a * 128 + g.wr * 64 + m * 16 + g.fr;
                bf16_t* op = ACC + (size_t)row * D + 128 * jt + 32 * g.wc + 4 * g.fq;
#pragma unroll
                for (int nn = 0; nn < 2; ++nn) { u32x2 w; w.x = outp[a][m][nn][0]; w.y = outp[a][m][nn][1]; *(u32x2*)(op + 16 * nn) = w; }
            }
    }
}

__device__ __forceinline__ float* xrow_ptr(Frame& F, int row) { return (row < TLAT) ? F.out + (size_t)row * D : (float*)(F.ws + WS_X1CTX) + (size_t)(row - TLAT) * D; }
__device__ __forceinline__ void phase_outproj(Frame& F, int layer) {
    const GeoT g = make_geo();
    const char* A = (const char*)(F.ws + WS_P);
    const char* B = (const char*)(F.ws + WS_WOUT) + (size_t)layer * 1024 * 1024 * 2;
    const int nrow_tiles = (layer == 0) ? T / 256 : TLAT / 256;
    for (int u = blockIdx.x; u < nrow_tiles * 4; u += F.G) {
        const int pm = u >> 2, pn = u & 3;
        unsigned aoff[2][2], boff[2][2];
        rows_contig(aoff, g, pm * 256, 2048u);
        rows_contig(boff, g, pn * 256, 2048u);
        f32x4 acc[2][2][4][2]; acc_zero<2>(acc);
        gemm_kloop<2>(F.lds, A, aoff, B, boff, 16, acc, g.wid, g.aoffl, g.boffl);
        const int row0 = pm * 256 + g.wr * 64 + g.fr;
        const float* gt = mod_ptr(F, layer, pm * 256) + 2048;
#pragma unroll
        for (int ai = 0; ai < 2; ++ai)
#pragma unroll
            for (int m = 0; m < 4; ++m) {
                const int row = row0 + ai * 128 + m * 16;
                const float* xin = (layer == 0) ? ((row < TLAT) ? F.in[I_X] + (size_t)row * D : F.in[I_CTX] + (size_t)(row - TLAT) * D) : xrow_ptr(F, row);
                float* xo = xrow_ptr(F, row);
#pragma unroll
                for (int bj = 0; bj < 2; ++bj)
#pragma unroll
                    for (int n = 0; n < 2; ++n) {
                        const int col = pn * 256 + bj * 128 + g.wc * 32 + n * 16 + 4 * g.fq;
                        const f32x4 xv = *(const f32x4*)(xin + col), gv = *(const f32x4*)(gt + col);
                        *(f32x4*)(xo + col) = xv + gv * acc[ai][bj][m][n];
                    }
            }
    }
}

__device__ __forceinline__ void phase_norm2route(Frame& F, int layer) {
    LAS float* wrl = (LAS float*)F.lds;
    LAS unsigned* rowE = (LAS unsigned*)(F.lds + 65536);
    LAS float* rowW = (LAS float*)(F.lds + 65536 + 1024);
    LAS unsigned* ebase = (LAS unsigned*)(F.lds + 65536 + 3072);
    for (int i = F.tid; i < 16384 / 4; i += 512) ((LAS f32x4*)wrl)[i] = ((const f32x4*)F.in[I_WR])[i];
    SYNC();
    const int nrows = (layer == 0) ? T : TLAT;
    bf16_t* XM = (bf16_t*)(F.ws + WS_XH);
    unsigned* ecnt = (unsigned*)(F.ws + WS_CTL) + CW_ECNT + 64 * layer;
    unsigned* toklist = (unsigned*)(F.ws + WS_TOKLIST);
    unsigned* tokslot = (unsigned*)(F.ws + WS_TOKSLOT);
    float* tokw = (float*)(F.ws + WS_TOKW);
    const float* rb = F.in[I_RB];
    for (int ch = blockIdx.x; ch < nrows / 256; ch += F.G) {
        for (int rr = 0; rr < 32; ++rr) {
            const int rl = F.wave * 32 + rr, row = ch * 256 + rl;
            f32x4 v[4]; row_load(xrow_ptr(F, row), F.lane, v);
            const float rstd = row_rstd(v);
            const float* mp = mod_ptr(F, layer, row);
            row_modulate(v, rstd, F.in[I_G2] + layer * D, mp + 3072, mp + 4096, F.lane);
            row_store_bf16(XM + (size_t)row * D, F.lane, v);
            float lg[16];
#pragma unroll
            for (int e = 0; e < 16; ++e) lg[e] = 0.f;
#pragma unroll
            for (int j = 0; j < 4; ++j)
#pragma unroll
                for (int c = 0; c < 4; ++c) {
                    const int k = 4 * F.lane + 256 * j + c; const float xv = v[j][c];
                    const LAS f32x4* wp = (const LAS f32x4*)(wrl + k * 16);
#pragma unroll
                    for (int q = 0; q < 4; ++q) { const f32x4 w4 = wp[q]; lg[4 * q] += xv * w4.x; lg[4 * q + 1] += xv * w4.y; lg[4 * q + 2] += xv * w4.z; lg[4 * q + 3] += xv * w4.w; }
                }
#pragma unroll
            for (int e = 0; e < 16; ++e) lg[e] = wave_sum(lg[e]);
            if (F.lane == 0) {
                float s[16], sel[16];
#pragma unroll
                for (int e = 0; e < 16; ++e) { s[e] = 1.0f / (1.0f + expf(-lg[e])); sel[e] = s[e] + rb[e]; }
                int gbest = 0; float gs_best = -1e30f;
#pragma unroll
                for (int gi = 0; gi < 4; ++gi) {
                    float a = -1e30f, b2 = -1e30f;
#pragma unroll
                    for (int i = 0; i < 4; ++i) { const float x = sel[4 * gi + i]; if (x > a) { b2 = a; a = x; } else if (x > b2) b2 = x; }
                    const float gs = a + b2; if (gs > gs_best) { gs_best = gs; gbest = gi; }
                }
                int i0 = 0, i1 = 0; float a = -1e30f, b2 = -1e30f;
#pragma unroll
                for (int gi = 0; gi < 4; ++gi) if (gi == gbest) {
#pragma unroll
                    for (int i = 0; i < 4; ++i) { const float x = sel[4 * gi + i]; if (x > a) { b2 = a; i1 = i0; a = x; i0 = i; } else if (x > b2) { b2 = x; i1 = i; } }
                }
                const int e0 = 4 * gbest + i0, e1 = 4 * gbest + i1;
                float w0 = 0.f, w1 = 0.f;
#pragma unroll
                for (int e = 0; e < 16; ++e) { if (e == e0) w0 = s[e]; if (e == e1) w1 = s[e]; }
                const float inv = 1.0f / (w0 + w1);
                rowE[rl] = (unsigned)e0 | ((unsigned)e1 << 8); rowW[2 * rl] = w0 * inv; rowW[2 * rl + 1] = w1 * inv;
            }
        }
        SYNC();
        if (F.tid < 16) {
            const unsigned e = F.tid; unsigned cnt = 0;
            for (int i = 0; i < 256; ++i) { const unsigned pe = rowE[i]; cnt += ((pe & 255u) == e) + ((pe >> 8) == e); }
            unsigned base = cnt ? atomicAdd(ecnt + e, cnt) : 0u;
            for (int i = 0; i < 256; ++i) {
                const unsigned pe = rowE[i]; const int row = ch * 256 + i;
                if ((pe & 255u) == e) { toklist[e * T + base] = row; tokslot[2 * row] = (e << 24) | base; tokw[2 * row] = rowW[2 * i]; ++base; }
                if ((pe >> 8) == e) { toklist[e * T + base] = row; tokslot[2 * row + 1] = (e << 24) | base; tokw[2 * row + 1] = rowW[2 * i + 1]; ++base; }
            }
        }
        SYNC();
    }
    (void)ebase;
}

__device__ __forceinline__ int moe_segments(Frame& F, int layer) {
    const unsigned* ecnt = (const unsigned*)(F.ws + WS_CTL) + CW_ECNT + 64 * layer;
    LAS int* seg = (LAS int*)(F.lds + LDS_MISC + 256);
    LAS unsigned char* blk2e = (LAS unsigned char*)(F.lds + LDS_MISC + 512);
    if (F.tid == 0) { int acc = 0;
        for (int e = 0; e < 16; ++e) { seg[e] = acc; acc += (int)((__hip_atomic_load(ecnt + e, __ATOMIC_RELAXED, __HIP_MEMORY_SCOPE_AGENT) + 255u) >> 8); }
        seg[16] = acc; }
    SYNC();
    const int nblk = seg[16];
    for (int blk = F.tid; blk < nblk; blk += 512) { int e = 0; for (int i = 1; i < 16; ++i) e += (blk >= seg[i]) ? 1 : 0; blk2e[blk] = (unsigned char)e; }
    SYNC();
    return nblk;
}
__device__ __forceinline__ void phase_moeup(Frame& F, int layer) {
    const GeoT g = make_geo();
    const unsigned* ecnt = (const unsigned*)(F.ws + WS_CTL) + CW_ECNT + 64 * layer;
    const LAS int* seg = (const LAS int*)(F.lds + LDS_MISC + 256);
    const LAS unsigned char* blk2e = (const LAS unsigned char*)(F.lds + LDS_MISC + 512);
    const int nblk = moe_segments(F, layer);
    const char* A = (const char*)(F.ws + WS_XH);
    const unsigned* toklist = (const unsigned*)(F.ws + WS_TOKLIST);
    bf16_t* U = (bf16_t*)(F.ws + WS_U);
    for (int u = blockIdx.x; u < nblk * 4; u += F.G) {
        const int blk = u >> 2, pn = u & 3;
        const int e = __builtin_amdgcn_readfirstlane((int)blk2e[blk]);
        const int rb = blk - __builtin_amdgcn_readfirstlane(seg[e]);
        const int cnt = (int)__hip_atomic_load(ecnt + e, __ATOMIC_RELAXED, __HIP_MEMORY_SCOPE_AGENT);
        const char* B = (const char*)(F.ws + WS_WGU) + (size_t)(layer * 16 + e) * 1024 * 1024 * 2;
        unsigned aoff[2][2], boff[2][2];
#pragma unroll
        for (int h = 0; h < 2; ++h)
#pragma unroll
            for (int i = 0; i < 2; ++i) { const int sl = rb * 256 + 128 * h + g.R[i]; const unsigned tok = (sl < cnt) ? toklist[e * T + sl] : 0u; aoff[h][i] = tok * 2048u + (unsigned)g.C[i] * 2u; }
        rows_contig(boff, g, pn * 256, 2048u);
        f32x4 acc[2][2][4][2]; acc_zero<2>(acc);
        gemm_kloop<2>(F.lds, A, aoff, B, boff, 16, acc, g.wid, g.aoffl, g.boffl);
#pragma unroll
        for (int ai = 0; ai < 2; ++ai)
#pragma unroll
            for (int m = 0; m < 4; ++m) {
                const size_t slot = (size_t)blk * 256 + ai * 128 + g.wr * 64 + m * 16 + g.fr;
                bf16_t* up = U + slot * DE + pn * 128 + g.wc * 32 + 4 * g.fq;
#pragma unroll
                for (int n = 0; n < 2; ++n) {
                    const f32x4 gv = acc[ai][0][m][n], uv = acc[ai][1][m][n];
                    u32x2 w; w.x = cvt_pk_bf16(siluf_(gv.x) * uv.x, siluf_(gv.y) * uv.y); w.y = cvt_pk_bf16(siluf_(gv.z) * uv.z, siluf_(gv.w) * uv.w);
                    *(u32x2*)(up + 16 * n) = w;
                }
            }
    }
}
__device__ __forceinline__ void phase_moedown(Frame& F, int layer) {
    const GeoT g = make_geo();
    const LAS unsigned char* blk2e = (const LAS unsigned char*)(F.lds + LDS_MISC + 512);
    const int nblk = moe_segments(F, layer);
    const char* A = (const char*)(F.ws + WS_U);
    bf16_t* DN = (bf16_t*)(F.ws + WS_DN);
    for (int u = blockIdx.x; u < nblk * 4; u += F.G) {
        const int blk = u >> 2, pn = u & 3;
        const int e = __builtin_amdgcn_readfirstlane((int)blk2e[blk]);
        const char* B = (const char*)(F.ws + WS_WD) + (size_t)(layer * 16 + e) * 1024 * 512 * 2;
        unsigned aoff[2][2], boff[2][2];
        rows_contig(aoff, g, blk * 256, 1024u);
        rows_contig(boff, g, pn * 256, 1024u);
        f32x4 acc[2][2][4][2]; acc_zero<2>(acc);
        gemm_kloop<2>(F.lds, A, aoff, B, boff, 8, acc, g.wid, g.aoffl, g.boffl);
#pragma unroll
        for (int ai = 0; ai < 2; ++ai)
#pragma unroll
            for (int m = 0; m < 4; ++m) {
                const size_t slot = (size_t)blk * 256 + ai * 128 + g.wr * 64 + m * 16 + g.fr;
                bf16_t* dp = DN + slot * D + pn * 256 + g.wc * 32 + 4 * g.fq;
#pragma unroll
                for (int bj = 0; bj < 2; ++bj)
#pragma unroll
                    for (int n = 0; n < 2; ++n) { const f32x4 v = acc[ai][bj][m][n]; u32x2 w; w.x = cvt_pk_bf16(v.x, v.y); w.y = cvt_pk_bf16(v.z, v.w); *(u32x2*)(dp + bj * 128 + 16 * n) = w; }
            }
    }
}
__device__ __forceinline__ void phase_combine(Frame& F, int layer) {
    const LAS int* seg = (const LAS int*)(F.lds + LDS_MISC + 256);
    (void)moe_segments(F, layer);
    const int nrows = (layer == 0) ? T : TLAT;
    const int gw = blockIdx.x * 8 + F.wave, NGW = F.G * 8;
    const unsigned* tokslot = (const unsigned*)(F.ws + WS_TOKSLOT);
    const float* tokw = (const float*)(F.ws + WS_TOKW);
    const bf16_t* DN = (const bf16_t*)(F.ws + WS_DN);
    bf16_t* XH = (bf16_t*)(F.ws + WS_XH);
    for (int row = gw; row < nrows; row += NGW) {
        const unsigned s0 = tokslot[2 * row], s1 = tokslot[2 * row + 1];
        const float w0 = tokw[2 * row], w1 = tokw[2 * row + 1];
        const size_t sl0 = (size_t)seg[s0 >> 24] * 256 + (s0 & 0xffffffu), sl1 = (size_t)seg[s1 >> 24] * 256 + (s1 & 0xffffffu);
        float* xr = xrow_ptr(F, row);
        f32x4 v[4]; row_load(xr, F.lane, v);
        const float* gt2 = mod_ptr(F, layer, row) + 5120;
#pragma unroll
        for (int j = 0; j < 4; ++j) {
            const u32x2 a = ((const u32x2*)(DN + sl0 * D))[F.lane + 64 * j], b = ((const u32x2*)(DN + sl1 * D))[F.lane + 64 * j];
            const f32x4 gv = ((const f32x4*)gt2)[F.lane + 64 * j];
            f32x4 f; f.x = w0 * bf_lo(a.x) + w1 * bf_lo(b.x); f.y = w0 * bf_hi(a.x) + w1 * bf_hi(b.x); f.z = w0 * bf_lo(a.y) + w1 * bf_lo(b.y); f.w = w0 * bf_hi(a.y) + w1 * bf_hi(b.y);
            v[j] = v[j] + gv * f;
        }
        const float rstd = row_rstd(v);
        if (layer == 0) {
#pragma unroll
            for (int j = 0; j < 4; ++j) ((f32x4*)xr)[F.lane + 64 * j] = v[j];
            const float* mp = mod_ptr(F, 1, row);
            row_modulate(v, rstd, F.in[I_G1] + D, mp, mp + 1024, F.lane);
            row_store_bf16(XH + (size_t)row * D, F.lane, v);
        } else {
#pragma unroll
            for (int j = 0; j < 4; ++j) { const f32x4 gg = ((const f32x4*)F.in[I_GF])[F.lane + 64 * j]; ((f32x4*)xr)[F.lane + 64 * j] = v[j] * rstd * gg; }
        }
    }
}

__device__ __forceinline__ const void* opaque_ptr(const void* p) {
    unsigned long long w = (unsigned long long)p; unsigned lo = (unsigned)w, hi = (unsigned)(w >> 32);
    asm volatile("" : "+v"(lo), "+v"(hi));
    lo = __builtin_amdgcn_readfirstlane(lo); hi = __builtin_amdgcn_readfirstlane(hi);
    return (const void*)(((unsigned long long)hi << 32) | lo);
}
constexpr int N_PHASES = 2 + 2 * 9;
__global__ void __launch_bounds__(512, 2) mk_fwd(Args args) {
    extern __shared__ __attribute__((aligned(16))) unsigned char lds_raw[];
    Frame F; F.lds = (LAS unsigned char*)lds_raw; F.tid = threadIdx.x; F.lane = F.tid & 63; F.wave = __builtin_amdgcn_readfirstlane(F.tid >> 6); F.G = gridDim.x;
    static_assert(offsetof(Args, out) == 184 && offsetof(Args, ws) == 192, "kernarg layout");
    F.in = nullptr; F.out = nullptr; F.ws = args.ws;
    const int lo = args.ph_lo, hi = args.ph_hi;
    volatile LAS unsigned* misc = (volatile LAS unsigned*)(F.lds + LDS_MISC);
    if (F.tid < 64) misc[F.tid] = 0u;
    __syncthreads();
    XcdBarrier bar; bar.bar = (unsigned*)(F.ws + WS_CTL) + CW_BAR; bar.x = 0; bar.st = misc;
    if (hi - lo > 1) bar = xcd_barrier_post((unsigned*)(F.ws + WS_CTL) + CW_BAR, misc);
#define IN(k) (lo <= (k) && (k) < hi)
#define SEAM(k) do { if (IN(k) && IN((k) + 1)) { XcdBarrier _b = bar; _b.bar = (unsigned*)opaque_ptr(bar.bar); xcd_barrier(_b); } } while (0)
#define FRESH() do { int _t = threadIdx.x; int _g = gridDim.x; unsigned _l = (unsigned)(uintptr_t)lds_raw; asm volatile("" : "+v"(_t), "+v"(_g), "+v"(_l)); \
        const unsigned char* _ka = (const unsigned char*)opaque_ptr((const void*)__builtin_amdgcn_kernarg_segment_ptr()); \
        F.in = (const float* const*)_ka; F.out = *(float* const*)(_ka + 184); F.ws = *(unsigned char* const*)(_ka + 192); \
        F.G = __builtin_amdgcn_readfirstlane(_g); F.lds = (LAS unsigned char*)(uintptr_t)__builtin_amdgcn_readfirstlane(_l); \
        F.tid = _t; F.lane = _t & 63; F.wave = __builtin_amdgcn_readfirstlane(_t >> 6); } while (0)
    if (IN(0)) { FRESH(); phase_pro(F); } SEAM(0);
    if (IN(1)) { FRESH(); phase_norm1_l0(F); } SEAM(1);
    for (int layer = 0; layer < 2; ++layer) {
        const int pb = 2 + 9 * layer;
        if (IN(pb + 0)) { FRESH(); phase_inproj(F, layer); } SEAM(pb + 0);
        if (IN(pb + 1)) { FRESH(); phase_retkv(F, layer); } SEAM(pb + 1);
        if (IN(pb + 2)) { FRESH(); phase_mixers(F, layer); } SEAM(pb + 2);
        if (IN(pb + 3)) { FRESH(); phase_merge(F, layer); } SEAM(pb + 3);
        if (IN(pb + 4)) { FRESH(); phase_outproj(F, layer); } SEAM(pb + 4);
        if (IN(pb + 5)) { FRESH(); phase_norm2route(F, layer); } SEAM(pb + 5);
        if (IN(pb + 6)) { FRESH(); phase_moeup(F, layer); } SEAM(pb + 6);
        if (IN(pb + 7)) { FRESH(); phase_moedown(F, layer); } SEAM(pb + 7);
        if (IN(pb + 8)) { FRESH(); phase_combine(F, layer); } SEAM(pb + 8);
    }
#undef IN
#undef SEAM
}

extern "C" void kernel_launch(void* const* d_in, const int* in_sizes, int n_in, void* d_out, int out_size, void* d_ws, size_t ws_size, hipStream_t stream) {
    static int grid = 0;
    if (grid == 0) {
        if (n_in != 23 || out_size != TLAT * D || ws_size < WS_END) { fprintf(stderr, "kernel_launch: unexpected shapes (n_in %d out %d ws %zu)\n", n_in, out_size, ws_size); grid = -1; return; }
        int dev = 0, cus = 0;
        if (hipGetDevice(&dev) != hipSuccess || hipDeviceGetAttribute(&cus, hipDeviceAttributeMultiprocessorCount, dev) != hipSuccess) { grid = -1; return; }
        if (hipFuncSetAttribute((const void*)mk_fwd, hipFuncAttributeMaxDynamicSharedMemorySize, LDS_BYTES) != hipSuccess) { fprintf(stderr, "kernel_launch: hipFuncSetAttribute failed\n"); grid = -1; return; }
        int per_cu = 0;
        if (hipOccupancyMaxActiveBlocksPerMultiprocessor(&per_cu, (const void*)mk_fwd, 512, LDS_BYTES) != hipSuccess || per_cu < 1) { fprintf(stderr, "kernel_launch: occupancy query says %d\n", per_cu); }
        (void)hipGetLastError();
        grid = cus;
    }
    if (grid < 0) return;
    (void)hipMemsetAsync((char*)d_ws + WS_CTL, 0, CTL_BYTES, stream);
    Args a{};
    for (int i = 0; i < 23; ++i) a.in[i] = (const float*)d_in[i];
    a.out = (float*)d_out; a.ws = (unsigned char*)d_ws;
#if MK_ONE_LAUNCH
    a.ph_lo = 0; a.ph_hi = N_PHASES;
    hipLaunchKernelGGL(mk_fwd, dim3(grid), dim3(512), LDS_BYTES, stream, a);
#else
    for (int p = 0; p < N_PHASES; ++p) { a.ph_lo = p; a.ph_hi = p + 1; hipLaunchKernelGGL(mk_fwd, dim3(grid), dim3(512), LDS_BYTES, stream, a); }
#endif
}
```

```cpp
#include <hip/hip_runtime.h>
#include <stdint.h>
#include <stdio.h>
#include <math.h>
#include <stddef.h>

#ifndef MK_ONE_LAUNCH
#define MK_ONE_LAUNCH 1
#endif

#define LAS __attribute__((address_space(3)))
typedef unsigned short bf16_t;
typedef short bf16x8 __attribute__((ext_vector_type(8)));
typedef short s16x4 __attribute__((ext_vector_type(4)));
typedef float f32x4 __attribute__((ext_vector_type(4)));
typedef float f32x16 __attribute__((ext_vector_type(16)));
typedef unsigned u32x4 __attribute__((ext_vector_type(4)));
typedef unsigned u32x2 __attribute__((ext_vector_type(2)));

constexpr int D = 1024, NBATCH = 32, SEQ = 2048, CTXL = 256, GRIDW = 64;
constexpr int TLAT = NBATCH * SEQ;
constexpr int TCTX = NBATCH * CTXL;
constexpr int T = TLAT + TCTX;
constexpr int PW = 3072;
constexpr int INW = 7168;
constexpr int NE = 16, DE = 512;
constexpr int SLOTS_MAX = 2 * T + NE * 256;
constexpr int NCHUNK = 18;
constexpr float EPS = 1e-6f;
constexpr float LOG2E = 1.4426950408889634f;
constexpr int C_NAQ = 0, C_NAK = 256, C_NAV = 512, C_RQ = 768, C_RK = 1024, C_RV = 1280, C_RG = 1536, C_GQ = 1792, C_GK = 2048, C_GV = 2176, C_DQ = 2304, C_DK = 2560, C_DV = 2816;

constexpr size_t MiB = 1u << 20;
constexpr size_t WS_CTL = 0, CTL_BYTES = 1 * MiB;
constexpr size_t WS_MOD = 1 * MiB;
constexpr size_t WS_TAB = 3 * MiB;
constexpr size_t WS_TOKLIST = 4 * MiB;
constexpr size_t WS_TOKSLOT = 9 * MiB;
constexpr size_t WS_TOKW = 10 * MiB;
constexpr size_t WS_RETKV = 12 * MiB;
constexpr size_t WS_WIN = 88 * MiB;
constexpr size_t WS_WBR = 116 * MiB;
constexpr size_t WS_WOUT = 120 * MiB;
constexpr size_t WS_WGU = 124 * MiB;
constexpr size_t WS_WD = 188 * MiB;
constexpr size_t WS_X1CTX = 220 * MiB;
constexpr size_t WS_XH = 252 * MiB;
constexpr size_t WS_Y = 396 * MiB;
constexpr size_t WS_P = 540 * MiB;
constexpr size_t WS_U = WS_P;
constexpr size_t WS_DN = WS_P + 148 * MiB;
constexpr size_t WS_END = 988 * MiB;
static_assert((size_t)SLOTS_MAX * DE * 2 <= 148 * MiB && (size_t)SLOTS_MAX * D * 2 <= 296 * MiB, "moe buffers");
constexpr int CW_ECNT = 64;
constexpr int CW_BAR = 4096;
constexpr int TB_R64C = 0, TB_R64S = 1024, TB_R32C = 2048, TB_R32S = 2560, TB_SC = 3072;

constexpr int LDS_BYTES = 147456;
constexpr int LDS_MISC = 145408;
constexpr int HTB = 16384;

__device__ __forceinline__ unsigned cvt_pk_bf16(float lo, float hi) { unsigned r; asm volatile("v_cvt_pk_bf16_f32 %0, %1, %2" : "=v"(r) : "v"(lo), "v"(hi)); return r; }
__device__ __forceinline__ float bf_lo(unsigned u) { return __uint_as_float(u << 16); }
__device__ __forceinline__ float bf_hi(unsigned u) { return __uint_as_float(u & 0xffff0000u); }
__device__ __forceinline__ float bf2f(bf16_t b) { return __uint_as_float(((unsigned)b) << 16); }
__device__ __forceinline__ float wave_sum(float v) {
#pragma unroll
    for (int o = 1; o < 64; o <<= 1) v += __shfl_xor(v, o);
    return v;
}
__device__ __forceinline__ float sigmoidf_(float x) { return 1.0f / (1.0f + __expf(-x)); }
__device__ __forceinline__ float siluf_(float x) { return x / (1.0f + __expf(-x)); }
#define VG(x) asm volatile("" : "+v"(x))
#define WAIT_V(n) asm volatile("s_waitcnt vmcnt(" #n ")" ::: "memory")
#define WAIT_L(n) asm volatile("s_waitcnt lgkmcnt(" #n ")" ::: "memory")
#define BAR() __builtin_amdgcn_s_barrier()
#define SYNC() do { asm volatile("s_waitcnt vmcnt(0) lgkmcnt(0)" ::: "memory"); __builtin_amdgcn_s_barrier(); asm volatile("" ::: "memory"); } while (0)

#define XB_TMO      128
#define XB_XCNT(j)  (256  + 64 * (j))
#define XB_XSUB(j)  (1280 + 64 * (j))
#define XB_XGEN(j)  (2304 + 64 * (j))
#define XB_TOP      3328
#define XB_TOPGEN   3392
#define XCD_BAR_WORDS 3456
#define XB_SPIN_CAP (1u << 18)
__device__ __forceinline__ unsigned xb_ld(unsigned* p)              { return __hip_atomic_load(p, __ATOMIC_RELAXED, __HIP_MEMORY_SCOPE_AGENT); }
__device__ __forceinline__ unsigned xb_add(unsigned* p, unsigned v) { return __hip_atomic_fetch_add(p, v, __ATOMIC_RELAXED, __HIP_MEMORY_SCOPE_AGENT); }
__device__ __forceinline__ unsigned xb_xcc_id() { return (unsigned)__builtin_amdgcn_s_getreg((3 << 11) | 20) & 0xFu; }
#define XB_SPIN(cond, bar) do { unsigned _sp = 0; while (cond) { __builtin_amdgcn_s_sleep(1); \
    if ((++_sp & 255u) == 0u) { if (xb_ld(&(bar)[XB_TMO])) break; if (_sp > XB_SPIN_CAP) { atomicAdd(&(bar)[XB_TMO], 1u); break; } } } } while (0)
struct XcdBarrier { unsigned* bar; unsigned x; volatile LAS unsigned* st; };
__device__ __forceinline__ XcdBarrier xcd_barrier_post(unsigned* bar, volatile LAS unsigned* st) {
    XcdBarrier b; b.bar = bar; b.x = xb_xcc_id(); b.st = st;
    if (threadIdx.x == 0) (void)xb_add(&bar[XB_XCNT(b.x)], 1u);
    return b;
}
__device__ __forceinline__ void xcd_barrier_complete(unsigned* bar, unsigned x, unsigned& nloc, unsigned& nx) {
    const unsigned G = gridDim.x * gridDim.y * gridDim.z;
    unsigned sum, cnt, mine, sp = 0u;
    for (;;) {
        sum = 0u; cnt = 0u; mine = 0u;
#pragma unroll
        for (unsigned j = 0; j < 16; ++j) { const unsigned c = xb_ld(&bar[XB_XCNT(j)]); sum += c; cnt += (c > 0u) ? 1u : 0u; mine = (j == x) ? c : mine; }
        if (sum == G) break;
        __builtin_amdgcn_s_sleep(1);
        if ((++sp & 255u) == 0u) { if (xb_ld(&bar[XB_TMO])) break; if (sp > XB_SPIN_CAP) { atomicAdd(&bar[XB_TMO], 1u); break; } }
    }
    nloc = mine > 0u ? mine : 1u; nx = cnt > 0u ? cnt : 1u;
}
__device__ __forceinline__ void xcd_barrier(const XcdBarrier& b) {
    asm volatile("s_waitcnt vmcnt(0)" ::: "memory");
    __syncthreads();
    if (threadIdx.x == 0) {
        unsigned* bar = b.bar;
        __builtin_amdgcn_s_waitcnt(0);
        unsigned nloc = b.st[0], nx = b.st[1];
        if (nloc == 0u) { xcd_barrier_complete(bar, b.x, nloc, nx); b.st[0] = nloc; b.st[1] = nx; }
        const unsigned old = xb_add(&bar[XB_XSUB(b.x)], 1u);
        const unsigned gen = old / nloc;
        if (old + 1u == (gen + 1u) * nloc) {
            __builtin_amdgcn_fence(__ATOMIC_RELEASE, "agent");
            asm volatile("s_waitcnt vmcnt(0)" ::: "memory");
            const unsigned og = xb_add(&bar[XB_TOP], 1u);
            const unsigned tg = og / nx;
            if (og + 1u == (tg + 1u) * nx) xb_add(&bar[XB_TOPGEN], 1u);
            else XB_SPIN(xb_ld(&bar[XB_TOPGEN]) == tg, bar);
            __builtin_amdgcn_fence(__ATOMIC_ACQUIRE, "agent");
            xb_add(&bar[XB_XGEN(b.x)], 1u);
            asm volatile("s_waitcnt vmcnt(0)" ::: "memory");
        } else {
            XB_SPIN(xb_ld(&bar[XB_XGEN(b.x)]) == gen, bar);
            __builtin_amdgcn_fence(__ATOMIC_ACQUIRE, "agent");
            asm volatile("s_waitcnt vmcnt(0)" ::: "memory");
        }
    }
    __syncthreads();
}

struct Args { const float* in[23]; float* out; unsigned char* ws; int ph_lo, ph_hi; };
struct Frame {
    LAS unsigned char* lds;
    int tid, lane, wave, G;
    const float* const* in; float* out; unsigned char* ws;
};
enum { I_X = 0, I_C, I_CTX, I_CCTX, I_WMOD, I_BMOD, I_G1, I_G2, I_WIN, I_RPB, I_RLD, I_QG, I_KG, I_DLAM, I_DSUB, I_WBR, I_WOUT, I_WR, I_RB, I_WG, I_WU, I_WD, I_GF };

__device__ __forceinline__ int lds_byte(int r, int c) { const int st = (r >> 4) * 2 + (c >> 5), rr = r & 15, cc = c & 31, ob = rr * 64 + cc * 2; return st * 1024 + (ob ^ (((ob >> 9) & 1) << 5)); }
__device__ __forceinline__ void stage_rc(int b, int& R, int& C) { const int st = b / 1024, sb = b % 1024, swz = sb ^ (((sb >> 9) & 1) << 5); R = (st >> 1) * 16 + swz / 64; C = (st & 1) * 32 + (swz % 64) / 2; }

template <int NBH>
__device__ __forceinline__ void gemm_kloop(LAS unsigned char* lds, const char* aBase, const unsigned (&aoff)[2][2], const char* bBase, const unsigned (&boff)[2][2], int nk,
                                           f32x4 (&acc)[2][NBH][4][2], int wid, int aoffl, int boffl) {
    const unsigned ldsw = (unsigned)wid * 1024u;
#define GE_STAGE(buf, kt) do { const unsigned _ko = (unsigned)(kt) * 128u; \
        _Pragma("unroll") for (int _h = 0; _h < 2; ++_h) _Pragma("unroll") for (int _i = 0; _i < 2; ++_i) \
            __builtin_amdgcn_global_load_lds((const unsigned*)(aBase + aoff[_h][_i] + _ko), (LAS unsigned*)(lds + (buf) * 65536 + _h * HTB + ldsw + _i * 8192), 16, 0, 0); \
        _Pragma("unroll") for (int _h = 0; _h < NBH; ++_h) _Pragma("unroll") for (int _i = 0; _i < 2; ++_i) \
            __builtin_amdgcn_global_load_lds((const unsigned*)(bBase + boff[_h][_i] + _ko), (LAS unsigned*)(lds + (buf) * 65536 + 32768 + _h * HTB + ldsw + _i * 8192), 16, 0, 0); } while (0)
    GE_STAGE(0, 0);
#pragma unroll 1
    for (int kt = 0; kt < nk; ++kt) {
        const int buf = kt & 1;
        WAIT_V(0); BAR();
        if (kt + 1 < nk) GE_STAGE(buf ^ 1, kt + 1);
        const LAS unsigned char* la = lds + buf * 65536 + aoffl;
        const LAS unsigned char* lb = lds + buf * 65536 + 32768 + boffl;
        bf16x8 Bf[NBH][2][2];
#pragma unroll
        for (int bj = 0; bj < NBH; ++bj)
#pragma unroll
            for (int n = 0; n < 2; ++n)
#pragma unroll
                for (int k = 0; k < 2; ++k) Bf[bj][n][k] = *(const LAS bf16x8*)(lb + bj * HTB + n * 2048 + k * 1024);
#pragma unroll
        for (int ai = 0; ai < 2; ++ai)
#pragma unroll
            for (int mh = 0; mh < 2; ++mh) {
                bf16x8 Af[2][2];
#pragma unroll
                for (int mm = 0; mm < 2; ++mm)
#pragma unroll
                    for (int k = 0; k < 2; ++k) Af[mm][k] = *(const LAS bf16x8*)(la + ai * HTB + (2 * mh + mm) * 2048 + k * 1024);
#pragma unroll
                for (int bj = 0; bj < NBH; ++bj)
#pragma unroll
                    for (int mm = 0; mm < 2; ++mm)
#pragma unroll
                        for (int n = 0; n < 2; ++n)
#pragma unroll
                            for (int k = 0; k < 2; ++k)
                                acc[ai][bj][2 * mh + mm][n] = __builtin_amdgcn_mfma_f32_16x16x32_bf16(Bf[bj][n][k], Af[mm][k], acc[ai][bj][2 * mh + mm][n], 0, 0, 0);
            }
    }
    WAIT_L(0); BAR();
#undef GE_STAGE
}
template <int NBH> __device__ __forceinline__ void acc_zero(f32x4 (&acc)[2][NBH][4][2]) {
#pragma unroll
    for (int a = 0; a < 2; ++a)
#pragma unroll
        for (int b = 0; b < NBH; ++b)
#pragma unroll
            for (int m = 0; m < 4; ++m)
#pragma unroll
                for (int n = 0; n < 2; ++n) acc[a][b][m][n] = (f32x4){0.f, 0.f, 0.f, 0.f};
}
struct GeoT { int wid, lane, wr, wc, fr, fq, aoffl, boffl; int R[2], C[2]; };
__device__ __forceinline__ GeoT make_geo() {
    GeoT g; int tid = threadIdx.x; asm volatile("" : "+v"(tid)); g.wid = __builtin_amdgcn_readfirstlane(tid >> 6); g.lane = tid & 63; g.wr = g.wid >> 2; g.wc = g.wid & 3; g.fr = g.lane & 15; g.fq = g.lane >> 4;
    g.aoffl = lds_byte(g.wr * 64 + g.fr, g.fq * 8); g.boffl = lds_byte(g.wc * 32 + g.fr, g.fq * 8);
#pragma unroll
    for (int i = 0; i < 2; ++i) stage_rc(tid * 16 + i * 8192, g.R[i], g.C[i]);
    return g;
}
__device__ __forceinline__ void rows_contig(unsigned (&off)[2][2], const GeoT& g, int row0, unsigned pitch_bytes) {
#pragma unroll
    for (int h = 0; h < 2; ++h)
#pragma unroll
        for (int i = 0; i < 2; ++i) off[h][i] = (unsigned)(row0 + 128 * h + g.R[i]) * pitch_bytes + (unsigned)g.C[i] * 2u;
}

__device__ __forceinline__ void tr_item(const float* W, int N, bf16_t* WT, int Kd, int k0, int n0, int mode, LAS float* scr, int lane) {
#pragma unroll 8
    for (int i = 0; i < 32; ++i) { const int kk = 2 * i + (lane >> 5); scr[kk * 33 + (lane & 31)] = W[(size_t)(k0 + kk) * N + n0 + (lane & 31)]; }
    WAIT_L(0); asm volatile("" ::: "memory");
    const int c = lane & 7;
#pragma unroll
    for (int j = 0; j < 4; ++j) {
        const int nl = (lane >> 3) + 8 * j; const LAS float* s = scr + (8 * c) * 33 + nl;
        u32x4 o; o.x = cvt_pk_bf16(s[0 * 33], s[1 * 33]); o.y = cvt_pk_bf16(s[2 * 33], s[3 * 33]); o.z = cvt_pk_bf16(s[4 * 33], s[5 * 33]); o.w = cvt_pk_bf16(s[6 * 33], s[7 * 33]);
        const int n = n0 + nl;
        const int drow = (mode == 0) ? n : (256 * (n >> 7) + (n & 127) + (mode == 2 ? 128 : 0));
        *(u32x4*)(WT + (size_t)drow * Kd + k0 + 8 * c) = o;
    }
    WAIT_L(0); asm volatile("" ::: "memory");
}
__device__ __forceinline__ void mod_unit(Frame& F, int u) {
    const int l = u / 96, cb = u % 96;
    LAS float* sl = (LAS float*)F.lds;
    const float* c = F.in[I_C]; const float* cc = F.in[I_CCTX];
    for (int idx = F.tid; idx < 33 * 1024; idx += 512) { const int r = idx >> 10, k = idx & 1023; const float cv = (r < 32) ? c[r * 1024 + k] : cc[k]; sl[idx] = cv / (1.0f + expf(-cv)); }
    SYNC();
    float acc[33];
#pragma unroll
    for (int r = 0; r < 33; ++r) acc[r] = 0.f;
    const float* W = F.in[I_WMOD] + (size_t)l * 1024 * 6144 + 64 * cb + F.lane;
    const int kb = F.wave * 128;
#pragma unroll 4
    for (int k = 0; k < 128; ++k) {
        const float wv = W[(size_t)(kb + k) * 6144];
#pragma unroll
        for (int r = 0; r < 33; ++r) acc[r] += sl[r * 1024 + kb + k] * wv;
    }
    SYNC();
#pragma unroll
    for (int r = 0; r < 33; ++r) sl[(F.wave * 33 + r) * 64 + F.lane] = acc[r];
    SYNC();
    float* MOD = (float*)(F.ws + WS_MOD);
    for (int idx = F.tid; idx < 33 * 64; idx += 512) {
        const int r = idx >> 6, cl = idx & 63; float s = 0.f;
#pragma unroll
        for (int w = 0; w < 8; ++w) s += sl[(w * 33 + r) * 64 + cl];
        MOD[(size_t)(l * 33 + r) * 6144 + 64 * cb + cl] = s + F.in[I_BMOD][l * 6144 + 64 * cb + cl];
    }
    SYNC();
}
__device__ __forceinline__ void phase_pro(Frame& F) {
    for (int u = blockIdx.x; u < 192; u += F.G) mod_unit(F, u);
    if (blockIdx.x == F.G - 1) {
        float* TB = (float*)(F.ws + WS_TAB);
        for (int idx = F.tid; idx < 1024; idx += 512) { const int pos = idx >> 4, i = idx & 15; const float inv = 1.0f / powf(10000.0f, (float)i / 16.0f); const float a = (float)pos * inv; TB[TB_R64C + idx] = cosf(a); TB[TB_R64S + idx] = sinf(a); }
        for (int idx = F.tid; idx < 512; idx += 512) { const int pos = idx >> 3, i = idx & 7; const float inv = 1.0f / powf(10000.0f, (float)i / 8.0f); const float a = (float)pos * inv; TB[TB_R32C + idx] = cosf(a); TB[TB_R32S + idx] = sinf(a); }
        if (F.tid < 2) {
            const int l = F.tid; const float* lp = F.in[I_DLAM] + l * 128; float s1 = 0.f, s2 = 0.f;
            for (int i = 0; i < 32; ++i) { s1 += lp[i] * lp[32 + i]; s2 += lp[64 + i] * lp[96 + i]; }
            const float lam_init = 0.8f - 0.6f * expf(-0.3f * (float)l);
            float* sc = TB + TB_SC + 16 * l;
            sc[0] = expf(s1) - expf(s2) + lam_init; sc[1] = 1.0f - lam_init;
            for (int d = 0; d < 2; ++d) for (int h = 0; h < 4; ++h) sc[2 + 4 * d + h] = log1pf(-expf(F.in[I_RLD][l * 8 + d * 4 + h])) * LOG2E;
        }
    }
    LAS float* scr = (LAS float*)(F.lds + F.wave * 16384);
    const int gw = blockIdx.x * 8 + F.wave, NGW = F.G * 8;
    constexpr int I_IN = 16 * 224, I_BRN = 4 * 32, I_OUT = 16 * 32, I_GE = 16 * 16, I_DE = 8 * 32;
    constexpr int PER_LAYER = I_IN + 4 * I_BRN + I_OUT + 16 * (2 * I_GE + I_DE);
    for (int it = gw; it < 2 * PER_LAYER; it += NGW) {
        const int l = it / PER_LAYER; int r = it % PER_LAYER;
        if (r < I_IN) { tr_item(F.in[I_WIN] + (size_t)l * 1024 * INW, INW, (bf16_t*)(F.ws + WS_WIN) + (size_t)l * INW * 1024, 1024, 64 * (r / 224), 32 * (r % 224), 0, scr, F.lane); continue; } r -= I_IN;
        if (r < 4 * I_BRN) { const int n = r / I_BRN; r %= I_BRN; tr_item(F.in[I_WBR] + (size_t)(l * 4 + n) * 256 * 1024, 1024, (bf16_t*)(F.ws + WS_WBR) + (size_t)(l * 4 + n) * 1024 * 256, 256, 64 * (r / 32), 32 * (r % 32), 0, scr, F.lane); continue; } r -= 4 * I_BRN;
        if (r < I_OUT) { tr_item(F.in[I_WOUT] + (size_t)l * 1024 * 1024, 1024, (bf16_t*)(F.ws + WS_WOUT) + (size_t)l * 1024 * 1024, 1024, 64 * (r / 32), 32 * (r % 32), 0, scr, F.lane); continue; } r -= I_OUT;
        const int e = r / (2 * I_GE + I_DE); r %= (2 * I_GE + I_DE);
        const size_t le = (size_t)(l * 16 + e);
        if (r < I_GE) { tr_item(F.in[I_WG] + le * 1024 * 512, 512, (bf16_t*)(F.ws + WS_WGU) + le * 1024 * 1024, 1024, 64 * (r / 16), 32 * (r % 16), 1, scr, F.lane); continue; } r -= I_GE;
        if (r < I_GE) { tr_item(F.in[I_WU] + le * 1024 * 512, 512, (bf16_t*)(F.ws + WS_WGU) + le * 1024 * 1024, 1024, 64 * (r / 16), 32 * (r % 16), 2, scr, F.lane); continue; } r -= I_GE;
        tr_item(F.in[I_WD] + le * 512 * 1024, 1024, (bf16_t*)(F.ws + WS_WD) + le * 1024 * 512, 512, 64 * (r / 32), 32 * (r % 32), 0, scr, F.lane);
    }
}

__device__ __forceinline__ void row_load(const float* xrow, int lane, f32x4 (&v)[4]) {
    const f32x4* xr = (const f32x4*)xrow + lane;
#pragma unroll
    for (int j = 0; j < 4; ++j) v[j] = xr[64 * j];
}
__device__ __forceinline__ float row_rstd(const f32x4 (&v)[4]) {
    float s = 0.f;
#pragma unroll
    for (int j = 0; j < 4; ++j) s += (v[j].x * v[j].x + v[j].y * v[j].y) + (v[j].z * v[j].z + v[j].w * v[j].w);
    return 1.0f / sqrtf(wave_sum(s) * (1.0f / D) + EPS);
}
__device__ __forceinline__ void row_modulate(f32x4 (&v)[4], float rstd, const float* g, const float* shift, const float* scale, int lane) {
#pragma unroll
    for (int j = 0; j < 4; ++j) {
        const f32x4 gg = ((const f32x4*)g)[lane + 64 * j], sh = ((const f32x4*)shift)[lane + 64 * j], sc = ((const f32x4*)scale)[lane + 64 * j];
        v[j] = v[j] * rstd * gg * (sc + 1.0f) + sh;
    }
}
__device__ __forceinline__ void row_store_bf16(bf16_t* orow, int lane, const f32x4 (&v)[4]) {
    u32x2* o8 = (u32x2*)orow + lane;
#pragma unroll
    for (int j = 0; j < 4; ++j) { u32x2 w; w.x = cvt_pk_bf16(v[j].x, v[j].y); w.y = cvt_pk_bf16(v[j].z, v[j].w); o8[64 * j] = w; }
}
__device__ __forceinline__ const float* mod_ptr(Frame& F, int layer, int row) {
    const int b = (row < TLAT) ? (row >> 11) : 32;
    return (const float*)(F.ws + WS_MOD) + (size_t)(layer * 33 + b) * 6144;
}
__device__ __forceinline__ void phase_norm1_l0(Frame& F) {
    const int gw = blockIdx.x * 8 + F.wave, NGW = F.G * 8;
    bf16_t* XH = (bf16_t*)(F.ws + WS_XH);
    for (int row = gw; row < T; row += NGW) {
        const float* xrow = (row < TLAT) ? F.in[I_X] + (size_t)row * D : F.in[I_CTX] + (size_t)(row - TLAT) * D;
        f32x4 v[4]; row_load(xrow, F.lane, v);
        const float rstd = row_rstd(v);
        const float* mp = mod_ptr(F, 0, row);
        row_modulate(v, rstd, F.in[I_G1], mp, mp + 1024, F.lane);
        row_store_bf16(XH + (size_t)row * D, F.lane, v);
    }
}

__device__ __forceinline__ void epi_inproj(Frame& F, const f32x4 (&acc)[2][2][4][2], const GeoT& g, int pm, int pn, int layer) {
    bf16_t* P = (bf16_t*)(F.ws + WS_P);
    const float* TB = (const float*)(F.ws + WS_TAB);
    const bool lat = pm < 256;
    int mode = 0; float scale = 1.0f; const float* gain = nullptr;
    switch (pn) {
        case 0: scale = 0.125f * LOG2E; break;
        case 3: mode = 2; break;
        case 4: mode = 2; scale = 0.125f; break;
        case 6: mode = 4; break;
        case 7: mode = 5; scale = 0.125f * LOG2E; gain = F.in[I_QG] + layer * 64; break;
        case 8: if (g.wc < 2) { mode = 5; gain = F.in[I_KG] + layer * 64; } break;
        case 9: mode = 7; scale = 0.17677669529663687f * LOG2E; break;
        case 10: mode = 7; break;
        default: break;
    }
#pragma unroll
    for (int ai = 0; ai < 2; ++ai)
#pragma unroll
        for (int m = 0; m < 4; ++m) {
            const int row = pm * 256 + ai * 128 + g.wr * 64 + m * 16 + g.fr;
            const int t = row & 2047, gr = t >> 6, gc = t & 63;
            float v[2][2][4];
#pragma unroll
            for (int bj = 0; bj < 2; ++bj)
#pragma unroll
                for (int n = 0; n < 2; ++n)
#pragma unroll
                    for (int j = 0; j < 4; ++j) v[bj][n][j] = acc[ai][bj][m][n][j];
            if (mode == 5) {
                float ss = 0.f;
#pragma unroll
                for (int bj = 0; bj < 2; ++bj)
#pragma unroll
                    for (int n = 0; n < 2; ++n)
#pragma unroll
                        for (int j = 0; j < 4; ++j) ss += v[bj][n][j] * v[bj][n][j];
                ss += __shfl_xor(ss, 16); ss += __shfl_xor(ss, 32);
                const float r = 1.0f / sqrtf(ss * (1.0f / 64.0f) + EPS);
#pragma unroll
                for (int bj = 0; bj < 2; ++bj)
#pragma unroll
                    for (int n = 0; n < 2; ++n) { const f32x4 gg = *(const f32x4*)(gain + 32 * bj + 16 * n + 4 * g.fq);
#pragma unroll
                        for (int j = 0; j < 4; ++j) v[bj][n][j] = v[bj][n][j] * r * gg[j]; }
            }
            if ((mode == 2 || mode == 5) && lat) {
#pragma unroll
                for (int bj = 0; bj < 2; ++bj) {
                    const int pos = bj ? gc : gr;
                    const f32x4 cs = *(const f32x4*)(TB + TB_R64C + pos * 16 + 4 * g.fq), sn = *(const f32x4*)(TB + TB_R64S + pos * 16 + 4 * g.fq);
#pragma unroll
                    for (int j = 0; j < 4; ++j) { const float x1 = v[bj][0][j], x2 = v[bj][1][j]; v[bj][0][j] = x1 * cs[j] - x2 * sn[j]; v[bj][1][j] = x2 * cs[j] + x1 * sn[j]; }
                }
            }
            if (mode == 7) {
#pragma unroll
                for (int bj = 0; bj < 2; ++bj)
#pragma unroll
                    for (int n = 0; n < 2; ++n) {
                        const int pos = n ? gc : gr;
                        const f32x4 cs = *(const f32x4*)(TB + TB_R32C + pos * 8 + 4 * (g.fq & 1)), sn = *(const f32x4*)(TB + TB_R32S + pos * 8 + 4 * (g.fq & 1));
#pragma unroll
                        for (int j = 0; j < 4; ++j) {
                            const float xs = v[bj][n][j], xo = __shfl_xor(xs, 32);
                            const float rot = (g.fq >> 1) ? (xs * cs[j] + xo * sn[j]) : (xs * cs[j] - xo * sn[j]);
                            v[bj][n][j] = lat ? rot : xs;
                        }
                    }
            }
            bf16_t* prow = P + (size_t)row * PW + pn * 256 + g.wc * 64 + 4 * g.fq;
#pragma unroll
            for (int bj = 0; bj < 2; ++bj)
#pragma unroll
                for (int n = 0; n < 2; ++n) {
                    float o[4];
#pragma unroll
                    for (int j = 0; j < 4; ++j) { float x = v[bj][n][j] * scale; if (mode == 4) x = siluf_(x); o[j] = x; }
                    u32x2 w; w.x = cvt_pk_bf16(o[0], o[1]); w.y = cvt_pk_bf16(o[2], o[3]);
                    *(u32x2*)(prow + 32 * bj + 16 * n) = w;
                }
        }
}
__device__ __forceinline__ void phase_inproj(Frame& F, int layer) {
    const GeoT g = make_geo();
    const char* A = (const char*)(F.ws + WS_XH);
    const char* B = (const char*)(F.ws + WS_WIN) + (size_t)layer * INW * 1024 * 2;
    constexpr int NUN = (T / 256) * 12;
    for (int u = blockIdx.x; u < NUN; u += F.G) {
        const int pm = u / 12, pn = u % 12;
        unsigned aoff[2][2], boff[2][2];
        rows_contig(aoff, g, pm * 256, 2048u);
#pragma unroll
        for (int h = 0; h < 2; ++h)
#pragma unroll
            for (int i = 0; i < 2; ++i) { const int rho = g.R[i]; const int col = 256 * pn + 64 * (rho >> 5) + 32 * h + (rho & 31); boff[h][i] = (unsigned)col * 2048u + (unsigned)g.C[i] * 2u; }
        f32x4 acc[2][2][4][2]; acc_zero<2>(acc);
        gemm_kloop<2>(F.lds, A, aoff, B, boff, 16, acc, g.wid, g.aoffl, g.boffl);
        epi_inproj(F, acc, g, pm, pn, layer);
    }
}

constexpr int AL_K = 0, AL_V = 16384, AL_WSF = 32768, AL_OST = 36864, AL_TAB = 102400;
typedef short v4i16_t __attribute__((ext_vector_type(4)));
__device__ __forceinline__ int crow(int r, int hi) { return (r & 3) + 8 * (r >> 2) + 4 * hi; }
__device__ __forceinline__ f32x16 mfma32(bf16x8 a, bf16x8 b, f32x16 c) { return __builtin_amdgcn_mfma_f32_32x32x16_bf16(a, b, c, 0, 0, 0); }
__device__ __forceinline__ s16x4 vtr(const LAS unsigned char* p) { return __builtin_bit_cast(s16x4, __builtin_amdgcn_ds_read_tr16_b64_v4i16((LAS v4i16_t*)p)); }
__device__ __forceinline__ f32x16 f16zero() { f32x16 z;
#pragma unroll
    for (int r = 0; r < 16; ++r) z[r] = 0.f;
    return z; }

template <int D0LO, int D0HI>
__device__ __forceinline__ void qk_tile(f32x16& p0, f32x16& p1, const LAS unsigned char* Kb, const bf16x8 (&qr)[4], int r32, int hi) {
    const LAS unsigned char* kb = Kb + hi * 1024 + r32 * 16;
    p0 = f16zero(); p1 = f16zero();
#pragma unroll
    for (int d0 = D0LO; d0 < D0HI; ++d0) {
        const bf16x8 b0 = *(const LAS bf16x8*)(kb + d0 * 2048), b1 = *(const LAS bf16x8*)(kb + d0 * 2048 + 512);
        p0 = mfma32(b0, qr[d0], p0); p1 = mfma32(b1, qr[d0], p1);
    }
}
__device__ __forceinline__ float sm_tile(f32x16& p0, f32x16& p1, float& m, float& l) {
    float mx = fmaxf(p0[0], p1[0]);
#pragma unroll
    for (int r = 1; r < 16; ++r) mx = fmaxf(mx, fmaxf(p0[r], p1[r]));
    mx = fmaxf(mx, __shfl_xor(mx, 32));
    const float mn = fmaxf(m, mx), alpha = __builtin_amdgcn_exp2f(m - mn);
    m = mn; float s = 0.f;
#pragma unroll
    for (int r = 0; r < 16; ++r) { p0[r] = __builtin_amdgcn_exp2f(p0[r] - mn); p1[r] = __builtin_amdgcn_exp2f(p1[r] - mn); s += p0[r] + p1[r]; }
    l = l * alpha + s;
    return alpha;
}
__device__ __forceinline__ void o_scale(f32x16 (&o)[2], float f, LAS float* wsf, int r32, int hi) {
    asm volatile("" ::: "memory");
    if (hi == 0) wsf[r32] = f;
    asm volatile("s_waitcnt lgkmcnt(0)" ::: "memory");
#pragma unroll
    for (int r = 0; r < 16; ++r) { const float g = wsf[crow(r, hi)]; o[0][r] *= g; o[1][r] *= g; }
    asm volatile("s_waitcnt lgkmcnt(0)" ::: "memory");
}
__device__ __forceinline__ void pack_p(const f32x16& p0, const f32x16& p1, bf16x8 (&pw)[4]) {
    u32x4 w;
    w.x = cvt_pk_bf16(p0[0], p0[1]); w.y = cvt_pk_bf16(p0[2], p0[3]); w.z = cvt_pk_bf16(p0[4], p0[5]); w.w = cvt_pk_bf16(p0[6], p0[7]); pw[0] = __builtin_bit_cast(bf16x8, w);
    w.x = cvt_pk_bf16(p0[8], p0[9]); w.y = cvt_pk_bf16(p0[10], p0[11]); w.z = cvt_pk_bf16(p0[12], p0[13]); w.w = cvt_pk_bf16(p0[14], p0[15]); pw[1] = __builtin_bit_cast(bf16x8, w);
    w.x = cvt_pk_bf16(p1[0], p1[1]); w.y = cvt_pk_bf16(p1[2], p1[3]); w.z = cvt_pk_bf16(p1[4], p1[5]); w.w = cvt_pk_bf16(p1[6], p1[7]); pw[2] = __builtin_bit_cast(bf16x8, w);
    w.x = cvt_pk_bf16(p1[8], p1[9]); w.y = cvt_pk_bf16(p1[10], p1[11]); w.z = cvt_pk_bf16(p1[12], p1[13]); w.w = cvt_pk_bf16(p1[14], p1[15]); pw[3] = __builtin_bit_cast(bf16x8, w);
}
__device__ __forceinline__ void pv_tile(f32x16 (&o)[2], const LAS unsigned char* Vb, const bf16x8 (&pw)[4], int lane, int hi) {
    const LAS unsigned char* vp = Vb + ((lane >> 4) & 1) * 32 + (lane & 3) * 8 + (4 * hi + ((lane & 15) >> 2)) * 64;
#pragma unroll
    for (int d0 = 0; d0 < 2; ++d0)
#pragma unroll
        for (int ks = 0; ks < 4; ++ks) {
            const s16x4 lo = vtr(vp + d0 * 4096 + ks * 1024), hh = vtr(vp + d0 * 4096 + ks * 1024 + 512);
            const bf16x8 vf = (bf16x8){lo[0], lo[1], lo[2], lo[3], hh[0], hh[1], hh[2], hh[3]};
            o[d0] = mfma32(pw[ks], vf, o[d0]);
        }
}
__device__ __forceinline__ void o_stage(const f32x16 (&o)[2], LAS float* ost, int r32, int hi) {
#pragma unroll
    for (int r = 0; r < 16; ++r) { const int q = crow(r, hi); ost[q * 64 + r32] = o[0][r]; ost[q * 64 + 32 + r32] = o[1][r]; }
    asm volatile("s_waitcnt lgkmcnt(0)" ::: "memory");
}
__device__ __forceinline__ void stage_row_read(const LAS float* ost, int lane, float (&x)[32]) {
    const LAS f32x4* s = (const LAS f32x4*)(ost + (lane >> 1) * 64 + (lane & 1) * 32);
#pragma unroll
    for (int i = 0; i < 8; ++i) { const f32x4 v = s[i]; x[4 * i] = v.x; x[4 * i + 1] = v.y; x[4 * i + 2] = v.z; x[4 * i + 3] = v.w; }
    asm volatile("s_waitcnt lgkmcnt(0)" ::: "memory");
}
__device__ __forceinline__ void store_row32(bf16_t* dst, const float (&x)[32]) {
#pragma unroll
    for (int i = 0; i < 4; ++i) { u32x4 w; w.x = cvt_pk_bf16(x[8 * i], x[8 * i + 1]); w.y = cvt_pk_bf16(x[8 * i + 2], x[8 * i + 3]); w.z = cvt_pk_bf16(x[8 * i + 4], x[8 * i + 5]); w.w = cvt_pk_bf16(x[8 * i + 6], x[8 * i + 7]); ((u32x4*)dst)[i] = w; }
}

struct SmUnit {
    int qrow, qcol, kcol, vcol, ycol;
    int n1, row1, n2, row2;
    int na_r, na_c, na_kr0;
};
#define AT_LOADKV(t) do { const int _r0 = ((t) < U.n1) ? U.row1 + 64 * (t) : U.row2 + 64 * ((t) - U.n1); \
        kreg = *(const u32x4*)(Pb + (size_t)(_r0 + lane) * (PW * 2) + (U.kcol + 8 * wid) * 2); \
        vreg = *(const u32x4*)(Pb + (size_t)(_r0 + 16 * (wid & 3) + (lane >> 2)) * (PW * 2) + (U.vcol + 32 * (wid >> 2) + 8 * (lane & 3)) * 2); } while (0)
#define AT_COMMIT(buf) do { *(LAS u32x4*)(lds + AL_K + (buf) * 8192 + wid * 1024 + lane * 16) = kreg; *(LAS u32x4*)(lds + AL_V + (buf) * 8192 + wid * 1024 + lane * 16) = vreg; } while (0)

template <bool NA>
__device__ __forceinline__ void sm_unit(Frame& F, const SmUnit& U_) {
    SmUnit U = U_; VG(U.qcol); VG(U.kcol); VG(U.vcol); VG(U.ycol); VG(U.row1); VG(U.row2);
    const char* Pb = (const char*)(F.ws + WS_P);
    LAS unsigned char* lds = F.lds;
    const int lane = F.lane, r32 = lane & 31, hi = lane >> 5, wid = F.wave;
    bf16x8 qr[4];
    { const char* qp = Pb + (size_t)U.qrow * (PW * 2) + (U.qcol + 8 * hi) * 2;
#pragma unroll
      for (int d0 = 0; d0 < 4; ++d0) qr[d0] = *(const bf16x8*)(qp + d0 * 32); }
    const int NT = U.n1 + U.n2;
    u32x4 kreg, vreg;
    AT_LOADKV(0); AT_COMMIT(0); SYNC();
    float m = -1e30f, l = 0.f; f32x16 o[2]; o[0] = f16zero(); o[1] = f16zero();
    LAS float* wsf = (LAS float*)(lds + AL_WSF) + wid * 128;
    const LAS float* tab = (const LAS float*)(lds + AL_TAB);
    const int na_r0 = min(max(U.na_r - 4, 0), 24), na_ws = min(max(U.na_c - 8, 0), 48);
    for (int t = 0; t < NT; ++t) {
        const int buf = t & 1;
        if (t + 1 < NT) AT_LOADKV(t + 1);
        bool active = true; int kr = 0;
        if (NA && t >= U.n1) { kr = U.na_kr0 + (t - U.n1); active = (kr >= na_r0) && (kr < na_r0 + 8); }
        if (active) {
            f32x16 p0, p1; qk_tile<0, 4>(p0, p1, lds + AL_K + buf * 8192, qr, r32, hi);
            if (NA && t >= U.n1) {
                const LAS float* trow = tab + (kr - U.na_r + 7) * 31 + 15 - U.na_c;
#pragma unroll
                for (int r = 0; r < 16; ++r) {
                    const int kc0 = crow(r, hi), kc1 = kc0 + 32;
                    const bool v0 = (unsigned)(kc0 - na_ws) < 16u, v1 = (unsigned)(kc1 - na_ws) < 16u;
                    const float b0 = trow[v0 ? kc0 : U.na_c], b1 = trow[v1 ? kc1 : U.na_c];
                    p0[r] = v0 ? p0[r] + b0 : -1e30f; p1[r] = v1 ? p1[r] + b1 : -1e30f;
                }
            }
            const float alpha = sm_tile(p0, p1, m, l);
            o_scale(o, alpha, wsf, r32, hi);
            bf16x8 pw[4]; pack_p(p0, p1, pw);
            pv_tile(o, lds + AL_V + buf * 8192, pw, lane, hi);
        }
        if (t + 1 < NT) AT_COMMIT(buf ^ 1);
        SYNC();
    }
    l += __shfl_xor(l, 32);
    o_scale(o, 1.0f / l, wsf, r32, hi);
    LAS float* ost = (LAS float*)(lds + AL_OST) + wid * 2048;
    o_stage(o, ost, r32, hi);
    float x[32]; stage_row_read(ost, lane, x);
    const int trow_q = __shfl(U.qrow, lane >> 1);
    store_row32((bf16_t*)(F.ws + WS_Y) + (size_t)trow_q * D + U.ycol + 32 * (lane & 1), x);
}

__device__ __forceinline__ void diff_unit(Frame& F, const SmUnit& U_, int layer) {
    SmUnit U = U_; VG(U.qcol); VG(U.kcol); VG(U.vcol); VG(U.ycol); VG(U.row1); VG(U.row2);
    const char* Pb = (const char*)(F.ws + WS_P);
    LAS unsigned char* lds = F.lds;
    const int lane = F.lane, r32 = lane & 31, hi = lane >> 5, wid = F.wave;
    bf16x8 qr[4];
    { const char* qp = Pb + (size_t)U.qrow * (PW * 2) + (U.qcol + 8 * hi) * 2;
#pragma unroll
      for (int d0 = 0; d0 < 4; ++d0) qr[d0] = *(const bf16x8*)(qp + d0 * 32); }
    const int NT = U.n1 + U.n2;
    u32x4 kreg, vreg;
    AT_LOADKV(0); AT_COMMIT(0); SYNC();
    float m0 = -1e30f, l0 = 0.f, m1 = -1e30f, l1 = 0.f; f32x16 oa[2], ob[2]; oa[0] = f16zero(); oa[1] = f16zero(); ob[0] = f16zero(); ob[1] = f16zero();
    LAS float* wsf = (LAS float*)(lds + AL_WSF) + wid * 128;
    for (int t = 0; t < NT; ++t) {
        const int buf = t & 1;
        if (t + 1 < NT) AT_LOADKV(t + 1);
        {
            f32x16 p0, p1; bf16x8 pw[4];
            qk_tile<0, 2>(p0, p1, lds + AL_K + buf * 8192, qr, r32, hi);
            float alpha = sm_tile(p0, p1, m0, l0);
            o_scale(oa, alpha, wsf, r32, hi);
            pack_p(p0, p1, pw);
            pv_tile(oa, lds + AL_V + buf * 8192, pw, lane, hi);
            qk_tile<2, 4>(p0, p1, lds + AL_K + buf * 8192, qr, r32, hi);
            alpha = sm_tile(p0, p1, m1, l1);
            o_scale(ob, alpha, wsf, r32, hi);
            pack_p(p0, p1, pw);
            pv_tile(ob, lds + AL_V + buf * 8192, pw, lane, hi);
        }
        if (t + 1 < NT) AT_COMMIT(buf ^ 1);
        SYNC();
    }
    const float* SC = (const float*)(F.ws + WS_TAB) + TB_SC + 16 * layer;
    const float lam = SC[0], post = SC[1];
    l0 += __shfl_xor(l0, 32); l1 += __shfl_xor(l1, 32);
    o_scale(oa, 1.0f / l0, wsf, r32, hi);
    o_scale(ob, -lam / l1, wsf, r32, hi);
#pragma unroll
    for (int r = 0; r < 16; ++r) { oa[0][r] += ob[0][r]; oa[1][r] += ob[1][r]; }
    LAS float* ost = (LAS float*)(lds + AL_OST) + wid * 2048;
    o_stage(oa, ost, r32, hi);
    float x[32]; stage_row_read(ost, lane, x);
    float ss = 0.f;
#pragma unroll
    for (int i = 0; i < 32; ++i) ss += x[i] * x[i];
    ss += __shfl_xor(ss, 1);
    const float rn = post / sqrtf(ss * (1.0f / 64.0f) + EPS);
    const float* gain = F.in[I_DSUB] + layer * 64 + 32 * (lane & 1);
#pragma unroll
    for (int i = 0; i < 32; ++i) x[i] = x[i] * rn * gain[i];
    const int trow_q = __shfl(U.qrow, lane >> 1);
    store_row32((bf16_t*)(F.ws + WS_Y) + (size_t)trow_q * D + U.ycol + 32 * (lane & 1), x);
}

__device__ __forceinline__ int ret_chunk_row(int b, int ci) { return (ci < 2) ? TLAT + b * 256 + 128 * ci : b * 2048 + 128 * (ci - 2); }
__device__ __forceinline__ int ret_bpos(int ci) { return ci == 0 ? 1 : (ci == 1 ? 0 : 19 - ci); }
__device__ __forceinline__ void ret_unit(Frame& F, int layer, int b, int h, int cp) {
    const char* Pb = (const char*)(F.ws + WS_P);
    LAS unsigned char* lds = F.lds;
    const int lane = F.lane, r32 = lane & 31, hi = lane >> 5, wid = F.wave;
    const float* SC = (const float*)(F.ws + WS_TAB) + TB_SC + 16 * layer;
    const float lgf = SC[2 + h], lgb = SC[6 + h];
    const int ccw = wid >> 2, ciw = 2 * cp + ccw, tq = 32 * (wid & 3) + r32;
    const int qrow = ret_chunk_row(b, ciw) + tq;
    bf16x8 qr[4];
    { const char* qp = Pb + (size_t)qrow * (PW * 2) + (C_RQ + 64 * h + 8 * hi) * 2;
#pragma unroll
      for (int d0 = 0; d0 < 4; ++d0) qr[d0] = *(const bf16x8*)(qp + d0 * 32); }
    const float* KV = (const float*)(F.ws + WS_RETKV) + (size_t)((b * 4 + h) * NCHUNK) * 2 * 4096;
    u32x4 kreg, vreg;
    const int sd = 16 * (wid & 3) + (lane >> 2), se = 32 * (wid >> 2) + 8 * (lane & 3);
#define RT_LOAD(t) do { const int _cc = (t) >> 2, _kind = (t) & 3, _c2 = 2 * cp + _cc; \
        if (_kind < 2) { const int _r0 = ret_chunk_row(b, _c2) + 64 * _kind; \
            kreg = *(const u32x4*)(Pb + (size_t)(_r0 + lane) * (PW * 2) + (C_RK + 64 * h + 8 * wid) * 2); \
            vreg = *(const u32x4*)(Pb + (size_t)(_r0 + sd) * (PW * 2) + (C_RV + 64 * h + se) * 2); \
        } else { \
            const int _e = lane - 8 * wid; kreg = (u32x4){0u, 0u, 0u, 0u}; \
            if (_e >= 0 && _e < 8) { const unsigned _one = (_e & 1) ? 0x3F800000u : 0x00003F80u; if ((_e >> 1) == 0) kreg.x = _one; else if ((_e >> 1) == 1) kreg.y = _one; else if ((_e >> 1) == 2) kreg.z = _one; else kreg.w = _one; } \
            float _s[8]; _Pragma("unroll") for (int _i = 0; _i < 8; ++_i) _s[_i] = 0.f; \
            const int _dir = _kind - 2; const float _lg = _dir ? lgb : lgf; const int _mypos = _dir ? ret_bpos(_c2) : _c2; \
            for (int _j = 0; _j < NCHUNK; ++_j) { const int _jp = _dir ? ret_bpos(_j) : _j; if (_jp < _mypos) { \
                const float _cf = __builtin_amdgcn_exp2f(_lg * 128.0f * (float)(_mypos - 1 - _jp)); const f32x4* _p = (const f32x4*)(KV + (size_t)(_j * 2 + _dir) * 4096 + sd * 64 + se); \
                const f32x4 _a = _p[0], _b = _p[1]; _s[0] += _cf * _a.x; _s[1] += _cf * _a.y; _s[2] += _cf * _a.z; _s[3] += _cf * _a.w; _s[4] += _cf * _b.x; _s[5] += _cf * _b.y; _s[6] += _cf * _b.z; _s[7] += _cf * _b.w; } } \
            vreg.x = cvt_pk_bf16(_s[0], _s[1]); vreg.y = cvt_pk_bf16(_s[2], _s[3]); vreg.z = cvt_pk_bf16(_s[4], _s[5]); vreg.w = cvt_pk_bf16(_s[6], _s[7]); } } while (0)
    RT_LOAD(0); AT_COMMIT(0); SYNC();
    f32x16 o[2]; o[0] = f16zero(); o[1] = f16zero();
    for (int t = 0; t < 8; ++t) {
        const int buf = t & 1;
        if (t + 1 < 8) RT_LOAD(t + 1);
        const int cc = t >> 2, kind = t & 3;
        if (cc == ccw) {
            f32x16 p0, p1; qk_tile<0, 4>(p0, p1, lds + AL_K + buf * 8192, qr, r32, hi);
            if (kind < 2) {
#pragma unroll
                for (int r = 0; r < 16; ++r) {
                    const int tk0 = 64 * kind + crow(r, hi), d0 = tq - tk0, d1 = d0 - 32;
                    const float f0 = d0 > 0 ? __builtin_amdgcn_exp2f(lgf * (float)d0) : (d0 < 0 ? __builtin_amdgcn_exp2f(lgb * (float)(-d0)) : 2.0f);
                    const float f1 = d1 > 0 ? __builtin_amdgcn_exp2f(lgf * (float)d1) : (d1 < 0 ? __builtin_amdgcn_exp2f(lgb * (float)(-d1)) : 2.0f);
                    p0[r] *= f0; p1[r] *= f1;
                }
            } else {
                const float f = (kind == 2) ? __builtin_amdgcn_exp2f(lgf * (float)(tq + 1)) : __builtin_amdgcn_exp2f(lgb * (float)(128 - tq));
#pragma unroll
                for (int r = 0; r < 16; ++r) { p0[r] *= f; p1[r] *= f; }
            }
            bf16x8 pw[4]; pack_p(p0, p1, pw);
            pv_tile(o, lds + AL_V + buf * 8192, pw, lane, hi);
        }
        if (t + 1 < 8) AT_COMMIT(buf ^ 1);
        SYNC();
    }
#undef RT_LOAD
    LAS float* ost = (LAS float*)(lds + AL_OST) + wid * 2048;
    o_stage(o, ost, r32, hi);
    float x[32]; stage_row_read(ost, lane, x);
    float s = 0.f;
#pragma unroll
    for (int i = 0; i < 32; ++i) s += x[i];
    s += __shfl_xor(s, 1);
    const float mu = s * (1.0f / 64.0f); float q = 0.f;
#pragma unroll
    for (int i = 0; i < 32; ++i) { x[i] -= mu; q += x[i] * x[i]; }
    q += __shfl_xor(q, 1);
    const float rs = 1.0f / sqrtf(q * (1.0f / 64.0f) + EPS);
    const int trow_q = __shfl(qrow, lane >> 1);
    const bf16_t* gp = (const bf16_t*)Pb + (size_t)trow_q * PW + C_RG + 64 * h + 32 * (lane & 1);
#pragma unroll
    for (int i = 0; i < 4; ++i) { const u32x4 gw = ((const u32x4*)gp)[i];
        x[8 * i + 0] *= rs * bf_lo(gw.x); x[8 * i + 1] *= rs * bf_hi(gw.x); x[8 * i + 2] *= rs * bf_lo(gw.y); x[8 * i + 3] *= rs * bf_hi(gw.y);
        x[8 * i + 4] *= rs * bf_lo(gw.z); x[8 * i + 5] *= rs * bf_hi(gw.z); x[8 * i + 6] *= rs * bf_lo(gw.w); x[8 * i + 7] *= rs * bf_hi(gw.w); }
    store_row32((bf16_t*)(F.ws + WS_Y) + (size_t)trow_q * D + 256 + 64 * h + 32 * (lane & 1), x);
}

__device__ __forceinline__ void phase_retkv(Frame& F, int layer) {
    const char* Pb = (const char*)(F.ws + WS_P);
    const float* SC = (const float*)(F.ws + WS_TAB) + TB_SC + 16 * layer;
    LAS bf16_t* kl = (LAS bf16_t*)F.lds;
    LAS bf16_t* vl = (LAS bf16_t*)(F.lds + 16384);
    LAS float* wf = (LAS float*)(F.lds + 32768);
    const int tid = F.tid;
    for (int u = blockIdx.x; u < NBATCH * 4 * NCHUNK; u += F.G) {
        const int j = u % NCHUNK, bh = u / NCHUNK, h = bh & 3, b = bh >> 2;
        const int r0 = ret_chunk_row(b, j);
        const float lgf = SC[2 + h], lgb = SC[6 + h];
        for (int i = tid; i < 1024; i += 512) { const int s = i >> 3, c = i & 7;
            *(LAS u32x4*)(kl + s * 64 + 8 * c) = *(const u32x4*)(Pb + (size_t)(r0 + s) * (PW * 2) + (C_RK + 64 * h + 8 * c) * 2);
            *(LAS u32x4*)(vl + s * 64 + 8 * c) = *(const u32x4*)(Pb + (size_t)(r0 + s) * (PW * 2) + (C_RV + 64 * h + 8 * c) * 2); }
        if (tid < 128) { wf[tid] = exp2f(lgf * (float)(127 - tid)); wf[128 + tid] = exp2f(lgb * (float)tid); }
        SYNC();
        const int d = tid >> 3, e0 = 8 * (tid & 7);
        float af[8], ab[8];
#pragma unroll
        for (int i = 0; i < 8; ++i) { af[i] = 0.f; ab[i] = 0.f; }
        for (int s = 0; s < 128; ++s) {
            const float kd = bf2f(kl[s * 64 + d]); const float kf = kd * wf[s], kb = kd * wf[128 + s];
            const u32x4 vv = *(const LAS u32x4*)(vl + s * 64 + e0);
            const float v[8] = {bf_lo(vv.x), bf_hi(vv.x), bf_lo(vv.y), bf_hi(vv.y), bf_lo(vv.z), bf_hi(vv.z), bf_lo(vv.w), bf_hi(vv.w)};
#pragma unroll
            for (int i = 0; i < 8; ++i) { af[i] += kf * v[i]; ab[i] += kb * v[i]; }
        }
        float* KV = (float*)(F.ws + WS_RETKV) + (size_t)(bh * NCHUNK + j) * 2 * 4096 + d * 64 + e0;
        ((f32x4*)KV)[0] = (f32x4){af[0], af[1], af[2], af[3]}; ((f32x4*)KV)[1] = (f32x4){af[4], af[5], af[6], af[7]};
        ((f32x4*)(KV + 4096))[0] = (f32x4){ab[0], ab[1], ab[2], ab[3]}; ((f32x4*)(KV + 4096))[1] = (f32x4){ab[4], ab[5], ab[6], ab[7]};
        SYNC();
    }
}

__device__ __forceinline__ void phase_mixers(Frame& F, int layer) {
    const bool ctx = (layer == 0);
    const int lane = F.lane, r32 = lane & 31, wid = F.wave;
    for (int u = blockIdx.x; u < 1024 + (ctx ? 128 : 0); u += F.G) {
        SmUnit U{};
        if (u < 1024) { const int qb = u & 7, h = (u >> 3) & 3, b = u >> 5;
            U.qrow = b * 2048 + 256 * qb + 32 * wid + r32; U.qcol = C_DQ + 64 * h; U.kcol = C_DK + 64 * h; U.vcol = C_DV + 64 * h; U.ycol = 768 + 64 * h;
            U.n1 = 32; U.row1 = b * 2048; U.n2 = 4; U.row2 = TLAT + b * 256;
        } else { const int v = u - 1024, h = v & 3, b = v >> 2;
            U.qrow = TLAT + b * 256 + 32 * wid + r32; U.qcol = C_DQ + 64 * h; U.kcol = C_DK + 64 * h; U.vcol = C_DV + 64 * h; U.ycol = 768 + 64 * h;
            U.n1 = 4; U.row1 = TLAT + b * 256; U.n2 = 0; U.row2 = 0; }
        diff_unit(F, U, layer);
    }
    for (int u = blockIdx.x; u < 1024 + (ctx ? 256 : 0); u += F.G) {
        SmUnit U{};
        if (u < 1024) { const int qb = u & 15, kvh = (u >> 4) & 1, b = u >> 5, head = 2 * kvh + (wid >> 2);
            U.qrow = b * 2048 + 128 * qb + 32 * (wid & 3) + r32; U.qcol = C_GQ + 64 * head; U.kcol = C_GK + 64 * kvh; U.vcol = C_GV + 64 * kvh; U.ycol = 512 + 64 * head;
            U.n1 = 32; U.row1 = b * 2048; U.n2 = 4; U.row2 = TLAT + b * 256;
        } else if (u < 1152) { const int v = u - 1024, qb = v & 1, kvh = (v >> 1) & 1, b = v >> 2, head = 2 * kvh + (wid >> 2);
            U.qrow = TLAT + b * 256 + 128 * qb + 32 * (wid & 3) + r32; U.qcol = C_GQ + 64 * head; U.kcol = C_GK + 64 * kvh; U.vcol = C_GV + 64 * kvh; U.ycol = 512 + 64 * head;
            U.n1 = 4; U.row1 = TLAT + b * 256; U.n2 = 0; U.row2 = 0;
        } else { const int v = u - 1152, h = v & 3, b = v >> 2;
            U.qrow = TLAT + b * 256 + 32 * wid + r32; U.qcol = C_NAQ + 64 * h; U.kcol = C_NAK + 64 * h; U.vcol = C_NAV + 64 * h; U.ycol = 64 * h;
            U.n1 = 4; U.row1 = TLAT + b * 256; U.n2 = 0; U.row2 = 0; }
        sm_unit<false>(F, U);
    }
    for (int u = blockIdx.x; u < 1024; u += F.G) {
        const int g = u & 7, h = (u >> 3) & 3, b = u >> 5;
        { LAS float* tab = (LAS float*)(F.lds + AL_TAB); const float* rpb = F.in[I_RPB] + (size_t)(layer * 4 + h) * 465;
          for (int i = F.tid; i < 465; i += 512) tab[i] = rpb[i] * LOG2E; }
        SmUnit U{}; U.na_r = 4 * g + (wid >> 1); U.na_c = 32 * (wid & 1) + r32;
        U.qrow = b * 2048 + 64 * U.na_r + U.na_c; U.qcol = C_NAQ + 64 * h; U.kcol = C_NAK + 64 * h; U.vcol = C_NAV + 64 * h; U.ycol = 64 * h;
        U.n1 = 4; U.row1 = TLAT + b * 256;
        const int kr0 = min(max(4 * g - 4, 0), 24), krl = min(max(4 * g + 3 - 4, 0), 24) + 7;
        U.na_kr0 = kr0; U.n2 = krl - kr0 + 1; U.row2 = b * 2048 + 64 * kr0;
        sm_unit<true>(F, U);
    }
    { const int npair = ctx ? 9 : 8;
      for (int u = blockIdx.x; u < NBATCH * 4 * npair; u += F.G) { const int cp = (u % npair) + (ctx ? 0 : 1), bh = u / npair; ret_unit(F, layer, bh >> 2, bh & 3, cp); } }
}


__device__ __forceinline__ void phase_merge(Frame& F, int layer) {
    const GeoT g = make_geo();
    const char* XH = (const char*)(F.ws + WS_XH);
    const char* Yb = (const char*)(F.ws + WS_Y);
    const char* Wg = (const char*)(F.ws + WS_WIN) + ((size_t)layer * INW + PW) * 1024 * 2;
    const char* Wb = (const char*)(F.ws + WS_WBR) + (size_t)layer * 4 * 1024 * 256 * 2;
    bf16_t* ACC = (bf16_t*)(F.ws + WS_P);
    const int nrow_tiles = (layer == 0) ? T / 256 : TLAT / 256;
    for (int u = blockIdx.x; u < nrow_tiles * 8; u += F.G) {
        const int pm = u >> 3, jt = u & 7;
        unsigned aoffx[2][2], boffg[2][2], boffb[2][2];
        rows_contig(aoffx, g, pm * 256, 2048u);
#pragma unroll
        for (int i = 0; i < 2; ++i) { boffg[0][i] = (unsigned)(128 * jt + g.R[i]) * 2048u + (unsigned)g.C[i] * 2u; boffg[1][i] = 0u;
                                      boffb[0][i] = (unsigned)(128 * jt + g.R[i]) * 512u + (unsigned)g.C[i] * 2u; boffb[1][i] = 0u; }
        unsigned outp[2][4][2][2];
#pragma unroll
        for (int a = 0; a < 2; ++a)
#pragma unroll
            for (int m = 0; m < 4; ++m)
#pragma unroll
                for (int nn = 0; nn < 2; ++nn) { outp[a][m][nn][0] = 0u; outp[a][m][nn][1] = 0u; }
        for (int n = 0; n < 4; ++n) {
            f32x4 acc[2][1][4][2]; acc_zero<1>(acc);
            gemm_kloop<1>(F.lds, Yb + n * 512, aoffx, Wb + (size_t)n * 1024 * 256 * 2, boffb, 4, acc, g.wid, g.aoffl, g.boffl);
            unsigned yb[2][4][2][2];
#pragma unroll
            for (int a = 0; a < 2; ++a)
#pragma unroll
                for (int m = 0; m < 4; ++m)
#pragma unroll
                    for (int nn = 0; nn < 2; ++nn) { yb[a][m][nn][0] = cvt_pk_bf16(acc[a][0][m][nn][0], acc[a][0][m][nn][1]); yb[a][m][nn][1] = cvt_pk_bf16(acc[a][0][m][nn][2], acc[a][0][m][nn][3]); }
            acc_zero<1>(acc);
            gemm_kloop<1>(F.lds, XH, aoffx, Wg + (size_t)n * 1024 * 1024 * 2, boffg, 16, acc, g.wid, g.aoffl, g.boffl);
#pragma unroll
            for (int a = 0; a < 2; ++a)
#pragma unroll
                for (int m = 0; m < 4; ++m)
#pragma unroll
                    for (int nn = 0; nn < 2; ++nn) {
                        const float o0 = bf_lo(outp[a][m][nn][0]) + sigmoidf_(acc[a][0][m][nn][0]) * bf_lo(yb[a][m][nn][0]);
                        const float o1 = bf_hi(outp[a][m][nn][0]) + sigmoidf_(acc[a][0][m][nn][1]) * bf_hi(yb[a][m][nn][0]);
                        const float o2 = bf_lo(outp[a][m][nn][1]) + sigmoidf_(acc[a][0][m][nn][2]) * bf_lo(yb[a][m][nn][1]);
                        const float o3 = bf_hi(outp[a][m][nn][1]) + sigmoidf_(acc[a][0][m][nn][3]) * bf_hi(yb[a][m][nn][1]);
                        outp[a][m][nn][0] = cvt_pk_bf16(o0, o1); outp[a][m][nn][1] = cvt_pk_bf16(o2, o3);
                    }
        }
#pragma unroll
        for (int a = 0; a < 2; ++a)
#pragma unroll
            for (int m = 0; m < 4; ++m) {
                const int row = pm * 256 + a * 128 + g.wr * 64 + m * 16 + g.fr;
                bf16_t* op = ACC + (size_t)row * D + 128 * jt + 32 * g.wc + 4 * g.fq;
#pragma unroll
                for (int nn = 0; nn < 2; ++nn) { u32x2 w; w.x = outp[a][m][nn][0]; w.y = outp[a][m][nn][1]; *(u32x2*)(op + 16 * nn) = w; }
            }
    }
}

__device__ __forceinline__ float* xrow_ptr(Frame& F, int row) { return (row < TLAT) ? F.out + (size_t)row * D : (float*)(F.ws + WS_X1CTX) + (size_t)(row - TLAT) * D; }
__device__ __forceinline__ void phase_outproj(Frame& F, int layer) {
    const GeoT g = make_geo();
    const char* A = (const char*)(F.ws + WS_P);
    const char* B = (const char*)(F.ws + WS_WOUT) + (size_t)layer * 1024 * 1024 * 2;
    const int nrow_tiles = (layer == 0) ? T / 256 : TLAT / 256;
    for (int u = blockIdx.x; u < nrow_tiles * 4; u += F.G) {
        const int pm = u >> 2, pn = u & 3;
        unsigned aoff[2][2], boff[2][2];
        rows_contig(aoff, g, pm * 256, 2048u);
        rows_contig(boff, g, pn * 256, 2048u);
        f32x4 acc[2][2][4][2]; acc_zero<2>(acc);
        gemm_kloop<2>(F.lds, A, aoff, B, boff, 16, acc, g.wid, g.aoffl, g.boffl);
        const int row0 = pm * 256 + g.wr * 64 + g.fr;
        const float* gt = mod_ptr(F, layer, pm * 256) + 2048;
#pragma unroll
        for (int ai = 0; ai < 2; ++ai)
#pragma unroll
            for (int m = 0; m < 4; ++m) {
                const int row = row0 + ai * 128 + m * 16;
                const float* xin = (layer == 0) ? ((row < TLAT) ? F.in[I_X] + (size_t)row * D : F.in[I_CTX] + (size_t)(row - TLAT) * D) : xrow_ptr(F, row);
                float* xo = xrow_ptr(F, row);
#pragma unroll
                for (int bj = 0; bj < 2; ++bj)
#pragma unroll
                    for (int n = 0; n < 2; ++n) {
                        const int col = pn * 256 + bj * 128 + g.wc * 32 + n * 16 + 4 * g.fq;
                        const f32x4 xv = *(const f32x4*)(xin + col), gv = *(const f32x4*)(gt + col);
                        *(f32x4*)(xo + col) = xv + gv * acc[ai][bj][m][n];
                    }
            }
    }
}

__device__ __forceinline__ void phase_norm2route(Frame& F, int layer) {
    LAS float* wrl = (LAS float*)F.lds;
    LAS unsigned* rowE = (LAS unsigned*)(F.lds + 65536);
    LAS float* rowW = (LAS float*)(F.lds + 65536 + 1024);
    LAS unsigned* ebase = (LAS unsigned*)(F.lds + 65536 + 3072);
    for (int i = F.tid; i < 16384 / 4; i += 512) ((LAS f32x4*)wrl)[i] = ((const f32x4*)F.in[I_WR])[i];
    SYNC();
    const int nrows = (layer == 0) ? T : TLAT;
    bf16_t* XM = (bf16_t*)(F.ws + WS_XH);
    unsigned* ecnt = (unsigned*)(F.ws + WS_CTL) + CW_ECNT + 64 * layer;
    unsigned* toklist = (unsigned*)(F.ws + WS_TOKLIST);
    unsigned* tokslot = (unsigned*)(F.ws + WS_TOKSLOT);
    float* tokw = (float*)(F.ws + WS_TOKW);
    const float* rb = F.in[I_RB];
    for (int ch = blockIdx.x; ch < nrows / 256; ch += F.G) {
        for (int rr = 0; rr < 32; ++rr) {
            const int rl = F.wave * 32 + rr, row = ch * 256 + rl;
            f32x4 v[4]; row_load(xrow_ptr(F, row), F.lane, v);
            const float rstd = row_rstd(v);
            const float* mp = mod_ptr(F, layer, row);
            row_modulate(v, rstd, F.in[I_G2] + layer * D, mp + 3072, mp + 4096, F.lane);
            row_store_bf16(XM + (size_t)row * D, F.lane, v);
            float lg[16];
#pragma unroll
            for (int e = 0; e < 16; ++e) lg[e] = 0.f;
#pragma unroll
            for (int j = 0; j < 4; ++j)
#pragma unroll
                for (int c = 0; c < 4; ++c) {
                    const int k = 4 * F.lane + 256 * j + c; const float xv = v[j][c];
                    const LAS f32x4* wp = (const LAS f32x4*)(wrl + k * 16);
#pragma unroll
                    for (int q = 0; q < 4; ++q) { const f32x4 w4 = wp[q]; lg[4 * q] += xv * w4.x; lg[4 * q + 1] += xv * w4.y; lg[4 * q + 2] += xv * w4.z; lg[4 * q + 3] += xv * w4.w; }
                }
#pragma unroll
            for (int e = 0; e < 16; ++e) lg[e] = wave_sum(lg[e]);
            if (F.lane == 0) {
                float s[16], sel[16];
#pragma unroll
                for (int e = 0; e < 16; ++e) { s[e] = 1.0f / (1.0f + expf(-lg[e])); sel[e] = s[e] + rb[e]; }
                int gbest = 0; float gs_best = -1e30f;
#pragma unroll
                for (int gi = 0; gi < 4; ++gi) {
                    float a = -1e30f, b2 = -1e30f;
#pragma unroll
                    for (int i = 0; i < 4; ++i) { const float x = sel[4 * gi + i]; if (x > a) { b2 = a; a = x; } else if (x > b2) b2 = x; }
                    const float gs = a + b2; if (gs > gs_best) { gs_best = gs; gbest = gi; }
                }
                int i0 = 0, i1 = 0; float a = -1e30f, b2 = -1e30f;
#pragma unroll
                for (int gi = 0; gi < 4; ++gi) if (gi == gbest) {
#pragma unroll
                    for (int i = 0; i < 4; ++i) { const float x = sel[4 * gi + i]; if (x > a) { b2 = a; i1 = i0; a = x; i0 = i; } else if (x > b2) { b2 = x; i1 = i; } }
                }
                const int e0 = 4 * gbest + i0, e1 = 4 * gbest + i1;
                float w0 = 0.f, w1 = 0.f;
#pragma unroll
                for (int e = 0; e < 16; ++e) { if (e == e0) w0 = s[e]; if (e == e1) w1 = s[e]; }
                const float inv = 1.0f / (w0 + w1);
                rowE[rl] = (unsigned)e0 | ((unsigned)e1 << 8); rowW[2 * rl] = w0 * inv; rowW[2 * rl + 1] = w1 * inv;
            }
        }
        SYNC();
        if (F.tid < 16) {
            const unsigned e = F.tid; unsigned cnt = 0;
            for (int i = 0; i < 256; ++i) { const unsigned pe = rowE[i]; cnt += ((pe & 255u) == e) + ((pe >> 8) == e); }
            unsigned base = cnt ? atomicAdd(ecnt + e, cnt) : 0u;
            for (int i = 0; i < 256; ++i) {
                const unsigned pe = rowE[i]; const int row = ch * 256 + i;
                if ((pe & 255u) == e) { toklist[e * T + base] = row; tokslot[2 * row] = (e << 24) | base; tokw[2 * row] = rowW[2 * i]; ++base; }
                if ((pe >> 8) == e) { toklist[e * T + base] = row; tokslot[2 * row + 1] = (e << 24) | base; tokw[2 * row + 1] = rowW[2 * i + 1]; ++base; }
            }
        }
        SYNC();
    }
    (void)ebase;
}

__device__ __forceinline__ int moe_segments(Frame& F, int layer) {
    const unsigned* ecnt = (const unsigned*)(F.ws + WS_CTL) + CW_ECNT + 64 * layer;
    LAS int* seg = (LAS int*)(F.lds + LDS_MISC + 256);
    LAS unsigned char* blk2e = (LAS unsigned char*)(F.lds + LDS_MISC + 512);
    if (F.tid == 0) { int acc = 0;
        for (int e = 0; e < 16; ++e) { seg[e] = acc; acc += (int)((__hip_atomic_load(ecnt + e, __ATOMIC_RELAXED, __HIP_MEMORY_SCOPE_AGENT) + 255u) >> 8); }
        seg[16] = acc; }
    SYNC();
    const int nblk = seg[16];
    for (int blk = F.tid; blk < nblk; blk += 512) { int e = 0; for (int i = 1; i < 16; ++i) e += (blk >= seg[i]) ? 1 : 0; blk2e[blk] = (unsigned char)e; }
    SYNC();
    return nblk;
}
__device__ __forceinline__ void phase_moeup(Frame& F, int layer) {
    const GeoT g = make_geo();
    const unsigned* ecnt = (const unsigned*)(F.ws + WS_CTL) + CW_ECNT + 64 * layer;
    const LAS int* seg = (const LAS int*)(F.lds + LDS_MISC + 256);
    const LAS unsigned char* blk2e = (const LAS unsigned char*)(F.lds + LDS_MISC + 512);
    const int nblk = moe_segments(F, layer);
    const char* A = (const char*)(F.ws + WS_XH);
    const unsigned* toklist = (const unsigned*)(F.ws + WS_TOKLIST);
    bf16_t* U = (bf16_t*)(F.ws + WS_U);
    for (int u = blockIdx.x; u < nblk * 4; u += F.G) {
        const int blk = u >> 2, pn = u & 3;
        const int e = __builtin_amdgcn_readfirstlane((int)blk2e[blk]);
        const int rb = blk - __builtin_amdgcn_readfirstlane(seg[e]);
        const int cnt = (int)__hip_atomic_load(ecnt + e, __ATOMIC_RELAXED, __HIP_MEMORY_SCOPE_AGENT);
        const char* B = (const char*)(F.ws + WS_WGU) + (size_t)(layer * 16 + e) * 1024 * 1024 * 2;
        unsigned aoff[2][2], boff[2][2];
#pragma unroll
        for (int h = 0; h < 2; ++h)
#pragma unroll
            for (int i = 0; i < 2; ++i) { const int sl = rb * 256 + 128 * h + g.R[i]; const unsigned tok = (sl < cnt) ? toklist[e * T + sl] : 0u; aoff[h][i] = tok * 2048u + (unsigned)g.C[i] * 2u; }
        rows_contig(boff, g, pn * 256, 2048u);
        f32x4 acc[2][2][4][2]; acc_zero<2>(acc);
        gemm_kloop<2>(F.lds, A, aoff, B, boff, 16, acc, g.wid, g.aoffl, g.boffl);
#pragma unroll
        for (int ai = 0; ai < 2; ++ai)
#pragma unroll
            for (int m = 0; m < 4; ++m) {
                const size_t slot = (size_t)blk * 256 + ai * 128 + g.wr * 64 + m * 16 + g.fr;
                bf16_t* up = U + slot * DE + pn * 128 + g.wc * 32 + 4 * g.fq;
#pragma unroll
                for (int n = 0; n < 2; ++n) {
                    const f32x4 gv = acc[ai][0][m][n], uv = acc[ai][1][m][n];
                    u32x2 w; w.x = cvt_pk_bf16(siluf_(gv.x) * uv.x, siluf_(gv.y) * uv.y); w.y = cvt_pk_bf16(siluf_(gv.z) * uv.z, siluf_(gv.w) * uv.w);
                    *(u32x2*)(up + 16 * n) = w;
                }
            }
    }
}
__device__ __forceinline__ void phase_moedown(Frame& F, int layer) {
    const GeoT g = make_geo();
    const LAS unsigned char* blk2e = (const LAS unsigned char*)(F.lds + LDS_MISC + 512);
    const int nblk = moe_segments(F, layer);
    const char* A = (const char*)(F.ws + WS_U);
    bf16_t* DN = (bf16_t*)(F.ws + WS_DN);
    for (int u = blockIdx.x; u < nblk * 4; u += F.G) {
        const int blk = u >> 2, pn = u & 3;
        const int e = __builtin_amdgcn_readfirstlane((int)blk2e[blk]);
        const char* B = (const char*)(F.ws + WS_WD) + (size_t)(layer * 16 + e) * 1024 * 512 * 2;
        unsigned aoff[2][2], boff[2][2];
        rows_contig(aoff, g, blk * 256, 1024u);
        rows_contig(boff, g, pn * 256, 1024u);
        f32x4 acc[2][2][4][2]; acc_zero<2>(acc);
        gemm_kloop<2>(F.lds, A, aoff, B, boff, 8, acc, g.wid, g.aoffl, g.boffl);
#pragma unroll
        for (int ai = 0; ai < 2; ++ai)
#pragma unroll
            for (int m = 0; m < 4; ++m) {
                const size_t slot = (size_t)blk * 256 + ai * 128 + g.wr * 64 + m * 16 + g.fr;
                bf16_t* dp = DN + slot * D + pn * 256 + g.wc * 32 + 4 * g.fq;
#pragma unroll
                for (int bj = 0; bj < 2; ++bj)
#pragma unroll
                    for (int n = 0; n < 2; ++n) { const f32x4 v = acc[ai][bj][m][n]; u32x2 w; w.x = cvt_pk_bf16(v.x, v.y); w.y = cvt_pk_bf16(v.z, v.w); *(u32x2*)(dp + bj * 128 + 16 * n) = w; }
            }
    }
}
__device__ __forceinline__ void phase_combine(Frame& F, int layer) {
    const LAS int* seg = (const LAS int*)(F.lds + LDS_MISC + 256);
    (void)moe_segments(F, layer);
    const int nrows = (layer == 0) ? T : TLAT;
    const int gw = blockIdx.x * 8 + F.wave, NGW = F.G * 8;
    const unsigned* tokslot = (const unsigned*)(F.ws + WS_TOKSLOT);
    const float* tokw = (const float*)(F.ws + WS_TOKW);
    const bf16_t* DN = (const bf16_t*)(F.ws + WS_DN);
    bf16_t* XH = (bf16_t*)(F.ws + WS_XH);
    for (int row = gw; row < nrows; row += NGW) {
        const unsigned s0 = tokslot[2 * row], s1 = tokslot[2 * row + 1];
        const float w0 = tokw[2 * row], w1 = tokw[2 * row + 1];
        const size_t sl0 = (size_t)seg[s0 >> 24] * 256 + (s0 & 0xffffffu), sl1 = (size_t)seg[s1 >> 24] * 256 + (s1 & 0xffffffu);
        float* xr = xrow_ptr(F, row);
        f32x4 v[4]; row_load(xr, F.lane, v);
        const float* gt2 = mod_ptr(F, layer, row) + 5120;
#pragma unroll
        for (int j = 0; j < 4; ++j) {
            const u32x2 a = ((const u32x2*)(DN + sl0 * D))[F.lane + 64 * j], b = ((const u32x2*)(DN + sl1 * D))[F.lane + 64 * j];
            const f32x4 gv = ((const f32x4*)gt2)[F.lane + 64 * j];
            f32x4 f; f.x = w0 * bf_lo(a.x) + w1 * bf_lo(b.x); f.y = w0 * bf_hi(a.x) + w1 * bf_hi(b.x); f.z = w0 * bf_lo(a.y) + w1 * bf_lo(b.y); f.w = w0 * bf_hi(a.y) + w1 * bf_hi(b.y);
            v[j] = v[j] + gv * f;
        }
        const float rstd = row_rstd(v);
        if (layer == 0) {
#pragma unroll
            for (int j = 0; j < 4; ++j) ((f32x4*)xr)[F.lane + 64 * j] = v[j];
            const float* mp = mod_ptr(F, 1, row);
            row_modulate(v, rstd, F.in[I_G1] + D, mp, mp + 1024, F.lane);
            row_store_bf16(XH + (size_t)row * D, F.lane, v);
        } else {
#pragma unroll
            for (int j = 0; j < 4; ++j) { const f32x4 gg = ((const f32x4*)F.in[I_GF])[F.lane + 64 * j]; ((f32x4*)xr)[F.lane + 64 * j] = v[j] * rstd * gg; }
        }
    }
}

__device__ __forceinline__ const void* opaque_ptr(const void* p) {
    unsigned long long w = (unsigned long long)p; unsigned lo = (unsigned)w, hi = (unsigned)(w >> 32);
    asm volatile("" : "+v"(lo), "+v"(hi));
    lo = __builtin_amdgcn_readfirstlane(lo); hi = __builtin_amdgcn_readfirstlane(hi);
    return (const void*)(((unsigned long long)hi << 32) | lo);
}
constexpr int N_PHASES = 2 + 2 * 9;
__global__ void __launch_bounds__(512, 2) mk_fwd(Args args) {
    extern __shared__ __attribute__((aligned(16))) unsigned char lds_raw[];
    Frame F; F.lds = (LAS unsigned char*)lds_raw; F.tid = threadIdx.x; F.lane = F.tid & 63; F.wave = __builtin_amdgcn_readfirstlane(F.tid >> 6); F.G = gridDim.x;
    static_assert(offsetof(Args, out) == 184 && offsetof(Args, ws) == 192, "kernarg layout");
    F.in = nullptr; F.out = nullptr; F.ws = args.ws;
    const int lo = args.ph_lo, hi = args.ph_hi;
    volatile LAS unsigned* misc = (volatile LAS unsigned*)(F.lds + LDS_MISC);
    if (F.tid < 64) misc[F.tid] = 0u;
    __syncthreads();
    XcdBarrier bar; bar.bar = (unsigned*)(F.ws + WS_CTL) + CW_BAR; bar.x = 0; bar.st = misc;
    if (hi - lo > 1) bar = xcd_barrier_post((unsigned*)(F.ws + WS_CTL) + CW_BAR, misc);
#define IN(k) (lo <= (k) && (k) < hi)
#define SEAM(k) do { if (IN(k) && IN((k) + 1)) { XcdBarrier _b = bar; _b.bar = (unsigned*)opaque_ptr(bar.bar); xcd_barrier(_b); } } while (0)
#define FRESH() do { int _t = threadIdx.x; int _g = gridDim.x; unsigned _l = (unsigned)(uintptr_t)lds_raw; asm volatile("" : "+v"(_t), "+v"(_g), "+v"(_l)); \
        const unsigned char* _ka = (const unsigned char*)opaque_ptr((const void*)__builtin_amdgcn_kernarg_segment_ptr()); \
        F.in = (const float* const*)_ka; F.out = *(float* const*)(_ka + 184); F.ws = *(unsigned char* const*)(_ka + 192); \
        F.G = __builtin_amdgcn_readfirstlane(_g); F.lds = (LAS unsigned char*)(uintptr_t)__builtin_amdgcn_readfirstlane(_l); \
        F.tid = _t; F.lane = _t & 63; F.wave = __builtin_amdgcn_readfirstlane(_t >> 6); } while (0)
    if (IN(0)) { FRESH(); phase_pro(F); } SEAM(0);
    if (IN(1)) { FRESH(); phase_norm1_l0(F); } SEAM(1);
    for (int layer = 0; layer < 2; ++layer) {
        const int pb = 2 + 9 * layer;
        if (IN(pb + 0)) { FRESH(); phase_inproj(F, layer); } SEAM(pb + 0);
        if (IN(pb + 1)) { FRESH(); phase_retkv(F, layer); } SEAM(pb + 1);
        if (IN(pb + 2)) { FRESH(); phase_mixers(F, layer); } SEAM(pb + 2);
        if (IN(pb + 3)) { FRESH(); phase_merge(F, layer); } SEAM(pb + 3);
        if (IN(pb + 4)) { FRESH(); phase_outproj(F, layer); } SEAM(pb + 4);
        if (IN(pb + 5)) { FRESH(); phase_norm2route(F, layer); } SEAM(pb + 5);
        if (IN(pb + 6)) { FRESH(); phase_moeup(F, layer); } SEAM(pb + 6);
        if (IN(pb + 7)) { FRESH(); phase_moedown(F, layer); } SEAM(pb + 7);
        if (IN(pb + 8)) { FRESH(); phase_combine(F, layer); } SEAM(pb + 8);
    }
#undef IN
#undef SEAM
}

extern "C" void kernel_launch(void* const* d_in, const int* in_sizes, int n_in, void* d_out, int out_size, void* d_ws, size_t ws_size, hipStream_t stream) {
    static int grid = 0;
    if (grid == 0) {
        if (n_in != 23 || out_size != TLAT * D || ws_size < WS_END) { fprintf(stderr, "kernel_launch: unexpected shapes (n_in %d out %d ws %zu)\n", n_in, out_size, ws_size); grid = -1; return; }
        int dev = 0, cus = 0;
        if (hipGetDevice(&dev) != hipSuccess || hipDeviceGetAttribute(&cus, hipDeviceAttributeMultiprocessorCount, dev) != hipSuccess) { grid = -1; return; }
        if (hipFuncSetAttribute((const void*)mk_fwd, hipFuncAttributeMaxDynamicSharedMemorySize, LDS_BYTES) != hipSuccess) { fprintf(stderr, "kernel_launch: hipFuncSetAttribute failed\n"); grid = -1; return; }
        int per_cu = 0;
        if (hipOccupancyMaxActiveBlocksPerMultiprocessor(&per_cu, (const void*)mk_fwd, 512, LDS_BYTES) != hipSuccess || per_cu < 1) { fprintf(stderr, "kernel_launch: occupancy query says %d\n", per_cu); }
        (void)hipGetLastError();
        grid = cus;
    }
    if (grid < 0) return;
    (void)hipMemsetAsync((char*)d_ws + WS_CTL, 0, CTL_BYTES, stream);
    Args a{};
    for (int i = 0; i < 23; ++i) a.in[i] = (const float*)d_in[i];
    a.out = (float*)d_out; a.ws = (unsigned char*)d_ws;
#if MK_ONE_LAUNCH
    a.ph_lo = 0; a.ph_hi = N_PHASES;
    hipLaunchKernelGGL(mk_fwd, dim3(grid), dim3(512), LDS_BYTES, stream, a);
#else
    for (int p = 0; p < N_PHASES; ++p) { a.ph_lo = p; a.ph_hi = p + 1; hipLaunchKernelGGL(mk_fwd, dim3(grid), dim3(512), LDS_BYTES, stream, a); }
#endif
}
```

```cpp
#include <hip/hip_runtime.h>
#include <stdint.h>
#include <stdio.h>
#include <math.h>
#include <stddef.h>

#ifndef MK_DIAG
#define MK_DIAG 0
#endif
#ifndef MK_DIAG_A0
#define MK_DIAG_A0 0
#define MK_DIAG_B0 1
#define MK_DIAG_A1 0
#define MK_DIAG_B1 0
#endif
#ifndef MK_REP
#define MK_REP -1
#endif
#ifndef MK_REP_MIX
#define MK_REP_MIX -1
#endif
#ifndef MK_ONE_LAUNCH
#define MK_ONE_LAUNCH 1
#endif

#define LAS __attribute__((address_space(3)))
typedef unsigned short bf16_t;
typedef short bf16x8 __attribute__((ext_vector_type(8)));
typedef short s16x4 __attribute__((ext_vector_type(4)));
typedef float f32x4 __attribute__((ext_vector_type(4)));
typedef float f32x2 __attribute__((ext_vector_type(2)));
typedef float f32x16 __attribute__((ext_vector_type(16)));
typedef unsigned u32x4 __attribute__((ext_vector_type(4)));
typedef unsigned u32x2 __attribute__((ext_vector_type(2)));

constexpr int D = 1024, NBATCH = 32, SEQ = 2048, CTXL = 256, GRIDW = 64;
constexpr int TLAT = NBATCH * SEQ;
constexpr int TCTX = NBATCH * CTXL;
constexpr int T = TLAT + TCTX;
constexpr int PW = 3072;
constexpr int INW = 7168;
constexpr int NE = 16, DE = 512;
constexpr int SLOTS_MAX = 2 * T + NE * 256;
constexpr int NCHUNK = 18;
constexpr float EPS = 1e-6f;
constexpr float LOG2E = 1.4426950408889634f;
constexpr int C_NAQ = 0, C_NAK = 256, C_NAV = 512, C_RQ = 768, C_RK = 1024, C_RV = 1280, C_RG = 1536, C_GQ = 1792, C_GK = 2048, C_GV = 2176, C_DQ = 2304, C_DK = 2560, C_DV = 2816;

constexpr size_t MiB = 1u << 20;
constexpr size_t WS_CTL = 0, CTL_BYTES = 1 * MiB;
constexpr size_t WS_MOD = 1 * MiB;
constexpr size_t WS_TAB = 3 * MiB;
constexpr size_t WS_TOKLIST = 4 * MiB;
constexpr size_t WS_TOKSLOT = 9 * MiB;
constexpr size_t WS_TOKW = 10 * MiB;
constexpr size_t WS_RETKV = 12 * MiB;
constexpr size_t WS_WIN = 88 * MiB;
constexpr size_t WS_WBR = 116 * MiB;
constexpr size_t WS_WOUT = 120 * MiB;
constexpr size_t WS_WGU = 124 * MiB;
constexpr size_t WS_WD = 188 * MiB;
constexpr size_t WS_X1CTX = 220 * MiB;
constexpr size_t WS_XH = 252 * MiB;
constexpr size_t WS_Y = 396 * MiB;
constexpr size_t WS_P = 540 * MiB;
constexpr size_t WS_U = WS_P;
constexpr size_t WS_DN = WS_P + 148 * MiB;
constexpr size_t WS_WIN8 = 988 * MiB;
constexpr size_t WS_END = 1002 * MiB;
constexpr size_t OUT_XH8 = 128 * MiB;
static_assert((size_t)SLOTS_MAX * DE * 2 <= 148 * MiB && (size_t)SLOTS_MAX * D * 2 <= 296 * MiB, "moe buffers");
constexpr int CW_ECNT = 64;
constexpr int CW_BAR = 4096;
constexpr int TB_R64C = 0, TB_R64S = 1024, TB_R32C = 2048, TB_R32S = 2560, TB_SC = 3072;

constexpr int LDS_BYTES = 163840;
constexpr int LDS_MISC = 161792;
constexpr int LDS_GOFF = 131072;
constexpr int HTB = 16384;

__device__ __forceinline__ unsigned cvt_pk_bf16(float lo, float hi) { unsigned r; asm volatile("v_cvt_pk_bf16_f32 %0, %1, %2" : "=v"(r) : "v"(lo), "v"(hi)); return r; }
__device__ __forceinline__ float bf_lo(unsigned u) { return __uint_as_float(u << 16); }
__device__ __forceinline__ float bf_hi(unsigned u) { return __uint_as_float(u & 0xffff0000u); }
__device__ __forceinline__ float bf2f(bf16_t b) { return __uint_as_float(((unsigned)b) << 16); }
__device__ __forceinline__ float sat8(float v) { return __builtin_amdgcn_fmed3f(v, -448.0f, 448.0f); }
__device__ __forceinline__ unsigned cvt_pk4_fp8(float a, float b, float c, float d) { int w = __builtin_amdgcn_cvt_pk_fp8_f32(sat8(a), sat8(b), 0, false); w = __builtin_amdgcn_cvt_pk_fp8_f32(sat8(c), sat8(d), w, true); return (unsigned)w; }
template <int CTRL> __device__ __forceinline__ float dppf(float v) { return __int_as_float(__builtin_amdgcn_update_dpp(0, __float_as_int(v), CTRL, 0xF, 0xF, true)); }
constexpr int DPP_XOR1 = 0xB1, DPP_XOR2 = 0x4E, DPP_HMIRROR = 0x141, DPP_MIRROR = 0x140, DPP_ROR8 = 0x128;
__device__ __forceinline__ float swapsum16(float a, float b) { auto r = __builtin_amdgcn_permlane16_swap(__float_as_uint(a), __float_as_uint(b), false, false); return __uint_as_float(r[0]) + __uint_as_float(r[1]); }
__device__ __forceinline__ float swapsum32(float a, float b) { auto r = __builtin_amdgcn_permlane32_swap(__float_as_uint(a), __float_as_uint(b), false, false); return __uint_as_float(r[0]) + __uint_as_float(r[1]); }
__device__ __forceinline__ float wave_sum(float v) {
    v += dppf<DPP_XOR1>(v); v += dppf<DPP_XOR2>(v); v += dppf<DPP_HMIRROR>(v); v += dppf<DPP_MIRROR>(v);
    v = swapsum16(v, v); v = swapsum32(v, v);
    return v;
}
__device__ __forceinline__ float sigmoidf_(float x) { return __builtin_amdgcn_rcpf(1.0f + __builtin_amdgcn_exp2f(x * -1.4426950408889634f)); }
__device__ __forceinline__ float siluf_(float x) { return x * sigmoidf_(x); }
#define VG(x) asm volatile("" : "+v"(x))
__device__ __forceinline__ int lane_now() { int l; asm volatile("v_mbcnt_lo_u32_b32 %0, -1, 0\n\tv_mbcnt_hi_u32_b32 %0, -1, %0" : "=v"(l)); return l; }
#define WAIT_V(n) asm volatile("s_waitcnt vmcnt(" #n ")" ::: "memory")
#define WAIT_L(n) asm volatile("s_waitcnt lgkmcnt(" #n ")" ::: "memory")
#define BAR() __builtin_amdgcn_s_barrier()
#define SYNC() do { asm volatile("s_waitcnt vmcnt(0) lgkmcnt(0)" ::: "memory"); __builtin_amdgcn_s_barrier(); asm volatile("" ::: "memory"); } while (0)

#define XB_TMO      128
#define XB_XCNT(j)  (256  + 64 * (j))
#define XB_XSUB(j)  (1280 + 64 * (j))
#define XB_XGEN(j)  (2304 + 64 * (j))
#define XB_TOP      3328
#define XB_TOPGEN   3392
#define XCD_BAR_WORDS 3456
#define XB_SPIN_CAP (1u << 18)
__device__ __forceinline__ unsigned xb_ld(unsigned* p)              { return __hip_atomic_load(p, __ATOMIC_RELAXED, __HIP_MEMORY_SCOPE_AGENT); }
__device__ __forceinline__ unsigned xb_add(unsigned* p, unsigned v) { return __hip_atomic_fetch_add(p, v, __ATOMIC_RELAXED, __HIP_MEMORY_SCOPE_AGENT); }
__device__ __forceinline__ unsigned xb_xcc_id() { return (unsigned)__builtin_amdgcn_s_getreg((3 << 11) | 20) & 0xFu; }
#define XB_SPIN(cond, bar) do { unsigned _sp = 0; while (cond) { __builtin_amdgcn_s_sleep(1); \
    if ((++_sp & 255u) == 0u) { if (xb_ld(&(bar)[XB_TMO])) break; if (_sp > XB_SPIN_CAP) { atomicAdd(&(bar)[XB_TMO], 1u); break; } } } } while (0)
struct XcdBarrier { unsigned* bar; unsigned x; volatile LAS unsigned* st; };
__device__ __forceinline__ XcdBarrier xcd_barrier_post(unsigned* bar, volatile LAS unsigned* st, bool leader) {
    XcdBarrier b; b.bar = bar; b.x = xb_xcc_id(); b.st = st;
    if (leader) (void)xb_add(&bar[XB_XCNT(b.x)], 1u);
    return b;
}
__device__ __forceinline__ void xcd_barrier_complete(unsigned* bar, unsigned x, unsigned& nloc, unsigned& nx) {
    const unsigned G = gridDim.x * gridDim.y * gridDim.z;
    unsigned sum, cnt, mine, sp = 0u;
    for (;;) {
        sum = 0u; cnt = 0u; mine = 0u;
#pragma unroll
        for (unsigned j = 0; j < 16; ++j) { const unsigned c = xb_ld(&bar[XB_XCNT(j)]); sum += c; cnt += (c > 0u) ? 1u : 0u; mine = (j == x) ? c : mine; }
        if (sum == G) break;
        __builtin_amdgcn_s_sleep(1);
        if ((++sp & 255u) == 0u) { if (xb_ld(&bar[XB_TMO])) break; if (sp > XB_SPIN_CAP) { atomicAdd(&bar[XB_TMO], 1u); break; } }
    }
    nloc = mine > 0u ? mine : 1u; nx = cnt > 0u ? cnt : 1u;
}
__device__ __forceinline__ void xcd_barrier(const XcdBarrier& b, bool leader) {
    asm volatile("s_waitcnt vmcnt(0)" ::: "memory");
    __syncthreads();
    if (leader) {
        unsigned* bar = b.bar;
        __builtin_amdgcn_s_waitcnt(0);
        unsigned nloc = b.st[0], nx = b.st[1];
        if (nloc == 0u) { xcd_barrier_complete(bar, b.x, nloc, nx); b.st[0] = nloc; b.st[1] = nx; }
        const unsigned old = xb_add(&bar[XB_XSUB(b.x)], 1u);
        const unsigned gen = old / nloc;
        if (old + 1u == (gen + 1u) * nloc) {
            __builtin_amdgcn_fence(__ATOMIC_RELEASE, "agent");
            asm volatile("s_waitcnt vmcnt(0)" ::: "memory");
            const unsigned og = xb_add(&bar[XB_TOP], 1u);
            const unsigned tg = og / nx;
            if (og + 1u == (tg + 1u) * nx) xb_add(&bar[XB_TOPGEN], 1u);
            else XB_SPIN(xb_ld(&bar[XB_TOPGEN]) == tg, bar);
            __builtin_amdgcn_fence(__ATOMIC_ACQUIRE, "agent");
            xb_add(&bar[XB_XGEN(b.x)], 1u);
            asm volatile("s_waitcnt vmcnt(0)" ::: "memory");
        } else {
            XB_SPIN(xb_ld(&bar[XB_XGEN(b.x)]) == gen, bar);
            __builtin_amdgcn_fence(__ATOMIC_ACQUIRE, "agent");
            asm volatile("s_waitcnt vmcnt(0)" ::: "memory");
        }
    }
    __syncthreads();
}

struct Args { const float* in[23]; float* out; unsigned char* ws; int ph_lo, ph_hi; };
typedef const float* cfptr_t;
typedef const __attribute__((address_space(4))) cfptr_t* in_tab_t;
struct Frame {
    LAS unsigned char* lds;
    int tid, lane, wave, G;
    in_tab_t in; float* out; unsigned char* ws;
};
enum { I_X = 0, I_C, I_CTX, I_CCTX, I_WMOD, I_BMOD, I_G1, I_G2, I_WIN, I_RPB, I_RLD, I_QG, I_KG, I_DLAM, I_DSUB, I_WBR, I_WOUT, I_WR, I_RB, I_WG, I_WU, I_WD, I_GF };

__device__ __forceinline__ int lds_byte(int r, int c) { const int st = (r >> 4) * 2 + (c >> 5), rr = r & 15, cc = c & 31, ob = rr * 64 + cc * 2; return st * 1024 + (ob ^ (((ob >> 9) & 1) << 5)); }
__device__ __forceinline__ void stage_rc(int b, int& R, int& C) { const int st = b / 1024, sb = b % 1024, swz = sb ^ (((sb >> 9) & 1) << 5); R = (st >> 1) * 16 + swz / 64; C = (st & 1) * 32 + (swz % 64) / 2; }

template <int NBH>
__device__ __forceinline__ void gemm_kloop(LAS unsigned char* lds, const char* aBase, const unsigned (&aoff)[2][2], const char* bBase, const unsigned (&boff)[2][2], int nk,
                                           f32x4 (&acc)[2][NBH][4][2], int wid, int aoffl, int boffl) {
    const unsigned ldsw = (unsigned)wid * 1024u;
#define GE_STAGE(buf, kt) do { const unsigned _ko = (unsigned)(kt) * 128u; \
        _Pragma("unroll") for (int _h = 0; _h < 2; ++_h) _Pragma("unroll") for (int _i = 0; _i < 2; ++_i) \
            __builtin_amdgcn_global_load_lds((const unsigned*)(aBase + aoff[_h][_i] + _ko), (LAS unsigned*)(lds + (buf) * 65536 + _h * HTB + ldsw + _i * 8192), 16, 0, 0); \
        _Pragma("unroll") for (int _h = 0; _h < NBH; ++_h) _Pragma("unroll") for (int _i = 0; _i < 2; ++_i) \
            __builtin_amdgcn_global_load_lds((const unsigned*)(bBase + boff[_h][_i] + _ko), (LAS unsigned*)(lds + (buf) * 65536 + 32768 + _h * HTB + ldsw + _i * 8192), 16, 0, 0); } while (0)
    GE_STAGE(0, 0);
#pragma unroll 1
    for (int kt = 0; kt < nk; ++kt) {
        const int buf = kt & 1;
        WAIT_V(0); BAR();
        if (kt + 1 < nk) GE_STAGE(buf ^ 1, kt + 1);
        const LAS unsigned char* la = lds + buf * 65536 + aoffl;
        const LAS unsigned char* lb = lds + buf * 65536 + 32768 + boffl;
        bf16x8 Bf[NBH][2][2];
#pragma unroll
        for (int bj = 0; bj < NBH; ++bj)
#pragma unroll
            for (int n = 0; n < 2; ++n)
#pragma unroll
                for (int k = 0; k < 2; ++k) Bf[bj][n][k] = *(const LAS bf16x8*)(lb + bj * HTB + n * 2048 + k * 1024);
#pragma unroll
        for (int ai = 0; ai < 2; ++ai)
#pragma unroll
            for (int mh = 0; mh < 2; ++mh) {
                bf16x8 Af[2][2];
#pragma unroll
                for (int mm = 0; mm < 2; ++mm)
#pragma unroll
                    for (int k = 0; k < 2; ++k) Af[mm][k] = *(const LAS bf16x8*)(la + ai * HTB + (2 * mh + mm) * 2048 + k * 1024);
#pragma unroll
                for (int bj = 0; bj < NBH; ++bj)
#pragma unroll
                    for (int mm = 0; mm < 2; ++mm)
#pragma unroll
                        for (int n = 0; n < 2; ++n)
#pragma unroll
                            for (int k = 0; k < 2; ++k)
                                acc[ai][bj][2 * mh + mm][n] = __builtin_amdgcn_mfma_f32_16x16x32_bf16(Bf[bj][n][k], Af[mm][k], acc[ai][bj][2 * mh + mm][n], 0, 0, 0);
            }
    }
    WAIT_L(0); BAR();
#undef GE_STAGE
}
template <int NBH> __device__ __forceinline__ void acc_zero(f32x4 (&acc)[2][NBH][4][2]) {
#pragma unroll
    for (int a = 0; a < 2; ++a)
#pragma unroll
        for (int b = 0; b < NBH; ++b)
#pragma unroll
            for (int m = 0; m < 4; ++m)
#pragma unroll
                for (int n = 0; n < 2; ++n) acc[a][b][m][n] = (f32x4){0.f, 0.f, 0.f, 0.f};
}
struct GeoT { int wid, lane, wr, wc, fr, fq, aoffl, boffl; int R[2], C[2]; };
__device__ __forceinline__ GeoT make_geo(int tid) {
    GeoT g; asm volatile("" : "+v"(tid)); g.wid = __builtin_amdgcn_readfirstlane(tid >> 6); g.lane = tid & 63; g.wr = g.wid >> 2; g.wc = g.wid & 3; g.fr = g.lane & 15; g.fq = g.lane >> 4;
    g.aoffl = lds_byte(g.wr * 64 + g.fr, g.fq * 8); g.boffl = lds_byte(g.wc * 32 + g.fr, g.fq * 8);
#pragma unroll
    for (int i = 0; i < 2; ++i) stage_rc(tid * 16 + i * 8192, g.R[i], g.C[i]);
    return g;
}
__device__ __forceinline__ void rows_contig(unsigned (&off)[2][2], const GeoT& g, int row0, unsigned pitch_bytes) {
#pragma unroll
    for (int h = 0; h < 2; ++h)
#pragma unroll
        for (int i = 0; i < 2; ++i) off[h][i] = (unsigned)(row0 + 128 * h + g.R[i]) * pitch_bytes + (unsigned)g.C[i] * 2u;
}

__device__ __forceinline__ bool unit_order(int L, int nM, int nN, int& pm, int& pn) {
    const int nwg = nM * nN; if (L >= nwg) return false;
    int wgid = L; { const int q = nwg / 8, r = nwg % 8, xcd = wgid % 8, off = wgid / 8; wgid = (xcd < r ? xcd * (q + 1) : r * (q + 1) + (xcd - r) * q) + off; }
    const int nig = 8 * nN, gid = wgid / nig, fm = gid * 8, gsz = (nM - fm) < 8 ? (nM - fm) : 8;
    pm = fm + ((wgid % nig) % gsz); pn = (wgid % nig) / gsz; return true;
}


typedef int i32x4_t __attribute__((ext_vector_type(4)));
typedef int i32x8_t __attribute__((ext_vector_type(8)));
template <class T>
__device__ __forceinline__ i32x8_t cat16(const T& lo, const T& hi) { return __builtin_shufflevector(__builtin_bit_cast(i32x4_t, lo), __builtin_bit_cast(i32x4_t, hi), 0, 1, 2, 3, 4, 5, 6, 7); }
__device__ __forceinline__ f32x4 mfma_f8k128(i32x8_t a, i32x8_t b, f32x4 c) { return __builtin_amdgcn_mfma_scale_f32_16x16x128_f8f6f4(a, b, c, 0, 0, 0, 0x7F7F7F7F, 0, 0x7F7F7F7F); }

template <bool GATHER, bool F8, class Sched, class Epi>
__device__ __forceinline__ void gemm_stream(LAS unsigned char* lds, const Sched& S, const Epi& E, const int nt, const unsigned (&voffA)[2], const unsigned hstepA,
                                            const unsigned (&voffB)[2], const unsigned hstepB, const GeoT& g) {
    typedef typename Sched::Unit Unit;
    const int wr = g.wr;
    const unsigned ldsw = (unsigned)g.wid * 1024u;
    const int aoff = g.aoffl, boff = g.boffl;
    const unsigned kstep = 128u;
#define GS_SA(b, h) (((b) * 2 + (h)) * HTB)
#define GS_SB(b, h) ((4 + (b) * 2 + (h)) * HTB)
#define GS_STAGE(bufoff, gbase, v0, v1) do { \
        __builtin_amdgcn_global_load_lds((const unsigned*)((gbase) + (v0)), (LAS unsigned*)(lds + (bufoff) + ldsw), 16, 0, 0); \
        __builtin_amdgcn_global_load_lds((const unsigned*)((gbase) + (v1)), (LAS unsigned*)(lds + (bufoff) + ldsw + 8192), 16, 0, 0); } while (0)
#define GS_STAGE_B(bufoff, gbase, vb) GS_STAGE(bufoff, gbase, vb[0], vb[1])
#define GS_STAGE_A(bufoff, gbase, h, sl) do { if (GATHER) { const unsigned _v0 = goff[(((sl) * 2 + (h)) * 2 + 0) * 512], _v1 = goff[(((sl) * 2 + (h)) * 2 + 1) * 512]; GS_STAGE(bufoff, gbase, _v0, _v1); } \
        else GS_STAGE(bufoff, (gbase) + (h) * (size_t)hstepA, voffA[0], voffA[1]); } while (0)
#define GS_LDA(dst, b, h) do { _Pragma("unroll") for (int m = 0; m < 4; ++m) _Pragma("unroll") for (int k = 0; k < 2; ++k) dst[m][k] = *(const LAS bf16x8*)(lds + GS_SA(b, h) + aoff + m * 2048 + k * 1024); } while (0)
#define GS_LDB(dst, b, h) do { _Pragma("unroll") for (int n = 0; n < 2; ++n) _Pragma("unroll") for (int k = 0; k < 2; ++k) dst[n][k] = *(const LAS bf16x8*)(lds + GS_SB(b, h) + boff + n * 2048 + k * 1024); } while (0)
#define GS_MMA(ai, bj, At, Bt) do { __builtin_amdgcn_s_setprio(1); _Pragma("unroll") for (int m = 0; m < 4; ++m) _Pragma("unroll") for (int n = 0; n < 2; ++n) { \
        if (F8) { acc[ai][bj][m][n] = mfma_f8k128(cat16(Bt[n][0], Bt[n][1]), cat16(At[m][0], At[m][1]), acc[ai][bj][m][n]); asm volatile("" : "+v"(acc[ai][bj][m][n])); } \
        else { _Pragma("unroll") for (int k = 0; k < 2; ++k) acc[ai][bj][m][n] = __builtin_amdgcn_mfma_f32_16x16x32_bf16(Bt[n][k], At[m][k], acc[ai][bj][m][n], 0, 0, 0); } } __builtin_amdgcn_s_setprio(0); } while (0)
#define GS_SCHED __builtin_amdgcn_sched_barrier(0)
    Unit cur, nxt; int ui = 0;
    if (!S.next(0, cur)) return;
    f32x4 acc[2][2][4][2]; acc_zero<2>(acc);
    bf16x8 At[4][2], B0[2][2], B1[2][2];
    LAS unsigned* goff = (LAS unsigned*)(lds + LDS_GOFF) + (g.wid * 64 + g.lane);
    int oc = 0;
    if (GATHER) { unsigned v[2][2]; S.gather(cur, v); goff[0] = v[0][0]; goff[512] = v[0][1]; goff[1024] = v[1][0]; goff[1536] = v[1][1]; }
    const char* cA = cur.a; const char* cB = cur.b;
    unsigned vbc[2], vbn[2];
    S.boff(cur, voffB, vbc); vbn[0] = vbc[0]; vbn[1] = vbc[1];
    GS_STAGE_B(GS_SB(0, 0), cB, vbc); GS_STAGE_B(GS_SB(0, 1), cB + hstepB, vbc); GS_STAGE_A(GS_SA(0, 0), cA, 0, oc); GS_STAGE_A(GS_SA(0, 1), cA, 1, oc);
    if (wr == 1) BAR();
    WAIT_V(2); BAR();
    GS_STAGE_B(GS_SB(1, 0), cB + kstep, vbc); GS_STAGE_A(GS_SA(1, 0), cA + kstep, 0, oc); GS_STAGE_B(GS_SB(1, 1), cB + hstepB + kstep, vbc);
    WAIT_V(6); BAR();
    for (;;) {
        const bool has_next = S.next(ui + 1, nxt);
        const char* nA = has_next ? nxt.a : cA; const char* nB = has_next ? nxt.b : cB;
        if (has_next) S.boff(nxt, voffB, vbn);
        for (int t = 0; t < nt; t += 2) {
            const bool last = (t == nt - 2);
            if (GATHER && last) { unsigned v[2][2]; S.gather(has_next ? nxt : cur, v); LAS unsigned* gn = goff + (oc ^ 1) * 2048; gn[0] = v[0][0]; gn[512] = v[0][1]; gn[1024] = v[1][0]; gn[1536] = v[1][1]; }
            const char* a1 = cA + (size_t)(t + 1) * kstep;
            const char* a2 = last ? nA : cA + (size_t)(t + 2) * kstep; const char* b2 = last ? nB : cB + (size_t)(t + 2) * kstep;
            const char* a3 = a2 + kstep; const char* b3 = b2 + kstep;
            const int o2 = last ? (oc ^ 1) : oc;
            unsigned vb2[2]; vb2[0] = last ? vbn[0] : vbc[0]; vb2[1] = last ? vbn[1] : vbc[1];
            GS_LDB(B0, 0, 0); GS_LDB(B1, 0, 1); GS_SCHED; GS_LDA(At, 0, 0); GS_STAGE_A(GS_SA(1, 1), a1, 1, oc);
            WAIT_V(8); WAIT_L(0); BAR(); GS_MMA(0, 0, At, B0); GS_MMA(0, 1, At, B1); BAR(); GS_SCHED;
            GS_LDA(At, 0, 1); GS_STAGE_B(GS_SB(0, 0), b2, vb2); GS_STAGE_B(GS_SB(0, 1), b2 + hstepB, vb2); GS_STAGE_A(GS_SA(0, 0), a2, 0, o2);
            WAIT_V(8); WAIT_L(0); BAR(); GS_MMA(1, 0, At, B0); GS_MMA(1, 1, At, B1); BAR(); GS_SCHED;
            GS_LDB(B0, 1, 0); GS_LDB(B1, 1, 1); GS_SCHED; GS_LDA(At, 1, 0); GS_STAGE_A(GS_SA(0, 1), a2, 1, o2);
            WAIT_V(8); WAIT_L(0); BAR(); GS_MMA(0, 0, At, B0); GS_MMA(0, 1, At, B1); BAR(); GS_SCHED;
            GS_LDA(At, 1, 1); GS_STAGE_B(GS_SB(1, 0), b3, vb2); GS_STAGE_B(GS_SB(1, 1), b3 + hstepB, vb2); GS_STAGE_A(GS_SA(1, 0), a3, 0, o2);
            WAIT_V(8); WAIT_L(0); BAR(); GS_MMA(1, 0, At, B0); GS_MMA(1, 1, At, B1); BAR(); GS_SCHED;
        }
        if (wr == 0) BAR();
        E(acc, cur, g);
        if (!has_next) break;
        acc_zero<2>(acc);
        cur = nxt; cA = nA; cB = nB; ++ui; vbc[0] = vbn[0]; vbc[1] = vbn[1];
        oc ^= 1;
        if (wr == 1) BAR();
    }
    WAIT_V(0);
    BAR();
#undef GS_SA
#undef GS_SB
#undef GS_STAGE
#undef GS_STAGE_B
#undef GS_STAGE_A
#undef GS_LDA
#undef GS_LDB
#undef GS_MMA
#undef GS_SCHED
}

__device__ __forceinline__ void tr_item(const float* W, int N, bf16_t* WT, int Kd, int k0, int n0, int mode, LAS float* scr, int lane, unsigned char* W8 = nullptr) {
    float tv[32];
#pragma unroll
    for (int i = 0; i < 32; ++i) tv[i] = W[(size_t)(k0 + 2 * i + (lane >> 5)) * N + n0 + (lane & 31)];
#pragma unroll
    for (int i = 0; i < 32; ++i) scr[(2 * i + (lane >> 5)) * 33 + (lane & 31)] = tv[i];
    WAIT_L(0); asm volatile("" ::: "memory");
    const int c = lane & 7;
#pragma unroll
    for (int j = 0; j < 4; ++j) {
        const int nl = (lane >> 3) + 8 * j; const LAS float* s = scr + (8 * c) * 33 + nl;
        u32x4 o; o.x = cvt_pk_bf16(s[0 * 33], s[1 * 33]); o.y = cvt_pk_bf16(s[2 * 33], s[3 * 33]); o.z = cvt_pk_bf16(s[4 * 33], s[5 * 33]); o.w = cvt_pk_bf16(s[6 * 33], s[7 * 33]);
        const int n = n0 + nl;
        const int cs = n & 127, sl = (cs >> 5) * 32 + ((cs >> 2) & 1) * 16 + ((cs >> 3) & 3) * 4 + (cs & 3);
        const int drow = (mode == 0) ? n : ((mode == 3) ? ((n & ~127) + sl) : (256 * (n >> 7) + sl + (mode == 2 ? 128 : 0)));
        if (WT != nullptr) *(u32x4*)(WT + (size_t)drow * Kd + k0 + 8 * c) = o;
        if (W8 != nullptr) { u32x2 q; q.x = cvt_pk4_fp8(64.f * s[0 * 33], 64.f * s[1 * 33], 64.f * s[2 * 33], 64.f * s[3 * 33]); q.y = cvt_pk4_fp8(64.f * s[4 * 33], 64.f * s[5 * 33], 64.f * s[6 * 33], 64.f * s[7 * 33]);
            *(u32x2*)(W8 + (size_t)drow * Kd + k0 + 8 * c) = q; }
    }
    WAIT_L(0); asm volatile("" ::: "memory");
}
__device__ __forceinline__ void mod_unit(Frame& F, int u) {
    const int l = u / 96, cb = u % 96;
    LAS float* sl = (LAS float*)F.lds;
    const float* c = F.in[I_C]; const float* cc = F.in[I_CCTX];
    for (int idx = F.tid; idx < 33 * 1024; idx += 512) { const int r = idx >> 10, k = idx & 1023; const float cv = (r < 32) ? c[r * 1024 + k] : cc[k]; sl[idx] = cv / (1.0f + expf(-cv)); }
    SYNC();
    float acc[33];
#pragma unroll
    for (int r = 0; r < 33; ++r) acc[r] = 0.f;
    const float* W = F.in[I_WMOD] + (size_t)l * 1024 * 6144 + 64 * cb + F.lane;
    const int kb = F.wave * 128;
    for (int k0 = 0; k0 < 128; k0 += 16) {
        float wv[16];
#pragma unroll
        for (int kk = 0; kk < 16; ++kk) wv[kk] = W[(size_t)(kb + k0 + kk) * 6144];
#pragma unroll
        for (int kk = 0; kk < 16; ++kk)
#pragma unroll
            for (int r = 0; r < 33; ++r) acc[r] += sl[r * 1024 + kb + k0 + kk] * wv[kk];
    }
    SYNC();
#pragma unroll
    for (int r = 0; r < 33; ++r) sl[(F.wave * 33 + r) * 64 + F.lane] = acc[r];
    SYNC();
    float* MOD = (float*)(F.ws + WS_MOD);
    for (int idx = F.tid; idx < 33 * 64; idx += 512) {
        const int r = idx >> 6, cl = idx & 63; float s = 0.f;
#pragma unroll
        for (int w = 0; w < 8; ++w) s += sl[(w * 33 + r) * 64 + cl];
        MOD[(size_t)(l * 33 + r) * 6144 + 64 * cb + cl] = s + F.in[I_BMOD][l * 6144 + 64 * cb + cl];
    }
    SYNC();
}
__device__ __forceinline__ void phase_pro(Frame& F) {
    for (int u = blockIdx.x; u < 192; u += F.G) mod_unit(F, u);
    if (blockIdx.x == F.G - 1) {
        float* TB = (float*)(F.ws + WS_TAB);
        for (int idx = F.tid; idx < 1024; idx += 512) { const int pos = idx >> 4, i = idx & 15; const float inv = 1.0f / powf(10000.0f, (float)i / 16.0f); const float a = (float)pos * inv; TB[TB_R64C + idx] = cosf(a); TB[TB_R64S + idx] = sinf(a); }
        for (int idx = F.tid; idx < 512; idx += 512) { const int pos = idx >> 3, i = idx & 7; const float inv = 1.0f / powf(10000.0f, (float)i / 8.0f); const float a = (float)pos * inv; TB[TB_R32C + idx] = cosf(a); TB[TB_R32S + idx] = sinf(a); }
        if (F.tid < 2) {
            const int l = F.tid; const float* lp = F.in[I_DLAM] + l * 128; float s1 = 0.f, s2 = 0.f;
            for (int i = 0; i < 32; ++i) { s1 += lp[i] * lp[32 + i]; s2 += lp[64 + i] * lp[96 + i]; }
            const float lam_init = 0.8f - 0.6f * expf(-0.3f * (float)l);
            float* sc = TB + TB_SC + 16 * l;
            sc[0] = expf(s1) - expf(s2) + lam_init; sc[1] = 1.0f - lam_init;
            for (int d = 0; d < 2; ++d) for (int h = 0; h < 4; ++h) sc[2 + 4 * d + h] = log1pf(-expf(F.in[I_RLD][l * 8 + d * 4 + h])) * LOG2E;
        }
    }
    LAS float* scr = (LAS float*)(F.lds + F.wave * 16384);
    const int gw = blockIdx.x * 8 + F.wave, NGW = F.G * 8;
    constexpr int I_IN = 16 * 224, I_BRN = 4 * 32, I_OUT = 16 * 32, I_GE = 16 * 16, I_DE = 8 * 32;
    constexpr int PER_LAYER = I_IN + 4 * I_BRN + I_OUT + 16 * (2 * I_GE + I_DE);
    for (int it = gw; it < 2 * PER_LAYER; it += NGW) {
        const int l = it / PER_LAYER; int r = it % PER_LAYER;
        if (r < I_IN) { tr_item(F.in[I_WIN] + (size_t)l * 1024 * INW, INW, (bf16_t*)nullptr, 1024, 64 * (r / 224), 32 * (r % 224), (32 * (r % 224) >= 3072) ? 3 : 0, scr, F.lane, F.ws + WS_WIN8 + (size_t)l * INW * 1024); continue; } r -= I_IN;
        if (r < 4 * I_BRN) { const int n = r / I_BRN; r %= I_BRN; tr_item(F.in[I_WBR] + (size_t)(l * 4 + n) * 256 * 1024, 1024, (bf16_t*)nullptr, 256, 64 * (r / 32), 32 * (r % 32), 3, scr, F.lane, F.ws + WS_WBR + (size_t)(l * 4 + n) * 1024 * 256); continue; } r -= 4 * I_BRN;
        if (r < I_OUT) { tr_item(F.in[I_WOUT] + (size_t)l * 1024 * 1024, 1024, (bf16_t*)nullptr, 1024, 64 * (r / 32), 32 * (r % 32), 0, scr, F.lane, F.ws + WS_WOUT + (size_t)l * 1024 * 1024); continue; } r -= I_OUT;
        const int e = r / (2 * I_GE + I_DE); r %= (2 * I_GE + I_DE);
        const size_t le = (size_t)(l * 16 + e);
        if (r < I_GE) { tr_item(F.in[I_WG] + le * 1024 * 512, 512, (bf16_t*)nullptr, 1024, 64 * (r / 16), 32 * (r % 16), 1, scr, F.lane, F.ws + WS_WGU + le * 1024 * 1024); continue; } r -= I_GE;
        if (r < I_GE) { tr_item(F.in[I_WU] + le * 1024 * 512, 512, (bf16_t*)nullptr, 1024, 64 * (r / 16), 32 * (r % 16), 2, scr, F.lane, F.ws + WS_WGU + le * 1024 * 1024); continue; } r -= I_GE;
        tr_item(F.in[I_WD] + le * 512 * 1024, 1024, (bf16_t*)nullptr, 512, 64 * (r / 32), 32 * (r % 32), 0, scr, F.lane, F.ws + WS_WD + le * 1024 * 512);
    }
    SYNC();
}

__device__ __forceinline__ void row_load(const float* xrow, int lane, f32x4 (&v)[4]) {
    const f32x4* xr = (const f32x4*)xrow + lane;
#pragma unroll
    for (int j = 0; j < 4; ++j) v[j] = xr[64 * j];
}
__device__ __forceinline__ float row_rstd(const f32x4 (&v)[4]) {
    float s = 0.f;
#pragma unroll
    for (int j = 0; j < 4; ++j) s += (v[j].x * v[j].x + v[j].y * v[j].y) + (v[j].z * v[j].z + v[j].w * v[j].w);
    return 1.0f / sqrtf(wave_sum(s) * (1.0f / D) + EPS);
}
__device__ __forceinline__ void row_modulate(f32x4 (&v)[4], float rstd, const float* g, const float* shift, const float* scale, int lane) {
#pragma unroll
    for (int j = 0; j < 4; ++j) {
        const f32x4 gg = ((const f32x4*)g)[lane + 64 * j], sh = ((const f32x4*)shift)[lane + 64 * j], sc = ((const f32x4*)scale)[lane + 64 * j];
        v[j] = v[j] * rstd * gg * (sc + 1.0f) + sh;
    }
}
__device__ __forceinline__ void row_store_bf16(bf16_t* orow, int lane, const f32x4 (&v)[4]) {
    u32x2* o8 = (u32x2*)orow + lane;
#pragma unroll
    for (int j = 0; j < 4; ++j) { u32x2 w; w.x = cvt_pk_bf16(v[j].x, v[j].y); w.y = cvt_pk_bf16(v[j].z, v[j].w); o8[64 * j] = w; }
}
__device__ __forceinline__ void row_store_fp8(unsigned char* orow, int lane, const f32x4 (&v)[4]) {
    unsigned* o4 = (unsigned*)orow + lane;
#pragma unroll
    for (int j = 0; j < 4; ++j) o4[64 * j] = cvt_pk4_fp8(v[j].x, v[j].y, v[j].z, v[j].w);
}
__device__ __forceinline__ const float* mod_ptr(Frame& F, int layer, int row) {
    const int b = (row < TLAT) ? (row >> 11) : 32;
    return (const float*)(F.ws + WS_MOD) + (size_t)(layer * 33 + b) * 6144;
}
__device__ __forceinline__ void phase_norm1_l0(Frame& F) {
    const int gw = blockIdx.x * 8 + F.wave, NGW = F.G * 8;
    bf16_t* XH = (bf16_t*)(F.ws + WS_XH);
    for (int row = gw; row < T; row += NGW) {
        const float* xrow = (row < TLAT) ? F.in[I_X] + (size_t)row * D : F.in[I_CTX] + (size_t)(row - TLAT) * D;
        f32x4 v[4]; row_load(xrow, F.lane, v);
        const float rstd = row_rstd(v);
        const float* mp = mod_ptr(F, 0, row);
        row_modulate(v, rstd, F.in[I_G1], mp, mp + 1024, F.lane);
        row_store_fp8((unsigned char*)F.out + OUT_XH8 + (size_t)row * D, F.lane, v);
    }
}

__device__ __forceinline__ bool inproj_is_m8(int pn, int wc) { return pn == 3 || pn == 4 || pn == 7 || (pn == 8 && wc < 2); }
__device__ __forceinline__ void epi_inproj(Frame& F, const f32x4 (&acc)[2][2][4][2], const GeoT& g, int pm, int pn, int layer) {
    bf16_t* P = (bf16_t*)(F.ws + WS_P);
    const float* TB = (const float*)(F.ws + WS_TAB);
    const bool lat = pm < 256;
    const bool m8 = inproj_is_m8(pn, g.wc);
    int mode = 0; float scale = 1.0f; const float* gain = nullptr;
    switch (pn) {
        case 0: scale = 0.125f * LOG2E; break;
        case 3: mode = 2; break;
        case 4: mode = 2; scale = 0.125f; break;
        case 6: mode = 4; break;
        case 7: mode = 5; scale = 0.125f * LOG2E; gain = F.in[I_QG] + layer * 64; break;
        case 8: if (g.wc < 2) { mode = 5; gain = F.in[I_KG] + layer * 64; } break;
        case 9: mode = 7; scale = 0.17677669529663687f * LOG2E; break;
        case 10: mode = 7; break;
        default: break;
    }
    const int c0 = m8 ? (32 * (g.fq >> 1) + 8 * (g.fq & 1)) : 16 * g.fq;
    const int cstep = m8 ? 16 : 8;
#pragma unroll
    for (int ai = 0; ai < 2; ++ai)
#pragma unroll
        for (int m = 0; m < 4; ++m) {
            const int row = pm * 256 + ai * 128 + g.wr * 64 + m * 16 + g.fr;
            const int t = row & 2047, gr = t >> 6, gc = t & 63;
            float x[2][8];
#pragma unroll
            for (int n = 0; n < 2; ++n)
#pragma unroll
                for (int bj = 0; bj < 2; ++bj)
#pragma unroll
                    for (int j = 0; j < 4; ++j) x[n][4 * bj + j] = acc[ai][bj][m][n][j] * 0.015625f;
            if (mode == 5) {
                float ss = 0.f;
#pragma unroll
                for (int n = 0; n < 2; ++n)
#pragma unroll
                    for (int e = 0; e < 8; ++e) ss += x[n][e] * x[n][e];
                ss += __shfl_xor(ss, 16); ss += __shfl_xor(ss, 32);
                const float r = 1.0f / sqrtf(ss * (1.0f / 64.0f) + EPS);
#pragma unroll
                for (int n = 0; n < 2; ++n) { const f32x4 g0 = *(const f32x4*)(gain + c0 + cstep * n), g1 = *(const f32x4*)(gain + c0 + cstep * n + 4);
#pragma unroll
                    for (int e = 0; e < 4; ++e) { x[n][e] *= r * g0[e]; x[n][4 + e] *= r * g1[e]; } }
            }
            if ((mode == 2 || mode == 5) && lat) {
                const int pos = (g.fq >> 1) ? gc : gr; const int fo = pos * 16 + 8 * (g.fq & 1);
                const f32x4 ca = *(const f32x4*)(TB + TB_R64C + fo), cb = *(const f32x4*)(TB + TB_R64C + fo + 4), sa = *(const f32x4*)(TB + TB_R64S + fo), sb = *(const f32x4*)(TB + TB_R64S + fo + 4);
#pragma unroll
                for (int e = 0; e < 8; ++e) { const float cs = e < 4 ? ca[e & 3] : cb[e & 3], sn = e < 4 ? sa[e & 3] : sb[e & 3]; const float x1 = x[0][e], x2 = x[1][e]; x[0][e] = x1 * cs - x2 * sn; x[1][e] = x2 * cs + x1 * sn; }
            }
            if (mode == 7 && lat) {
                const int pos = (g.fq & 1) ? gc : gr; const int fo = pos * 8;
                const f32x4 ca = *(const f32x4*)(TB + TB_R32C + fo), cb = *(const f32x4*)(TB + TB_R32C + fo + 4), sa = *(const f32x4*)(TB + TB_R32S + fo), sb = *(const f32x4*)(TB + TB_R32S + fo + 4);
#pragma unroll
                for (int e = 0; e < 8; ++e) { const float cs = e < 4 ? ca[e & 3] : cb[e & 3], sn = e < 4 ? sa[e & 3] : sb[e & 3]; const float x1 = x[0][e], x2 = x[1][e]; x[0][e] = x1 * cs - x2 * sn; x[1][e] = x2 * cs + x1 * sn; }
            }
            bf16_t* prow = P + (size_t)row * PW + pn * 256 + g.wc * 64 + c0;
#pragma unroll
            for (int n = 0; n < 2; ++n) {
                float o[8];
#pragma unroll
                for (int e = 0; e < 8; ++e) { float y = x[n][e] * scale; if (mode == 4) y = siluf_(y); o[e] = y; }
                u32x4 w; w.x = cvt_pk_bf16(o[0], o[1]); w.y = cvt_pk_bf16(o[2], o[3]); w.z = cvt_pk_bf16(o[4], o[5]); w.w = cvt_pk_bf16(o[6], o[7]);
                *(u32x4*)(prow + cstep * n) = w;
            }
        }
}
struct SchedInproj {
    struct Unit { const char* a; const char* b; int pm, pn; };
    const char* A; const char* B; int G, c;
    __device__ __forceinline__ bool next(int i, Unit& u) const {
        int pm, pn; if (!unit_order(i * G + c, T / 256, 12, pm, pn)) return false;
        u.pm = pm; u.pn = pn; u.a = A + (size_t)pm * 256 * 1024; u.b = B + (size_t)pn * 256 * 1024; return true; }
    __device__ __forceinline__ void gather(const Unit&, unsigned (&)[2][2]) const {}
    int R0, R1, C0, C1;
    __device__ __forceinline__ unsigned slot_off(int pn, int rho, int C) const {
        const int wc = rho >> 5, n = (rho >> 4) & 1, fq = (rho >> 2) & 3, j = rho & 3;
        const int hc = inproj_is_m8(pn, wc) ? (32 * (fq >> 1) + 8 * (fq & 1) + 16 * n + j) : (16 * fq + 8 * n + j);
        return (unsigned)(64 * wc + hc) * 1024u + (unsigned)C * 2u; }
    __device__ __forceinline__ void boff(const Unit& u, const unsigned (&)[2], unsigned (&v)[2]) const { v[0] = slot_off(u.pn, R0, C0); v[1] = slot_off(u.pn, R1, C1); }
};
struct EpiInproj { Frame F; int layer;
    __device__ __forceinline__ void operator()(const f32x4 (&acc)[2][2][4][2], const SchedInproj::Unit& u, const GeoT& g_) const { GeoT g = g_; asm volatile("" : "+v"(g.fr), "+v"(g.fq)); Frame f = F; epi_inproj(f, acc, g, u.pm, u.pn, layer); } };
__device__ __forceinline__ void phase_inproj(Frame& F, int layer) {
    const GeoT g = make_geo(F.tid);
    SchedInproj S; S.A = (const char*)F.out + OUT_XH8; S.B = (const char*)(F.ws + WS_WIN8) + (size_t)layer * INW * 1024; S.G = F.G; S.c = blockIdx.x;
    S.R0 = g.R[0]; S.R1 = g.R[1]; S.C0 = g.C[0]; S.C1 = g.C[1];
    EpiInproj E; E.F = F; E.layer = layer;
    unsigned voffA[2], voffB[2] = {0u, 0u};
#pragma unroll
    for (int i = 0; i < 2; ++i) voffA[i] = (unsigned)g.R[i] * 1024u + (unsigned)g.C[i] * 2u;
    gemm_stream<false, true>(F.lds, S, E, 8, voffA, 128u * 1024u, voffB, 4u * 1024u, g);
}

constexpr int AL_K = 0, AL_V = 16384, AL_WSF = 32768, AL_OST = 36864, AL_TAB = 102400;
typedef short v4i16_t __attribute__((ext_vector_type(4)));
__device__ __forceinline__ int crow(int r, int hi) { return (r & 3) + 8 * (r >> 2) + 4 * hi; }
__device__ __forceinline__ f32x16 mfma32(bf16x8 a, bf16x8 b, f32x16 c) { return __builtin_amdgcn_mfma_f32_32x32x16_bf16(a, b, c, 0, 0, 0); }
__device__ __forceinline__ s16x4 vtr(const LAS unsigned char* p) { return __builtin_bit_cast(s16x4, __builtin_amdgcn_ds_read_tr16_b64_v4i16((LAS v4i16_t*)p)); }
__device__ __forceinline__ f32x16 f16zero() { f32x16 z;
#pragma unroll
    for (int r = 0; r < 16; ++r) z[r] = 0.f;
    return z; }

template <int D0LO, int D0HI>
__device__ __forceinline__ void qk_tile(f32x16& p0, f32x16& p1, const LAS unsigned char* Kb, const bf16x8 (&qr)[4], int r32, int hi, float cm) {
    const LAS unsigned char* kb = Kb + hi * 1024 + r32 * 16;
    f32x16 cinit;
#pragma unroll
    for (int r = 0; r < 16; ++r) cinit[r] = cm;
    p0 = cinit; p1 = cinit;
#pragma unroll
    for (int d0 = D0LO; d0 < D0HI; ++d0) {
        const bf16x8 b0 = *(const LAS bf16x8*)(kb + d0 * 2048), b1 = *(const LAS bf16x8*)(kb + d0 * 2048 + 512);
        p0 = mfma32(b0, qr[d0], p0); p1 = mfma32(b1, qr[d0], p1);
    }
}
__device__ __forceinline__ float sm_tile(f32x16& p0, f32x16& p1, float& m, float& l) {
    float mx = fmaxf(p0[0], p1[0]);
#pragma unroll
    for (int r = 1; r < 16; ++r) mx = fmaxf(mx, fmaxf(p0[r], p1[r]));
    mx = fmaxf(mx, __shfl_xor(mx, 32));
    const float mn = fmaxf(m, mx), alpha = __builtin_amdgcn_exp2f(m - mn);
    m = mn; float s = 0.f;
#pragma unroll
    for (int r = 0; r < 16; ++r) { p0[r] = __builtin_amdgcn_exp2f(p0[r] - mn); p1[r] = __builtin_amdgcn_exp2f(p1[r] - mn); s += p0[r] + p1[r]; }
    l = l * alpha + s;
    return alpha;
}
__device__ __forceinline__ float max3f(float a, float b, float c) { float d; asm("v_max3_f32 %0, %1, %2, %3" : "=v"(d) : "v"(a), "v"(b), "v"(c)); return d; }
__device__ __forceinline__ float tile_rowmax(const f32x16& p0, const f32x16& p1) {
    float ma = max3f(p0[0], p0[1], p0[2]), mb = max3f(p1[0], p1[1], p1[2]);
#pragma unroll
    for (int r = 3; r < 15; r += 2) { ma = max3f(ma, p0[r], p0[r + 1]); mb = max3f(mb, p1[r], p1[r + 1]); }
    float mx = max3f(ma, mb, p0[15]);
    mx = max3f(mx, p1[15], p1[15]);
    { auto rr = __builtin_amdgcn_permlane32_swap(__float_as_uint(mx), __float_as_uint(mx), false, false); mx = max3f(__uint_as_float(rr[0]), __uint_as_float(rr[1]), __uint_as_float(rr[1])); }
    return mx;
}
__device__ __forceinline__ void v_frags(bf16x8 (&vf)[2][4], const LAS unsigned char* Vb, int lane, int hi) {
    const LAS unsigned char* vp = Vb + ((lane >> 4) & 1) * 32 + (lane & 3) * 8 + (4 * hi + ((lane & 15) >> 2)) * 64;
#pragma unroll
    for (int ks = 0; ks < 4; ++ks)
#pragma unroll
        for (int d0 = 0; d0 < 2; ++d0) {
            const s16x4 lo = vtr(vp + d0 * 4096 + ks * 1024), hh = vtr(vp + d0 * 4096 + ks * 1024 + 512);
            vf[d0][ks] = (bf16x8){lo[0], lo[1], lo[2], lo[3], hh[0], hh[1], hh[2], hh[3]};
        }
}
__device__ __forceinline__ void k_frags(bf16x8 (&kf)[4][2], const LAS unsigned char* Kb, int r32, int hi) {
    const LAS unsigned char* kb = Kb + hi * 1024 + r32 * 16;
#pragma unroll
    for (int d0 = 0; d0 < 4; ++d0) { kf[d0][0] = *(const LAS bf16x8*)(kb + d0 * 2048); kf[d0][1] = *(const LAS bf16x8*)(kb + d0 * 2048 + 512); }
}
__device__ __forceinline__ void pv_mma(f32x16 (&o)[2], const bf16x8 (&pw)[4], const bf16x8 (&vf)[2][4]) {
#pragma unroll
    for (int ks = 0; ks < 4; ++ks) { o[0] = mfma32(pw[ks], vf[0][ks], o[0]); o[1] = mfma32(pw[ks], vf[1][ks], o[1]); }
}
template <int D0LO, int D0HI>
__device__ __forceinline__ void qk_mma(f32x16& p0, f32x16& p1, const bf16x8 (&kf)[4][2], const bf16x8 (&qr)[4], float cm) {
    f32x16 cinit;
#pragma unroll
    for (int r = 0; r < 16; ++r) cinit[r] = cm;
    p0 = cinit; p1 = cinit;
#pragma unroll
    for (int d0 = D0LO; d0 < D0HI; ++d0) { p0 = mfma32(kf[d0][0], qr[d0], p0); p1 = mfma32(kf[d0][1], qr[d0], p1); }
}
__device__ __forceinline__ bool sm_tile2(f32x16& p0, f32x16& p1, float& m, float& l, float& f, bool first) {
    const float mx = tile_rowmax(p0, p1);
    bool resc = false; f = 1.0f;
    if (first || __any(mx > 8.0f)) {
        const float dl = first ? mx : fmaxf(mx, 0.0f);
        m += dl;
#pragma unroll
        for (int r = 0; r < 16; ++r) { p0[r] -= dl; p1[r] -= dl; }
        f = __builtin_amdgcn_exp2f(-dl); l *= f; resc = true;
    }
    float s = 0.f;
#pragma unroll
    for (int r = 0; r < 16; ++r) { p0[r] = __builtin_amdgcn_exp2f(p0[r]); p1[r] = __builtin_amdgcn_exp2f(p1[r]); s += p0[r] + p1[r]; }
    l += s;
    asm volatile("" : "+v"(l));
    return resc;
}
__device__ __forceinline__ void o_scale(f32x16 (&o)[2], float f, LAS float* wsf, int r32, int hi) {
    asm volatile("" ::: "memory");
    if (hi == 0) wsf[r32] = f;
    asm volatile("s_waitcnt lgkmcnt(0)" ::: "memory");
#pragma unroll
    for (int r = 0; r < 16; ++r) { const float g = wsf[crow(r, hi)]; o[0][r] *= g; o[1][r] *= g; }
    asm volatile("s_waitcnt lgkmcnt(0)" ::: "memory");
}
__device__ __forceinline__ void pack_p(const f32x16& p0, const f32x16& p1, bf16x8 (&pw)[4]) {
    u32x4 w;
    w.x = cvt_pk_bf16(p0[0], p0[1]); w.y = cvt_pk_bf16(p0[2], p0[3]); w.z = cvt_pk_bf16(p0[4], p0[5]); w.w = cvt_pk_bf16(p0[6], p0[7]); pw[0] = __builtin_bit_cast(bf16x8, w);
    w.x = cvt_pk_bf16(p0[8], p0[9]); w.y = cvt_pk_bf16(p0[10], p0[11]); w.z = cvt_pk_bf16(p0[12], p0[13]); w.w = cvt_pk_bf16(p0[14], p0[15]); pw[1] = __builtin_bit_cast(bf16x8, w);
    w.x = cvt_pk_bf16(p1[0], p1[1]); w.y = cvt_pk_bf16(p1[2], p1[3]); w.z = cvt_pk_bf16(p1[4], p1[5]); w.w = cvt_pk_bf16(p1[6], p1[7]); pw[2] = __builtin_bit_cast(bf16x8, w);
    w.x = cvt_pk_bf16(p1[8], p1[9]); w.y = cvt_pk_bf16(p1[10], p1[11]); w.z = cvt_pk_bf16(p1[12], p1[13]); w.w = cvt_pk_bf16(p1[14], p1[15]); pw[3] = __builtin_bit_cast(bf16x8, w);
}
__device__ __forceinline__ void pv_tile(f32x16 (&o)[2], const LAS unsigned char* Vb, const bf16x8 (&pw)[4], int lane, int hi) {
    const LAS unsigned char* vp = Vb + ((lane >> 4) & 1) * 32 + (lane & 3) * 8 + (4 * hi + ((lane & 15) >> 2)) * 64;
#pragma unroll
    for (int d0 = 0; d0 < 2; ++d0)
#pragma unroll
        for (int ks = 0; ks < 4; ++ks) {
            const s16x4 lo = vtr(vp + d0 * 4096 + ks * 1024), hh = vtr(vp + d0 * 4096 + ks * 1024 + 512);
            const bf16x8 vf = (bf16x8){lo[0], lo[1], lo[2], lo[3], hh[0], hh[1], hh[2], hh[3]};
            o[d0] = mfma32(pw[ks], vf, o[d0]);
        }
}
__device__ __forceinline__ void o_stage(const f32x16 (&o)[2], LAS float* ost, int r32, int hi) {
#pragma unroll
    for (int r = 0; r < 16; ++r) { const int q = crow(r, hi); ost[q * 64 + r32] = o[0][r]; ost[q * 64 + 32 + r32] = o[1][r]; }
    asm volatile("s_waitcnt lgkmcnt(0)" ::: "memory");
}
__device__ __forceinline__ void stage_row_read(const LAS float* ost, int lane, float (&x)[32]) {
    const LAS f32x4* s = (const LAS f32x4*)(ost + (lane >> 1) * 64 + (lane & 1) * 32);
#pragma unroll
    for (int i = 0; i < 8; ++i) { const f32x4 v = s[i]; x[4 * i] = v.x; x[4 * i + 1] = v.y; x[4 * i + 2] = v.z; x[4 * i + 3] = v.w; }
    asm volatile("s_waitcnt lgkmcnt(0)" ::: "memory");
}
__device__ __forceinline__ void store_row32_f8(unsigned char* dst, const float (&x)[32]) {
#pragma unroll
    for (int i = 0; i < 2; ++i) { u32x4 w;
        w.x = cvt_pk4_fp8(8.f * x[16 * i], 8.f * x[16 * i + 1], 8.f * x[16 * i + 2], 8.f * x[16 * i + 3]); w.y = cvt_pk4_fp8(8.f * x[16 * i + 4], 8.f * x[16 * i + 5], 8.f * x[16 * i + 6], 8.f * x[16 * i + 7]);
        w.z = cvt_pk4_fp8(8.f * x[16 * i + 8], 8.f * x[16 * i + 9], 8.f * x[16 * i + 10], 8.f * x[16 * i + 11]); w.w = cvt_pk4_fp8(8.f * x[16 * i + 12], 8.f * x[16 * i + 13], 8.f * x[16 * i + 14], 8.f * x[16 * i + 15]);
        ((u32x4*)dst)[i] = w; }
}
__device__ __forceinline__ void store_row32(bf16_t* dst, const float (&x)[32]) {
#pragma unroll
    for (int i = 0; i < 4; ++i) { u32x4 w; w.x = cvt_pk_bf16(x[8 * i], x[8 * i + 1]); w.y = cvt_pk_bf16(x[8 * i + 2], x[8 * i + 3]); w.z = cvt_pk_bf16(x[8 * i + 4], x[8 * i + 5]); w.w = cvt_pk_bf16(x[8 * i + 6], x[8 * i + 7]); ((u32x4*)dst)[i] = w; }
}

struct SmUnit {
    int qrow, qcol, kcol, vcol, ycol;
    int n1, row1, n2, row2;
    int na_r, na_c, na_kr0;
};
#define AT_LOADKV(t) do { const int _r0 = ((t) < U.n1) ? U.row1 + 64 * (t) : U.row2 + 64 * ((t) - U.n1); \
        kreg = *(const u32x4*)(Pb + (size_t)(_r0 + lane) * (PW * 2) + (U.kcol + 8 * wid) * 2); \
        vreg = *(const u32x4*)(Pb + (size_t)(_r0 + 16 * (wid & 3) + (lane >> 2)) * (PW * 2) + (U.vcol + 32 * (wid >> 2) + 8 * (lane & 3)) * 2); } while (0)
#define AT_COMMIT(buf) do { *(LAS u32x4*)(lds + AL_K + (buf) * 8192 + wid * 1024 + lane * 16) = kreg; *(LAS u32x4*)(lds + AL_V + (buf) * 8192 + wid * 1024 + lane * 16) = vreg; } while (0)

constexpr int AL_K3 = 0, AL_V3 = 104448;
__device__ __forceinline__ void dma16(const void* gptr, unsigned ldsoff) {
    unsigned tmp; ldsoff = __builtin_amdgcn_readfirstlane(ldsoff);
    asm volatile("s_mov_b32 %0, m0\n\ts_mov_b32 m0, %1\n\ts_nop 0\n\tglobal_load_lds_dwordx4 %2, off\n\ts_mov_b32 m0, %0" : "=&s"(tmp) : "s"(ldsoff), "v"(gptr) : "memory");
}
#define AT_TROW(tt) (((tt) < U.n1) ? U.row1 + 64 * (tt) : U.row2 + 64 * ((tt) - U.n1))
#define AT_DMAK(tt) do { const int _r0 = AT_TROW(tt); dma16(Pb + (size_t)(_r0 + lane) * (PW * 2) + (U.kcol + 8 * wid) * 2, \
        (unsigned)(size_t)(lds + AL_K3 + ((tt) & 3) * 8192 + wid * 1024)); } while (0)
#define AT_DMAV(tt) do { const int _r0 = AT_TROW(tt); dma16(Pb + (size_t)(_r0 + 16 * (wid & 3) + (lane >> 2)) * (PW * 2) + (U.vcol + 32 * (wid >> 2) + 8 * (lane & 3)) * 2, \
        (unsigned)(size_t)(lds + AL_V3 + ((tt) & 3) * 8192 + wid * 1024)); } while (0)
#define AT_PROLOGUE() do { AT_DMAK(0); AT_DMAV(0); if (NT > 1) { AT_DMAK(1); AT_DMAV(1); } if (NT > 2) { AT_DMAK(2); AT_DMAV(2); } if (NT > 3) AT_DMAK(3); } while (0)
#define AT_WAIT_BAR2(t) do { if ((t) + 3 < NT) asm volatile("s_waitcnt vmcnt(2) lgkmcnt(0)" ::: "memory"); else asm volatile("s_waitcnt vmcnt(0) lgkmcnt(0)" ::: "memory"); \
        __builtin_amdgcn_s_barrier(); asm volatile("" ::: "memory"); } while (0)
#define AT_WAIT_BAR(t) do { if ((t) + 3 < NT) asm volatile("s_waitcnt vmcnt(4) lgkmcnt(0)" ::: "memory"); else asm volatile("s_waitcnt vmcnt(0) lgkmcnt(0)" ::: "memory"); \
        __builtin_amdgcn_s_barrier(); asm volatile("" ::: "memory"); } while (0)
#define BAR_L() do { asm volatile("s_waitcnt lgkmcnt(0)" ::: "memory"); __builtin_amdgcn_s_barrier(); asm volatile("" ::: "memory"); } while (0)
#define A3_COMMIT(sl) do { *(LAS u32x4*)(lds + AL_K3 + (sl) * 8192 + wid * 1024 + lane * 16) = kreg; *(LAS u32x4*)(lds + AL_V3 + (sl) * 8192 + wid * 1024 + lane * 16) = vreg; } while (0)
template <bool NA>
__device__ __forceinline__ void sm_unit(Frame& F, const SmUnit& U_) {
    SmUnit U = U_; VG(U.qcol); VG(U.kcol); VG(U.vcol); VG(U.ycol); VG(U.row1); VG(U.row2);
    const char* Pb = (const char*)(F.ws + WS_P);
    LAS unsigned char* lds = F.lds;
    const int lane_ = lane_now();
    const int lane = lane_, r32 = lane & 31, hi = lane >> 5, wid = F.wave;
    const bool trail = wid >= 4;
    bf16x8 qr[4];
    { const char* qp = Pb + (size_t)U.qrow * (PW * 2) + (U.qcol + 8 * hi) * 2;
#pragma unroll
      for (int d0 = 0; d0 < 4; ++d0) qr[d0] = *(const bf16x8*)(qp + d0 * 32); }
    const int NT = U.n1 + U.n2;
    AT_PROLOGUE();
    SYNC();
    float m = 0.f, l = 0.f; f32x16 o[2]; o[0] = f16zero(); o[1] = f16zero();
    f32x16 p0 = f16zero(), p1 = f16zero();
    LAS float* wsf = (LAS float*)(lds + AL_WSF) + wid * 128;
    const LAS float* tab = (const LAS float*)(lds + AL_TAB);
    const int na_r0 = min(max(U.na_r - 4, 0), 24), na_ws = min(max(U.na_c - 8, 0), 48);
#define SM_ACTIVE(tt) (!(NA && (tt) >= U.n1) || ((U.na_kr0 + ((tt) - U.n1)) >= na_r0 && (U.na_kr0 + ((tt) - U.n1)) < na_r0 + 8))
    bool act = SM_ACTIVE(0);
    if (act) qk_tile<0, 4>(p0, p1, lds + AL_K3, qr, r32, hi, 0.0f);
    bool seen = false;
    bf16x8 vf[2][4], kf[4][2];
    bool actn = (NT > 1) && SM_ACTIVE(1);
    if (act) v_frags(vf, lds + AL_V3, lane, hi);
    if (actn) k_frags(kf, lds + AL_K3 + 8192, r32, hi);
    if (trail) BAR_L();
    for (int t = 0; t < NT; ++t) {
        bf16x8 pw[4];
        if (act) {
            if (NA && t >= U.n1) { const int _kr = U.na_kr0 + (t - U.n1); const LAS float* trow = tab + (_kr - U.na_r + 7) * 31 + 15 - U.na_c;
#pragma unroll
                for (int r = 0; r < 16; ++r) { const int kc0 = crow(r, hi), kc1 = kc0 + 32;
                    const bool v0 = (unsigned)(kc0 - na_ws) < 16u, v1 = (unsigned)(kc1 - na_ws) < 16u;
                    const float b0 = trow[v0 ? kc0 : U.na_c], b1 = trow[v1 ? kc1 : U.na_c];
                    p0[r] = v0 ? p0[r] + b0 : -1e30f; p1[r] = v1 ? p1[r] + b1 : -1e30f; } }
            float fsc; const bool resc = sm_tile2(p0, p1, m, l, fsc, !seen); seen = true;
            if (resc) o_scale(o, fsc, wsf, r32, hi);
            pack_p(p0, p1, pw);
        }
        AT_WAIT_BAR2(t);
        if (t + 4 < NT) AT_DMAK(t + 4);
        if (t + 3 < NT) AT_DMAV(t + 3);
        if (act) pv_mma(o, pw, vf);
        if (actn) qk_mma<0, 4>(p0, p1, kf, qr, -m);
        __builtin_amdgcn_sched_barrier(0);
        const bool actnn = (t + 2 < NT) && SM_ACTIVE(t + 2);
        if (actn) v_frags(vf, lds + AL_V3 + ((t + 1) & 3) * 8192, lane, hi);
        if (actnn) k_frags(kf, lds + AL_K3 + ((t + 2) & 3) * 8192, r32, hi);
        act = actn; actn = actnn;
        __builtin_amdgcn_s_barrier();
        asm volatile("" ::: "memory");
    }
    if (!trail) BAR_L();
#undef SM_ACTIVE
    l += __shfl_xor(l, 32);
    o_scale(o, 1.0f / l, wsf, r32, hi);
    LAS float* ost = (LAS float*)(lds + AL_OST) + wid * 2048;
    o_stage(o, ost, r32, hi);
    float x[32]; stage_row_read(ost, lane, x);
    const int trow_q = __shfl(U.qrow, lane >> 1);
    store_row32_f8(F.ws + WS_Y + (size_t)trow_q * D + U.ycol + 32 * (lane & 1), x);
}

template <int D0LO, int D0HI>
__device__ __forceinline__ void qk_tile_l(f32x16& p0, f32x16& p1, const LAS unsigned char* Kb, const LAS unsigned char* ql, int lane, float cm) {
    const int r32 = lane & 31, hi = lane >> 5;
    const LAS unsigned char* kb = Kb + hi * 1024 + r32 * 16;
    f32x16 cinit;
#pragma unroll
    for (int r = 0; r < 16; ++r) cinit[r] = cm;
    p0 = cinit; p1 = cinit;
#pragma unroll
    for (int d0 = D0LO; d0 < D0HI; ++d0) {
        const bf16x8 q = *(const LAS bf16x8*)(ql + d0 * 1024 + lane * 16);
        const bf16x8 b0 = *(const LAS bf16x8*)(kb + d0 * 2048), b1 = *(const LAS bf16x8*)(kb + d0 * 2048 + 512);
        p0 = mfma32(b0, q, p0); p1 = mfma32(b1, q, p1);
    }
}
__device__ __forceinline__ void diff_unit(Frame& F, const SmUnit& U_, int layer) {
    SmUnit U = U_; VG(U.qcol); VG(U.kcol); VG(U.vcol); VG(U.ycol); VG(U.row1); VG(U.row2);
    const char* Pb = (const char*)(F.ws + WS_P);
    LAS unsigned char* lds = F.lds;
    const int lane_ = lane_now();
    const int lane = lane_, r32 = lane & 31, hi = lane >> 5, wid = F.wave;
    const bool trail = wid >= 4;
    LAS float* ost = (LAS float*)(lds + AL_OST) + wid * 2048;
    LAS unsigned char* ql = (LAS unsigned char*)ost;
    { const char* qp = Pb + (size_t)U.qrow * (PW * 2) + (U.qcol + 8 * hi) * 2;
#pragma unroll
      for (int d0 = 0; d0 < 4; ++d0) *(LAS bf16x8*)(ql + d0 * 1024 + lane * 16) = *(const bf16x8*)(qp + d0 * 32); }
    const int NT = U.n1 + U.n2;
    AT_PROLOGUE();
    SYNC();
    float m0 = 0.f, l0 = 0.f, m1 = 0.f, l1 = 0.f; f32x16 oa[2], ob[2]; oa[0] = f16zero(); oa[1] = f16zero(); ob[0] = f16zero(); ob[1] = f16zero();
    f32x16 pa0, pa1, pb0, pb1;
    qk_tile_l<0, 2>(pa0, pa1, lds + AL_K3, ql, lane, 0.0f);
    qk_tile_l<2, 4>(pb0, pb1, lds + AL_K3, ql, lane, 0.0f);
    LAS float* wsf = (LAS float*)(lds + AL_WSF) + wid * 128;
    if (trail) BAR_L();
    for (int t = 0; t < NT; ++t) {
        bf16x8 pwa[4], pwb[4];
        { float fsc; if (sm_tile2(pa0, pa1, m0, l0, fsc, t == 0)) o_scale(oa, fsc, wsf, r32, hi); pack_p(pa0, pa1, pwa); }
        { float fsc; if (sm_tile2(pb0, pb1, m1, l1, fsc, t == 0)) o_scale(ob, fsc, wsf, r32, hi); pack_p(pb0, pb1, pwb); }
        AT_WAIT_BAR(t);
        if (t + 4 < NT) AT_DMAK(t + 4);
        if (t + 3 < NT) AT_DMAV(t + 3);
        { bf16x8 vf[2][4];
          v_frags(vf, lds + AL_V3 + (t & 3) * 8192, lane, hi);
          __builtin_amdgcn_sched_barrier(0);
          pv_mma(oa, pwa, vf);
          pv_mma(ob, pwb, vf);
          __builtin_amdgcn_sched_barrier(0); }
        if (t + 1 < NT) { qk_tile_l<0, 2>(pa0, pa1, lds + AL_K3 + ((t + 1) & 3) * 8192, ql, lane, -m0); qk_tile_l<2, 4>(pb0, pb1, lds + AL_K3 + ((t + 1) & 3) * 8192, ql, lane, -m1); }
        BAR_L();
    }
    if (!trail) BAR_L();
    const float* SC = (const float*)(F.ws + WS_TAB) + TB_SC + 16 * layer;
    const float lam = SC[0], post = SC[1];
    l0 += __shfl_xor(l0, 32); l1 += __shfl_xor(l1, 32);
    o_scale(oa, 1.0f / l0, wsf, r32, hi);
    o_scale(ob, -lam / l1, wsf, r32, hi);
#pragma unroll
    for (int r = 0; r < 16; ++r) { oa[0][r] += ob[0][r]; oa[1][r] += ob[1][r]; }
    o_stage(oa, ost, r32, hi);
    float x[32]; stage_row_read(ost, lane, x);
    float ss = 0.f;
#pragma unroll
    for (int i = 0; i < 32; ++i) ss += x[i] * x[i];
    ss += __shfl_xor(ss, 1);
    const float rn = post / sqrtf(ss * (1.0f / 64.0f) + EPS);
    const float* gain = F.in[I_DSUB] + layer * 64 + 32 * (lane & 1);
#pragma unroll
    for (int i = 0; i < 32; ++i) x[i] = x[i] * rn * gain[i];
    const int trow_q = __shfl(U.qrow, lane >> 1);
    store_row32_f8(F.ws + WS_Y + (size_t)trow_q * D + U.ycol + 32 * (lane & 1), x);
}

__device__ __forceinline__ int ret_chunk_row(int b, int ci) { return (ci < 2) ? TLAT + b * 256 + 128 * ci : b * 2048 + 128 * (ci - 2); }
__device__ __forceinline__ int ret_bpos(int ci) { return ci == 0 ? 1 : (ci == 1 ? 0 : 19 - ci); }
__device__ __forceinline__ void ret_unit(Frame& F, int layer, int b, int h, int cp) {
    const char* Pb = (const char*)(F.ws + WS_P);
    LAS unsigned char* lds = F.lds;
    const int lane_ = lane_now();
    const int lane = lane_, r32 = lane & 31, hi = lane >> 5, wid = F.wave;
    const float* SC = (const float*)(F.ws + WS_TAB) + TB_SC + 16 * layer;
    const float lgf = SC[2 + h], lgb = SC[6 + h];
    const int ccw = wid >> 2, ciw = 2 * cp + ccw, tq = 32 * (wid & 3) + r32;
    const int qrow = ret_chunk_row(b, ciw) + tq;
    bf16x8 qr[4];
    { const char* qp = Pb + (size_t)qrow * (PW * 2) + (C_RQ + 64 * h + 8 * hi) * 2;
#pragma unroll
      for (int d0 = 0; d0 < 4; ++d0) qr[d0] = *(const bf16x8*)(qp + d0 * 32); }
    const float* KV = (const float*)(F.ws + WS_RETKV) + (size_t)((b * 4 + h) * NCHUNK) * 2 * 4096;
    u32x4 kreg, vreg;
    const int sd = 16 * (wid & 3) + (lane >> 2), se = 32 * (wid >> 2) + 8 * (lane & 3);
#define RT_LOAD(t) do { const int _cc = (t) >> 2, _kind = (t) & 3, _c2 = 2 * cp + _cc; \
        if (_kind < 2) { const int _r0 = ret_chunk_row(b, _c2) + 64 * _kind; \
            kreg = *(const u32x4*)(Pb + (size_t)(_r0 + lane) * (PW * 2) + (C_RK + 64 * h + 8 * wid) * 2); \
            vreg = *(const u32x4*)(Pb + (size_t)(_r0 + sd) * (PW * 2) + (C_RV + 64 * h + se) * 2); \
        } else { \
            const int _e = lane - 8 * wid; kreg = (u32x4){0u, 0u, 0u, 0u}; \
            if (_e >= 0 && _e < 8) { const unsigned _one = (_e & 1) ? 0x3F800000u : 0x00003F80u; if ((_e >> 1) == 0) kreg.x = _one; else if ((_e >> 1) == 1) kreg.y = _one; else if ((_e >> 1) == 2) kreg.z = _one; else kreg.w = _one; } \
            const int _dir = _kind - 2; const f32x4* _p = (const f32x4*)(KV + (size_t)(_c2 * 2 + _dir) * 4096 + sd * 64 + se); const f32x4 _a = _p[0], _b = _p[1]; \
            const float _s[8] = {_a.x, _a.y, _a.z, _a.w, _b.x, _b.y, _b.z, _b.w}; \
            vreg.x = cvt_pk_bf16(_s[0], _s[1]); vreg.y = cvt_pk_bf16(_s[2], _s[3]); vreg.z = cvt_pk_bf16(_s[4], _s[5]); vreg.w = cvt_pk_bf16(_s[6], _s[7]); } } while (0)
    RT_LOAD(0); AT_COMMIT(0); SYNC();
    f32x16 o[2]; o[0] = f16zero(); o[1] = f16zero();
    for (int t = 0; t < 8; ++t) {
        const int buf = t & 1;
        if (t + 1 < 8) RT_LOAD(t + 1);
        const int cc = t >> 2, kind = t & 3;
        if (cc == ccw) {
            f32x16 p0, p1; qk_tile<0, 4>(p0, p1, lds + AL_K + buf * 8192, qr, r32, hi, 0.0f);
            if (kind < 2) {
#pragma unroll
                for (int r = 0; r < 16; ++r) {
                    const int tk0 = 64 * kind + crow(r, hi), d0 = tq - tk0, d1 = d0 - 32;
                    const float f0 = d0 > 0 ? __builtin_amdgcn_exp2f(lgf * (float)d0) : (d0 < 0 ? __builtin_amdgcn_exp2f(lgb * (float)(-d0)) : 2.0f);
                    const float f1 = d1 > 0 ? __builtin_amdgcn_exp2f(lgf * (float)d1) : (d1 < 0 ? __builtin_amdgcn_exp2f(lgb * (float)(-d1)) : 2.0f);
                    p0[r] *= f0; p1[r] *= f1;
                }
            } else {
                const float f = (kind == 2) ? __builtin_amdgcn_exp2f(lgf * (float)(tq + 1)) : __builtin_amdgcn_exp2f(lgb * (float)(128 - tq));
#pragma unroll
                for (int r = 0; r < 16; ++r) { p0[r] *= f; p1[r] *= f; }
            }
            bf16x8 pw[4]; pack_p(p0, p1, pw);
            pv_tile(o, lds + AL_V + buf * 8192, pw, lane, hi);
        }
        if (t + 1 < 8) AT_COMMIT(buf ^ 1);
        SYNC();
    }
#undef RT_LOAD
    LAS float* ost = (LAS float*)(lds + AL_OST) + wid * 2048;
    o_stage(o, ost, r32, hi);
    float x[32]; stage_row_read(ost, lane, x);
    float s = 0.f;
#pragma unroll
    for (int i = 0; i < 32; ++i) s += x[i];
    s += __shfl_xor(s, 1);
    const float mu = s * (1.0f / 64.0f); float q = 0.f;
#pragma unroll
    for (int i = 0; i < 32; ++i) { x[i] -= mu; q += x[i] * x[i]; }
    q += __shfl_xor(q, 1);
    const float rs = 1.0f / sqrtf(q * (1.0f / 64.0f) + EPS);
    const int trow_q = __shfl(qrow, lane >> 1);
    const bf16_t* gp = (const bf16_t*)Pb + (size_t)trow_q * PW + C_RG + 64 * h + 32 * (lane & 1);
#pragma unroll
    for (int i = 0; i < 4; ++i) { const u32x4 gw = ((const u32x4*)gp)[i];
        x[8 * i + 0] *= rs * bf_lo(gw.x); x[8 * i + 1] *= rs * bf_hi(gw.x); x[8 * i + 2] *= rs * bf_lo(gw.y); x[8 * i + 3] *= rs * bf_hi(gw.y);
        x[8 * i + 4] *= rs * bf_lo(gw.z); x[8 * i + 5] *= rs * bf_hi(gw.z); x[8 * i + 6] *= rs * bf_lo(gw.w); x[8 * i + 7] *= rs * bf_hi(gw.w); }
    store_row32_f8(F.ws + WS_Y + (size_t)trow_q * D + 256 + 64 * h + 32 * (lane & 1), x);
}

__device__ __forceinline__ void phase_retkv(Frame& F, int layer) {
    const char* Pb = (const char*)(F.ws + WS_P);
    const float* SC = (const float*)(F.ws + WS_TAB) + TB_SC + 16 * layer;
    LAS unsigned char* lds = F.lds;
    const int lane = lane_now(), wid = F.wave, tid = wid * 64 + lane, hi = lane >> 5;
    const int d0 = (wid >> 1) & 1, e0 = wid & 1;
    for (int u = blockIdx.x; u < NBATCH * 4 * 2; u += F.G) {
        const int dir = u & 1, bh = u >> 1, h = bh & 3, b = bh >> 2;
        const float lg = SC[2 + 4 * dir + h];
        const float dec = __builtin_amdgcn_exp2f(lg * 128.0f);
        f32x16 S = f16zero();
        u32x4 kk[2], vv[2];
#define RK_CHUNK(p) (dir ? ((p) == 0 ? 1 : ((p) == 1 ? 0 : 19 - (p))) : (p))
#define RK_LOAD(p) do { const int _r0 = ret_chunk_row(b, RK_CHUNK(p)); \
            _Pragma("unroll") for (int it = 0; it < 2; ++it) { const int i = tid + 512 * it, s = i >> 3, c = i & 7; \
                kk[it] = *(const u32x4*)(Pb + (size_t)(_r0 + s) * (PW * 2) + (C_RK + 64 * h + 8 * c) * 2); vv[it] = *(const u32x4*)(Pb + (size_t)(_r0 + s) * (PW * 2) + (C_RV + 64 * h + 8 * c) * 2); } } while (0)
        RK_LOAD(0);
        for (int p = 0; p < NCHUNK; ++p) {
            const int j = RK_CHUNK(p);
            LAS unsigned char* buf = lds + (p & 1) * 32768;
#pragma unroll
            for (int it = 0; it < 2; ++it) {
                const int i = tid + 512 * it, s = i >> 3, c = i & 7;
                const float w = __builtin_amdgcn_exp2f(lg * (float)(dir ? s : 127 - s));
                u32x4 kw;
                kw.x = cvt_pk_bf16(bf_lo(kk[it].x) * w, bf_hi(kk[it].x) * w); kw.y = cvt_pk_bf16(bf_lo(kk[it].y) * w, bf_hi(kk[it].y) * w);
                kw.z = cvt_pk_bf16(bf_lo(kk[it].z) * w, bf_hi(kk[it].z) * w); kw.w = cvt_pk_bf16(bf_lo(kk[it].w) * w, bf_hi(kk[it].w) * w);
                const int off = (c >> 2) * 8192 + s * 64 + (c & 3) * 16;
                *(LAS u32x4*)(buf + off) = kw; *(LAS u32x4*)(buf + 16384 + off) = vv[it];
            }
            if (p + 1 < NCHUNK) RK_LOAD(p + 1);
            asm volatile("s_waitcnt lgkmcnt(0)" ::: "memory"); __builtin_amdgcn_s_barrier(); asm volatile("" ::: "memory");
            if (wid < 4) {
                float* KV = (float*)(F.ws + WS_RETKV) + (size_t)(bh * NCHUNK + j) * 2 * 4096 + dir * 4096 + (32 * d0) * 64 + 32 * e0 + (lane & 31);
#pragma unroll
                for (int r = 0; r < 16; ++r) KV[crow(r, hi) * 64] = S[r];
                const LAS unsigned char* ap = buf + d0 * 8192 + ((lane >> 4) & 1) * 32 + (lane & 3) * 8 + (4 * hi + ((lane & 15) >> 2)) * 64;
                const LAS unsigned char* bp = buf + 16384 + e0 * 8192 + ((lane >> 4) & 1) * 32 + (lane & 3) * 8 + (4 * hi + ((lane & 15) >> 2)) * 64;
#pragma unroll
                for (int r = 0; r < 16; ++r) S[r] *= dec;
#pragma unroll
                for (int ks = 0; ks < 8; ++ks) {
                    const s16x4 alo = vtr(ap + ks * 1024), ahi = vtr(ap + ks * 1024 + 512), blo = vtr(bp + ks * 1024), bhi = vtr(bp + ks * 1024 + 512);
                    const bf16x8 af = (bf16x8){alo[0], alo[1], alo[2], alo[3], ahi[0], ahi[1], ahi[2], ahi[3]};
                    const bf16x8 bf = (bf16x8){blo[0], blo[1], blo[2], blo[3], bhi[0], bhi[1], bhi[2], bhi[3]};
                    S = mfma32(af, bf, S);
                }
            }
        }
        SYNC();
#undef RK_LOAD
#undef RK_CHUNK
    }
}

__device__ __forceinline__ void phase_mixers(Frame& F, int layer) {
    const bool ctx = (layer == 0);
    const int wid = F.wave;
    for (int rep = 0; rep < (MK_REP_MIX == 0 ? 2 : 1); ++rep)
    for (int u = blockIdx.x; u < 1024 + (ctx ? 128 : 0); u += F.G) {
        const int r32 = lane_now() & 31;
        SmUnit U{};
        if (u < 1024) { const int qb = u & 7, h = (u >> 3) & 3, b = u >> 5;
            U.qrow = b * 2048 + 256 * qb + 32 * wid + r32; U.qcol = C_DQ + 64 * h; U.kcol = C_DK + 64 * h; U.vcol = C_DV + 64 * h; U.ycol = 768 + 64 * h;
            U.n1 = 32; U.row1 = b * 2048; U.n2 = 4; U.row2 = TLAT + b * 256;
        } else { const int v = u - 1024, h = v & 3, b = v >> 2;
            U.qrow = TLAT + b * 256 + 32 * wid + r32; U.qcol = C_DQ + 64 * h; U.kcol = C_DK + 64 * h; U.vcol = C_DV + 64 * h; U.ycol = 768 + 64 * h;
            U.n1 = 4; U.row1 = TLAT + b * 256; U.n2 = 0; U.row2 = 0; }
        diff_unit(F, U, layer);
    }
#if MK_DIAG
    if (blockIdx.x == 0 && threadIdx.x == 0) ((unsigned long long*)(F.ws + WS_CTL + 524288))[32 + 4 * layer + 0] = __builtin_amdgcn_s_memrealtime();
#endif
    for (int rep = 0; rep < (MK_REP_MIX == 1 ? 2 : 1); ++rep)
    for (int u = blockIdx.x; u < 1024 + (ctx ? 256 : 0); u += F.G) {
        const int r32 = lane_now() & 31;
        SmUnit U{};
        if (u < 1024) { const int qb = u & 15, kvh = (u >> 4) & 1, b = u >> 5, head = 2 * kvh + (wid >> 2);
            U.qrow = b * 2048 + 128 * qb + 32 * (wid & 3) + r32; U.qcol = C_GQ + 64 * head; U.kcol = C_GK + 64 * kvh; U.vcol = C_GV + 64 * kvh; U.ycol = 512 + 64 * head;
            U.n1 = 32; U.row1 = b * 2048; U.n2 = 4; U.row2 = TLAT + b * 256;
        } else if (u < 1152) { const int v = u - 1024, qb = v & 1, kvh = (v >> 1) & 1, b = v >> 2, head = 2 * kvh + (wid >> 2);
            U.qrow = TLAT + b * 256 + 128 * qb + 32 * (wid & 3) + r32; U.qcol = C_GQ + 64 * head; U.kcol = C_GK + 64 * kvh; U.vcol = C_GV + 64 * kvh; U.ycol = 512 + 64 * head;
            U.n1 = 4; U.row1 = TLAT + b * 256; U.n2 = 0; U.row2 = 0;
        } else { const int v = u - 1152, h = v & 3, b = v >> 2;
            U.qrow = TLAT + b * 256 + 32 * wid + r32; U.qcol = C_NAQ + 64 * h; U.kcol = C_NAK + 64 * h; U.vcol = C_NAV + 64 * h; U.ycol = 64 * h;
            U.n1 = 4; U.row1 = TLAT + b * 256; U.n2 = 0; U.row2 = 0; }
        sm_unit<false>(F, U);
    }
#if MK_DIAG
    if (blockIdx.x == 0 && threadIdx.x == 0) ((unsigned long long*)(F.ws + WS_CTL + 524288))[32 + 4 * layer + 1] = __builtin_amdgcn_s_memrealtime();
#endif
    for (int rep = 0; rep < (MK_REP_MIX == 2 ? 2 : 1); ++rep)
    for (int u = blockIdx.x; u < 1024; u += F.G) {
        const int r32 = lane_now() & 31;
        const int g = u & 7, h = (u >> 3) & 3, b = u >> 5;
        { LAS float* tab = (LAS float*)(F.lds + AL_TAB); const float* rpb = F.in[I_RPB] + (size_t)(layer * 4 + h) * 465;
          for (int i = wid * 64 + lane_now(); i < 465; i += 512) tab[i] = rpb[i] * LOG2E; }
        SmUnit U{}; U.na_r = 4 * g + (wid >> 1); U.na_c = 32 * (wid & 1) + r32;
        U.qrow = b * 2048 + 64 * U.na_r + U.na_c; U.qcol = C_NAQ + 64 * h; U.kcol = C_NAK + 64 * h; U.vcol = C_NAV + 64 * h; U.ycol = 64 * h;
        U.n1 = 4; U.row1 = TLAT + b * 256;
        const int kr0 = min(max(4 * g - 4, 0), 24), krl = min(max(4 * g + 3 - 4, 0), 24) + 7;
        U.na_kr0 = kr0; U.n2 = krl - kr0 + 1; U.row2 = b * 2048 + 64 * kr0;
        sm_unit<true>(F, U);
    }
#if MK_DIAG
    if (blockIdx.x == 0 && threadIdx.x == 0) ((unsigned long long*)(F.ws + WS_CTL + 524288))[32 + 4 * layer + 2] = __builtin_amdgcn_s_memrealtime();
#endif
    { const int npair = ctx ? 9 : 8;
      for (int rep = 0; rep < (MK_REP_MIX == 3 ? 2 : 1); ++rep)
      for (int u = blockIdx.x; u < NBATCH * 4 * npair; u += F.G) { const int cp = (u % npair) + (ctx ? 0 : 1), bh = u / npair; ret_unit(F, layer, bh >> 2, bh & 3, cp); } }
}


struct MergeState { int i, s, kt, pm, jt; bool valid; };
__device__ __forceinline__ void phase_merge(Frame& F, int layer) {
    const GeoT g = make_geo(F.tid);
    LAS unsigned char* lds = F.lds;
    const char* XH8 = (const char*)F.out + OUT_XH8;
    const char* Yb = (const char*)(F.ws + WS_Y);
    const char* Wg8 = (const char*)(F.ws + WS_WIN8) + ((size_t)layer * INW + PW) * 1024;
    const char* Wb = (const char*)(F.ws + WS_WBR) + (size_t)layer * 4 * 1024 * 256;
    bf16_t* ACC = (bf16_t*)(F.ws + WS_P);
    const int nM = (layer == 0) ? T / 256 : TLAT / 256;
    const int G = F.G, c = blockIdx.x;
    const bool trail = g.wr == 1;
    const unsigned ldsw = (unsigned)g.wid * 1024u;
    unsigned voffA[2], voffBb[2], voff8[2];
#pragma unroll
    for (int i = 0; i < 2; ++i) { voffA[i] = (unsigned)g.R[i] * 2048u + (unsigned)g.C[i] * 2u; voffBb[i] = (unsigned)g.R[i] * 256u + (unsigned)g.C[i] * 2u; voff8[i] = (unsigned)g.R[i] * 1024u + (unsigned)g.C[i] * 2u; }
    MergeState is; is.i = 0; is.s = 0; is.kt = 0; is.valid = unit_order(c, nM, 8, is.pm, is.jt);
    if (!is.valid) return;
    MergeState cs = is;
    const char* la_ptr = nullptr; const char* lb_ptr = nullptr; bool l_isg = false;
#define MG_ADV(st) do { (st).kt++; if ((st).kt == (((st).s & 1) ? 8 : 2)) { (st).kt = 0; (st).s++; if ((st).s == 8) { (st).s = 0; (st).i++; (st).valid = unit_order((st).i * G + c, nM, 8, (st).pm, (st).jt); } } } while (0)
#define MG_ISSUE(slot) do { if (is.valid) { const int _n = is.s >> 1; l_isg = (is.s & 1) != 0; \
            la_ptr = l_isg ? XH8 + (size_t)is.pm * (256 * 1024) + is.kt * 128 : Yb + _n * 256 + (size_t)is.pm * (256 * 1024) + is.kt * 128; \
            lb_ptr = l_isg ? Wg8 + (size_t)(_n * 1024 + is.jt * 128) * 1024 + is.kt * 128 : Wb + (size_t)(_n * 1024 + is.jt * 128) * 256 + is.kt * 128; } \
        LAS unsigned char* _d = lds + (slot) * 49152 + ldsw; const size_t _hs = (size_t)(128 * 1024); \
        _Pragma("unroll") for (int _h = 0; _h < 2; ++_h) _Pragma("unroll") for (int _i = 0; _i < 2; ++_i) \
            __builtin_amdgcn_global_load_lds((const unsigned*)(la_ptr + (size_t)_h * _hs + voff8[_i]), (LAS unsigned*)(_d + _h * 16384 + _i * 8192), 16, 0, 0); \
        _Pragma("unroll") for (int _i = 0; _i < 2; ++_i) \
            __builtin_amdgcn_global_load_lds((const unsigned*)(lb_ptr + (l_isg ? voff8[_i] : voffBb[_i])), (LAS unsigned*)(_d + 32768 + _i * 8192), 16, 0, 0); \
        if (is.valid) MG_ADV(is); } while (0)
    MG_ISSUE(0); MG_ISSUE(1);
    WAIT_V(6); BAR();
    if (trail) BAR();
    f32x4 acc[2][1][4][2]; acc_zero<1>(acc);
    unsigned yb[2][4][2][2], outp[2][4][2][2];
#pragma unroll
    for (int a2 = 0; a2 < 2; ++a2)
#pragma unroll
        for (int m = 0; m < 4; ++m)
#pragma unroll
            for (int nn = 0; nn < 2; ++nn) { outp[a2][m][nn][0] = 0u; outp[a2][m][nn][1] = 0u; }
    int sc = 0, si = 2;
    typedef long l64x2 __attribute__((ext_vector_type(2)));
#define MG_STEP(ISG) do { \
        const LAS unsigned char* tb = lds + sc * 49152; \
        l64x2 Bf[2][2], A0[4][2], A1[4][2]; \
        _Pragma("unroll") for (int n = 0; n < 2; ++n) _Pragma("unroll") for (int k = 0; k < 2; ++k) Bf[n][k] = *(const LAS l64x2*)(tb + 32768 + g.boffl + n * 2048 + k * 1024); \
        _Pragma("unroll") for (int m = 0; m < 4; ++m) _Pragma("unroll") for (int k = 0; k < 2; ++k) { A0[m][k] = *(const LAS l64x2*)(tb + g.aoffl + m * 2048 + k * 1024); A1[m][k] = *(const LAS l64x2*)(tb + 16384 + g.aoffl + m * 2048 + k * 1024); } \
        MG_ISSUE(si); \
        WAIT_V(6); WAIT_L(0); BAR(); \
        __builtin_amdgcn_s_setprio(1); \
        _Pragma("unroll") for (int m = 0; m < 4; ++m) _Pragma("unroll") for (int n = 0; n < 2; ++n) { \
            if (ISG) { \
                acc[0][0][m][n] = mfma_f8k128(cat16(Bf[n][0], Bf[n][1]), cat16(A0[m][0], A0[m][1]), acc[0][0][m][n]); asm volatile("" : "+v"(acc[0][0][m][n])); \
                acc[1][0][m][n] = mfma_f8k128(cat16(Bf[n][0], Bf[n][1]), cat16(A1[m][0], A1[m][1]), acc[1][0][m][n]); asm volatile("" : "+v"(acc[1][0][m][n])); \
            } else { _Pragma("unroll") for (int k = 0; k < 2; ++k) { \
                acc[0][0][m][n] = __builtin_amdgcn_mfma_f32_16x16x32_bf16(__builtin_bit_cast(bf16x8, Bf[n][k]), __builtin_bit_cast(bf16x8, A0[m][k]), acc[0][0][m][n], 0, 0, 0); \
                acc[1][0][m][n] = __builtin_amdgcn_mfma_f32_16x16x32_bf16(__builtin_bit_cast(bf16x8, Bf[n][k]), __builtin_bit_cast(bf16x8, A1[m][k]), acc[1][0][m][n], 0, 0, 0); } } } \
        __builtin_amdgcn_s_setprio(0); \
        BAR(); \
        sc = (sc == 2) ? 0 : sc + 1; si = (si == 2) ? 0 : si + 1; } while (0)
    for (;;) {
#pragma unroll 1
        for (int k2 = 0; k2 < 2; ++k2) MG_STEP(true);
#pragma unroll
        for (int a2 = 0; a2 < 2; ++a2)
#pragma unroll
            for (int m = 0; m < 4; ++m)
#pragma unroll
                for (int nn = 0; nn < 2; ++nn) { yb[a2][m][nn][0] = cvt_pk_bf16(acc[a2][0][m][nn][0] * (1.0f / 512.0f), acc[a2][0][m][nn][1] * (1.0f / 512.0f)); yb[a2][m][nn][1] = cvt_pk_bf16(acc[a2][0][m][nn][2] * (1.0f / 512.0f), acc[a2][0][m][nn][3] * (1.0f / 512.0f)); }
        acc_zero<1>(acc);
#pragma unroll 1
        for (int k8 = 0; k8 < 8; ++k8) MG_STEP(true);
#pragma unroll
        for (int a2 = 0; a2 < 2; ++a2)
#pragma unroll
            for (int m = 0; m < 4; ++m)
#pragma unroll
                for (int nn = 0; nn < 2; ++nn) {
                    const float o0 = bf_lo(outp[a2][m][nn][0]) + sigmoidf_(acc[a2][0][m][nn][0] * 0.015625f) * bf_lo(yb[a2][m][nn][0]);
                    const float o1 = bf_hi(outp[a2][m][nn][0]) + sigmoidf_(acc[a2][0][m][nn][1] * 0.015625f) * bf_hi(yb[a2][m][nn][0]);
                    const float o2 = bf_lo(outp[a2][m][nn][1]) + sigmoidf_(acc[a2][0][m][nn][2] * 0.015625f) * bf_lo(yb[a2][m][nn][1]);
                    const float o3 = bf_hi(outp[a2][m][nn][1]) + sigmoidf_(acc[a2][0][m][nn][3] * 0.015625f) * bf_hi(yb[a2][m][nn][1]);
                    outp[a2][m][nn][0] = cvt_pk_bf16(o0, o1); outp[a2][m][nn][1] = cvt_pk_bf16(o2, o3);
                }
        acc_zero<1>(acc);
        cs.s += 2;
        if (cs.s == 8) {
            int fr = g.fr, fq = g.fq; asm volatile("" : "+v"(fr), "+v"(fq));
#pragma unroll
            for (int a2 = 0; a2 < 2; ++a2)
#pragma unroll
                for (int m = 0; m < 4; ++m) {
                    const int row = cs.pm * 256 + a2 * 128 + g.wr * 64 + m * 16 + fr;
                    unsigned char* op = (unsigned char*)ACC + (size_t)row * D + 128 * cs.jt + 32 * g.wc + 8 * fq;
                    u32x2 w;
#pragma unroll
                    for (int nn = 0; nn < 2; ++nn) { const unsigned q = cvt_pk4_fp8(16.f * bf_lo(outp[a2][m][nn][0]), 16.f * bf_hi(outp[a2][m][nn][0]), 16.f * bf_lo(outp[a2][m][nn][1]), 16.f * bf_hi(outp[a2][m][nn][1]));
                        if (nn == 0) w.x = q; else w.y = q; outp[a2][m][nn][0] = 0u; outp[a2][m][nn][1] = 0u; }
                    *(u32x2*)op = w;
                }
            cs.s = 0; cs.i++; cs.valid = unit_order(cs.i * G + c, nM, 8, cs.pm, cs.jt);
            if (!cs.valid) break;
        }
    }
    WAIT_V(0);
    if (!trail) BAR();
    BAR();
#undef MG_STEP
#undef MG_ADV
#undef MG_ISSUE
}

__device__ __forceinline__ bf16_t* x1row_ptr(Frame& F, int row) { return (bf16_t*)(F.ws + WS_Y) + (size_t)row * D; }
__device__ __forceinline__ bf16_t* x2row_ptr(Frame& F, int row) { return (row < TLAT) ? (bf16_t*)F.out + (size_t)row * D : (bf16_t*)(F.ws + WS_X1CTX) + (size_t)(row - TLAT) * D; }
__device__ __forceinline__ void row_load_bf16(const bf16_t* xrow, int lane, f32x4 (&v)[4]) {
    const u32x2* xr = (const u32x2*)xrow + lane;
#pragma unroll
    for (int j = 0; j < 4; ++j) { const u32x2 w = xr[64 * j]; v[j] = (f32x4){bf_lo(w.x), bf_hi(w.x), bf_lo(w.y), bf_hi(w.y)}; }
}
struct SchedOut {
    struct Unit { const char* a; const char* b; int pm, pn; };
    const char* A; const char* B; int G, c, nM;
    __device__ __forceinline__ bool next(int i, Unit& u) const {
        int pm, pn; if (!unit_order(i * G + c, nM, 4, pm, pn)) return false;
        u.pm = pm; u.pn = pn; u.a = A + (size_t)pm * 256 * 1024; u.b = B + (size_t)pn * 256 * 1024; return true; }
    __device__ __forceinline__ void gather(const Unit&, unsigned (&)[2][2]) const {}
    __device__ __forceinline__ void boff(const Unit&, const unsigned (&d)[2], unsigned (&v)[2]) const { v[0] = d[0]; v[1] = d[1]; }
};
struct EpiOut { Frame F; int layer;
    __device__ __forceinline__ void operator()(const f32x4 (&acc)[2][2][4][2], const SchedOut::Unit& u, const GeoT& g_) const {
        GeoT g = g_; asm volatile("" : "+v"(g.fr), "+v"(g.fq));
        Frame f = F; const int pm = u.pm, pn = u.pn;
        const int row0 = pm * 256 + g.wr * 64 + g.fr;
        const float* gt = mod_ptr(f, layer, pm * 256) + 2048;
#pragma unroll
        for (int ai = 0; ai < 2; ++ai)
#pragma unroll
            for (int m = 0; m < 4; ++m) {
                const int row = row0 + ai * 128 + m * 16;
                const float* xin = (row < TLAT) ? f.in[I_X] + (size_t)row * D : f.in[I_CTX] + (size_t)(row - TLAT) * D;
                const bf16_t* xin2 = x2row_ptr(f, row);
                bf16_t* xo = x1row_ptr(f, row);
#pragma unroll
                for (int bj = 0; bj < 2; ++bj)
#pragma unroll
                    for (int n = 0; n < 2; ++n) {
                        const int col = pn * 256 + bj * 128 + g.wc * 32 + n * 16 + 4 * g.fq;
                        f32x4 xv;
                        if (layer == 0) xv = *(const f32x4*)(xin + col);
                        else { const u32x2 w = *(const u32x2*)(xin2 + col); xv = (f32x4){bf_lo(w.x), bf_hi(w.x), bf_lo(w.y), bf_hi(w.y)}; }
                        const f32x4 gv = *(const f32x4*)(gt + col);
                        const f32x4 r = xv + gv * (acc[ai][bj][m][n] * (1.0f / 1024.0f));
                        u32x2 o; o.x = cvt_pk_bf16(r.x, r.y); o.y = cvt_pk_bf16(r.z, r.w);
                        *(u32x2*)(xo + col) = o;
                    }
            }
    } };
__device__ __forceinline__ void phase_outproj(Frame& F, int layer) {
    const GeoT g = make_geo(F.tid);
    SchedOut S; S.A = (const char*)(F.ws + WS_P); S.B = (const char*)(F.ws + WS_WOUT) + (size_t)layer * 1024 * 1024; S.G = F.G; S.c = blockIdx.x; S.nM = (layer == 0) ? T / 256 : TLAT / 256;
    EpiOut E; E.F = F; E.layer = layer;
    unsigned voff[2];
#pragma unroll
    for (int i = 0; i < 2; ++i) voff[i] = (unsigned)g.R[i] * 1024u + (unsigned)g.C[i] * 2u;
    gemm_stream<false, true>(F.lds, S, E, 8, voff, 128u * 1024u, voff, 128u * 1024u, g);
}

__device__ __forceinline__ void phase_norm2route(Frame& F, int layer) {
    LAS float* wrl = (LAS float*)F.lds;
    LAS unsigned* rowE = (LAS unsigned*)(F.lds + 81920);
    LAS float* rowW = (LAS float*)(F.lds + 81920 + 1024);
    for (int i = F.tid; i < 4096; i += 512) { const int k = i >> 2, q = i & 3; const int R = ((k >> 8) * 4 + (k & 3)) * 64 + ((k & 255) >> 2);
        *(LAS f32x4*)(wrl + R * 20 + 4 * q) = ((const f32x4*)F.in[I_WR])[i]; }
    SYNC();
    const int nrows = (layer == 0) ? T : TLAT;
    bf16_t* XM = (bf16_t*)(F.ws + WS_XH);
    unsigned* ecnt = (unsigned*)(F.ws + WS_CTL) + CW_ECNT + 64 * layer;
    unsigned* toklist = (unsigned*)(F.ws + WS_TOKLIST);
    unsigned* tokslot = (unsigned*)(F.ws + WS_TOKSLOT);
    float* tokw = (float*)(F.ws + WS_TOKW);
    const float* rb = F.in[I_RB];
    for (int ch = blockIdx.x; ch < nrows / 256; ch += F.G) {
        f32x4 vn[4]; row_load_bf16(x1row_ptr(F, ch * 256 + F.wave * 32), F.lane, vn);
        for (int rr = 0; rr < 32; ++rr) {
            const int rl = F.wave * 32 + rr, row = ch * 256 + rl;
            f32x4 v[4];
#pragma unroll
            for (int j = 0; j < 4; ++j) v[j] = vn[j];
            if (rr + 1 < 32) row_load_bf16(x1row_ptr(F, row + 1), F.lane, vn);
            const float rstd = row_rstd(v);
            const float* mp = mod_ptr(F, layer, row);
            row_modulate(v, rstd, F.in[I_G2] + layer * D, mp + 3072, mp + 4096, F.lane);
            row_store_fp8((unsigned char*)F.out + OUT_XH8 + (size_t)row * D, F.lane, v);
            float lg[16];
#pragma unroll
            for (int e = 0; e < 16; ++e) lg[e] = 0.f;
#pragma unroll
            for (int j = 0; j < 4; ++j)
#pragma unroll
                for (int c = 0; c < 4; ++c) {
                    const float xv = v[j][c];
                    const LAS f32x4* wp = (const LAS f32x4*)(wrl + ((4 * j + c) * 64 + F.lane) * 20);
#pragma unroll
                    for (int q = 0; q < 4; ++q) { const f32x4 w4 = wp[q]; lg[4 * q] += xv * w4.x; lg[4 * q + 1] += xv * w4.y; lg[4 * q + 2] += xv * w4.z; lg[4 * q + 3] += xv * w4.w; }
                }
            float r8[8];
#pragma unroll
            for (int i = 0; i < 8; ++i) r8[i] = swapsum32(lg[i], lg[8 + i]);
            float r4[4];
#pragma unroll
            for (int i = 0; i < 4; ++i) r4[i] = swapsum16(r8[i], r8[4 + i]);
            float r2[2];
#pragma unroll
            for (int i = 0; i < 2; ++i) { const float y0 = r4[i] + dppf<DPP_ROR8>(r4[i]), y1 = r4[2 + i] + dppf<DPP_ROR8>(r4[2 + i]); r2[i] = (F.lane & 8) ? y1 : y0; }
            float r1; { const bool up = (F.lane & 4) != 0; const float keep = up ? r2[1] : r2[0], send = up ? r2[0] : r2[1]; r1 = keep + __shfl_xor(send, 4); }
            r1 += dppf<DPP_XOR2>(r1); r1 += dppf<DPP_XOR1>(r1);
            float s[16], sel[16];
#pragma unroll
            for (int e = 0; e < 16; ++e) { const float lgv = __int_as_float(__builtin_amdgcn_readlane(__float_as_int(r1), 32 * (e >> 3) + 16 * ((e >> 2) & 1) + 8 * ((e >> 1) & 1) + 4 * (e & 1))); s[e] = sigmoidf_(lgv); sel[e] = s[e] + rb[e]; }
            float gs[4];
#pragma unroll
            for (int gi = 0; gi < 4; ++gi) { const float x0 = sel[4 * gi], x1 = sel[4 * gi + 1], x2 = sel[4 * gi + 2], x3 = sel[4 * gi + 3];
                const float m01 = fmaxf(x0, x1), n01 = fminf(x0, x1), m23 = fmaxf(x2, x3), n23 = fminf(x2, x3);
                gs[gi] = fmaxf(m01, m23) + fmaxf(fminf(m01, m23), fmaxf(n01, n23)); }
            int gbest = 0; float gs_best = gs[0];
#pragma unroll
            for (int gi = 1; gi < 4; ++gi) { const bool gt = gs[gi] > gs_best; gs_best = gt ? gs[gi] : gs_best; gbest = gt ? gi : gbest; }
            float xg[4], sg[4];
#pragma unroll
            for (int i = 0; i < 4; ++i) { xg[i] = sel[i]; sg[i] = s[i];
#pragma unroll
                for (int gi = 1; gi < 4; ++gi) { xg[i] = (gbest == gi) ? sel[4 * gi + i] : xg[i]; sg[i] = (gbest == gi) ? s[4 * gi + i] : sg[i]; } }
            int i0 = 0, i1 = 0; float a = -1e30f, b2 = -1e30f, w0 = 0.f, w1 = 0.f;
#pragma unroll
            for (int i = 0; i < 4; ++i) { const float x = xg[i]; const bool ga = x > a, gb = x > b2;
                b2 = ga ? a : (gb ? x : b2); i1 = ga ? i0 : (gb ? i : i1); w1 = ga ? w0 : (gb ? sg[i] : w1);
                a = ga ? x : a; i0 = ga ? i : i0; w0 = ga ? sg[i] : w0; }
            const int e0 = 4 * gbest + i0, e1 = 4 * gbest + i1;
            const float inv = __builtin_amdgcn_rcpf(w0 + w1);
            if (F.lane == 0) { rowE[rl] = (unsigned)e0 | ((unsigned)e1 << 8); rowW[2 * rl] = w0 * inv; rowW[2 * rl + 1] = w1 * inv; }
        }
        SYNC();
        LAS unsigned* lcnt = (LAS unsigned*)(F.lds + 81920 + 4096);
        if (F.tid < 16) lcnt[F.tid] = 0u;
        SYNC();
        unsigned my_e0 = 0, my_e1 = 0, my_r0 = 0, my_r1 = 0;
        if (F.tid < 256) { const unsigned pe = rowE[F.tid]; my_e0 = pe & 255u; my_e1 = pe >> 8; my_r0 = atomicAdd((unsigned*)(lcnt + my_e0), 1u); my_r1 = atomicAdd((unsigned*)(lcnt + my_e1), 1u); }
        SYNC();
        if (F.tid < 16) { const unsigned cnt = lcnt[F.tid]; lcnt[16 + F.tid] = cnt ? atomicAdd(ecnt + F.tid, cnt) : 0u; }
        SYNC();
        if (F.tid < 256) {
            const int row = ch * 256 + F.tid; const unsigned p0 = lcnt[16 + my_e0] + my_r0, p1 = lcnt[16 + my_e1] + my_r1;
            toklist[my_e0 * T + p0] = row; toklist[my_e1 * T + p1] = row;
            *(u32x2*)(tokslot + 2 * row) = (u32x2){(my_e0 << 24) | p0, (my_e1 << 24) | p1};
            *(f32x2*)(tokw + 2 * row) = (f32x2){rowW[2 * F.tid], rowW[2 * F.tid + 1]};
        }
        SYNC();
    }
}

__device__ __forceinline__ int moe_segments(Frame& F, int layer) {
    const unsigned* ecnt = (const unsigned*)(F.ws + WS_CTL) + CW_ECNT + 64 * layer;
    LAS int* seg = (LAS int*)(F.lds + LDS_MISC + 256);
    LAS unsigned char* blk2e = (LAS unsigned char*)(F.lds + LDS_MISC + 512);
    if (F.tid == 0) { int acc = 0;
        for (int e = 0; e < 16; ++e) { seg[e] = acc; acc += (int)((__hip_atomic_load(ecnt + e, __ATOMIC_RELAXED, __HIP_MEMORY_SCOPE_AGENT) + 255u) >> 8); }
        seg[16] = acc; }
    SYNC();
    const int nblk = seg[16];
    for (int blk = F.tid; blk < nblk; blk += 512) { int e = 0; for (int i = 1; i < 16; ++i) e += (blk >= seg[i]) ? 1 : 0; blk2e[blk] = (unsigned char)e; }
    SYNC();
    return nblk;
}
struct SchedMoe {
    struct Unit { const char* a; const char* b; int blk, pn, e, rb, cnt; };
    const char* A; const char* B; int G, c, nblk; unsigned a_blk_bytes, b_exp_bytes, b_pn_bytes;
    const LAS int* seg; const LAS unsigned char* blk2e; const unsigned* ecnt; const unsigned* toklist; int R0, R1, C0, C1;
    __device__ __forceinline__ bool next(int i, Unit& u) const {
        int blk, pn; if (!unit_order(i * G + c, nblk, 4, blk, pn)) return false;
        const int e = __builtin_amdgcn_readfirstlane((int)blk2e[blk]);
        u.blk = blk; u.pn = pn; u.e = e; u.rb = blk - __builtin_amdgcn_readfirstlane(seg[e]);
        u.cnt = (int)__hip_atomic_load(ecnt + e, __ATOMIC_RELAXED, __HIP_MEMORY_SCOPE_AGENT);
        u.a = A + (size_t)blk * a_blk_bytes; u.b = B + (size_t)e * b_exp_bytes + (size_t)pn * b_pn_bytes; return true; }
    __device__ __forceinline__ void gather(const Unit& u, unsigned (&v)[2][2]) const {
#pragma unroll
        for (int h = 0; h < 2; ++h) {
            const int s0 = u.rb * 256 + 128 * h + R0, s1 = u.rb * 256 + 128 * h + R1;
            const unsigned t0 = (s0 < u.cnt) ? toklist[u.e * T + s0] : 0u, t1 = (s1 < u.cnt) ? toklist[u.e * T + s1] : 0u;
            v[h][0] = t0 * 1024u + (unsigned)C0 * 2u; v[h][1] = t1 * 1024u + (unsigned)C1 * 2u; } }
    __device__ __forceinline__ void boff(const Unit&, const unsigned (&d)[2], unsigned (&v)[2]) const { v[0] = d[0]; v[1] = d[1]; }
};
struct EpiMoeUp { unsigned char* U;
    __device__ __forceinline__ void operator()(const f32x4 (&acc)[2][2][4][2], const SchedMoe::Unit& u, const GeoT& g_) const {
        GeoT g = g_; asm volatile("" : "+v"(g.fr), "+v"(g.fq));
#pragma unroll
        for (int ai = 0; ai < 2; ++ai)
#pragma unroll
            for (int m = 0; m < 4; ++m) {
                const size_t slot = (size_t)u.blk * 256 + ai * 128 + g.wr * 64 + m * 16 + g.fr;
                unsigned char* up = U + slot * DE + u.pn * 128 + g.wc * 32 + 8 * g.fq;
                u32x2 w;
#pragma unroll
                for (int n = 0; n < 2; ++n) {
                    const f32x4 gv = acc[ai][0][m][n] * 0.015625f, uv = acc[ai][1][m][n] * 0.25f;
                    const unsigned q = cvt_pk4_fp8(siluf_(gv.x) * uv.x, siluf_(gv.y) * uv.y, siluf_(gv.z) * uv.z, siluf_(gv.w) * uv.w);
                    if (n == 0) w.x = q; else w.y = q;
                }
                *(u32x2*)up = w;
            }
    } };
__device__ __forceinline__ void phase_moeup(Frame& F, int layer) {
    const GeoT g = make_geo(F.tid);
    SchedMoe S; S.nblk = moe_segments(F, layer);
    S.A = (const char*)F.out + OUT_XH8; S.a_blk_bytes = 0u; S.B = (const char*)(F.ws + WS_WGU) + (size_t)layer * 16 * 1024 * 1024; S.b_exp_bytes = 1024u * 1024u; S.b_pn_bytes = 256u * 1024u;
    S.G = F.G; S.c = blockIdx.x; S.seg = (const LAS int*)(F.lds + LDS_MISC + 256); S.blk2e = (const LAS unsigned char*)(F.lds + LDS_MISC + 512);
    S.ecnt = (const unsigned*)(F.ws + WS_CTL) + CW_ECNT + 64 * layer; S.toklist = (const unsigned*)(F.ws + WS_TOKLIST); S.R0 = g.R[0]; S.R1 = g.R[1]; S.C0 = g.C[0]; S.C1 = g.C[1];
    EpiMoeUp E; E.U = F.ws + WS_U;
    unsigned voffA[2] = {0u, 0u}, voffB[2];
#pragma unroll
    for (int i = 0; i < 2; ++i) voffB[i] = (unsigned)g.R[i] * 1024u + (unsigned)g.C[i] * 2u;
    gemm_stream<true, true>(F.lds, S, E, 8, voffA, 0u, voffB, 128u * 1024u, g);
}
struct EpiMoeDown { bf16_t* DN;
    __device__ __forceinline__ void operator()(const f32x4 (&acc)[2][2][4][2], const SchedMoe::Unit& u, const GeoT& g_) const {
        GeoT g = g_; asm volatile("" : "+v"(g.fr), "+v"(g.fq));
#pragma unroll
        for (int ai = 0; ai < 2; ++ai)
#pragma unroll
            for (int m = 0; m < 4; ++m) {
                const size_t slot = (size_t)u.blk * 256 + ai * 128 + g.wr * 64 + m * 16 + g.fr;
                bf16_t* dp = DN + slot * D + u.pn * 256 + g.wc * 32 + 4 * g.fq;
#pragma unroll
                for (int bj = 0; bj < 2; ++bj)
#pragma unroll
                    for (int n = 0; n < 2; ++n) { const f32x4 v = acc[ai][bj][m][n] * (1.0f / 1024.0f); u32x2 w; w.x = cvt_pk_bf16(v.x, v.y); w.y = cvt_pk_bf16(v.z, v.w); *(u32x2*)(dp + bj * 128 + 16 * n) = w; }
            }
    } };
__device__ __forceinline__ void phase_moedown(Frame& F, int layer) {
    const GeoT g = make_geo(F.tid);
    SchedMoe S; S.nblk = moe_segments(F, layer);
    S.A = (const char*)(F.ws + WS_U); S.a_blk_bytes = 256u * 512u; S.B = (const char*)(F.ws + WS_WD) + (size_t)layer * 16 * 1024 * 512; S.b_exp_bytes = 1024u * 512u; S.b_pn_bytes = 256u * 512u;
    S.G = F.G; S.c = blockIdx.x; S.seg = (const LAS int*)(F.lds + LDS_MISC + 256); S.blk2e = (const LAS unsigned char*)(F.lds + LDS_MISC + 512);
    S.ecnt = (const unsigned*)(F.ws + WS_CTL) + CW_ECNT + 64 * layer; S.toklist = (const unsigned*)(F.ws + WS_TOKLIST); S.R0 = g.R[0]; S.R1 = g.R[1]; S.C0 = g.C[0]; S.C1 = g.C[1];
    EpiMoeDown E; E.DN = (bf16_t*)(F.ws + WS_DN);
    unsigned voff[2];
#pragma unroll
    for (int i = 0; i < 2; ++i) voff[i] = (unsigned)g.R[i] * 512u + (unsigned)g.C[i] * 2u;
    gemm_stream<false, true>(F.lds, S, E, 4, voff, 128u * 512u, voff, 128u * 512u, g);
}
__device__ __forceinline__ void phase_combine(Frame& F, int layer) {
    const LAS int* seg = (const LAS int*)(F.lds + LDS_MISC + 256);
    (void)moe_segments(F, layer);
    const int nrows = (layer == 0) ? T : TLAT;
    const int gw = blockIdx.x * 8 + F.wave, NGW = F.G * 8;
    const unsigned* tokslot = (const unsigned*)(F.ws + WS_TOKSLOT);
    const float* tokw = (const float*)(F.ws + WS_TOKW);
    const bf16_t* DN = (const bf16_t*)(F.ws + WS_DN);
    bf16_t* XH = (bf16_t*)(F.ws + WS_XH);
    int row = gw;
    u32x2 sl_n = (u32x2){0u, 0u}; f32x2 w_n = (f32x2){0.f, 0.f};
    if (row < nrows) { sl_n = *(const u32x2*)(tokslot + 2 * row); w_n = *(const f32x2*)(tokw + 2 * row); }
    u32x2 xa[4], da[4], db[4]; float w0c = 0.f, w1c = 0.f;
#define CB_ISSUE(r_, sl_) do { const size_t _s0 = (size_t)seg[(sl_).x >> 24] * 256 + ((sl_).x & 0xffffffu), _s1 = (size_t)seg[(sl_).y >> 24] * 256 + ((sl_).y & 0xffffffu); \
        const u32x2* _x = (const u32x2*)x1row_ptr(F, r_) + F.lane; const u32x2* _a = (const u32x2*)(DN + _s0 * D) + F.lane; const u32x2* _b = (const u32x2*)(DN + _s1 * D) + F.lane; \
        _Pragma("unroll") for (int j = 0; j < 4; ++j) { xa[j] = _x[64 * j]; da[j] = _a[64 * j]; db[j] = _b[64 * j]; } } while (0)
    if (row < nrows) { CB_ISSUE(row, sl_n); w0c = w_n.x; w1c = w_n.y; }
    if (row + NGW < nrows) { sl_n = *(const u32x2*)(tokslot + 2 * (row + NGW)); w_n = *(const f32x2*)(tokw + 2 * (row + NGW)); }
    for (; row < nrows; row += NGW) {
        f32x4 v[4], f[4];
        const float w0 = w0c, w1 = w1c;
#pragma unroll
        for (int j = 0; j < 4; ++j) {
            v[j] = (f32x4){bf_lo(xa[j].x), bf_hi(xa[j].x), bf_lo(xa[j].y), bf_hi(xa[j].y)};
            f[j].x = w0 * bf_lo(da[j].x) + w1 * bf_lo(db[j].x); f[j].y = w0 * bf_hi(da[j].x) + w1 * bf_hi(db[j].x); f[j].z = w0 * bf_lo(da[j].y) + w1 * bf_lo(db[j].y); f[j].w = w0 * bf_hi(da[j].y) + w1 * bf_hi(db[j].y);
        }
        const int rn = row + NGW;
        if (rn < nrows) { CB_ISSUE(rn, sl_n); w0c = w_n.x; w1c = w_n.y; }
        if (rn + NGW < nrows) { sl_n = *(const u32x2*)(tokslot + 2 * (rn + NGW)); w_n = *(const f32x2*)(tokw + 2 * (rn + NGW)); }
        const float* gt2 = mod_ptr(F, layer, row) + 5120;
#pragma unroll
        for (int j = 0; j < 4; ++j) { const f32x4 gv = ((const f32x4*)gt2)[F.lane + 64 * j]; v[j] = v[j] + gv * f[j]; }
        const float rstd = row_rstd(v);
        if (layer == 0) {
            row_store_bf16(x2row_ptr(F, row), F.lane, v);
            const float* mp = mod_ptr(F, 1, row);
            row_modulate(v, rstd, F.in[I_G1] + D, mp, mp + 1024, F.lane);
            row_store_fp8((unsigned char*)F.out + OUT_XH8 + (size_t)row * D, F.lane, v);
        } else {
#pragma unroll
            for (int j = 0; j < 4; ++j) { const f32x4 gg = ((const f32x4*)F.in[I_GF])[F.lane + 64 * j]; ((f32x4*)(F.out + (size_t)row * D))[F.lane + 64 * j] = v[j] * rstd * gg; }
        }
    }
#undef CB_ISSUE
}

__device__ __forceinline__ const __attribute__((address_space(4))) unsigned char* opaque_ka() {
    unsigned long long w = (unsigned long long)__builtin_amdgcn_kernarg_segment_ptr(); unsigned lo = (unsigned)w, hi = (unsigned)(w >> 32);
    asm volatile("" : "+v"(lo), "+v"(hi));
    lo = __builtin_amdgcn_readfirstlane(lo); hi = __builtin_amdgcn_readfirstlane(hi);
    return (const __attribute__((address_space(4))) unsigned char*)(((unsigned long long)hi << 32) | lo);
}
__device__ __forceinline__ const void* opaque_ptr(const void* p) {
    unsigned long long w = (unsigned long long)p; unsigned lo = (unsigned)w, hi = (unsigned)(w >> 32);
    asm volatile("" : "+v"(lo), "+v"(hi));
    lo = __builtin_amdgcn_readfirstlane(lo); hi = __builtin_amdgcn_readfirstlane(hi);
    return (const void*)(((unsigned long long)hi << 32) | lo);
}
constexpr int N_PHASES = 2 + 2 * 10;
__global__ void __launch_bounds__(512, 2) mk_fwd(Args args) {
    extern __shared__ __attribute__((aligned(16))) unsigned char lds_raw[];
    Frame F; F.lds = (LAS unsigned char*)lds_raw; F.tid = threadIdx.x; F.lane = F.tid & 63; F.wave = __builtin_amdgcn_readfirstlane(F.tid >> 6); F.G = gridDim.x;
    static_assert(offsetof(Args, out) == 184 && offsetof(Args, ws) == 192, "kernarg layout");
    F.in = (in_tab_t)nullptr; F.out = nullptr; F.ws = args.ws;
    const int lo = args.ph_lo, hi = args.ph_hi;
    volatile LAS unsigned* misc = (volatile LAS unsigned*)(F.lds + LDS_MISC);
    if (F.tid < 64) misc[F.tid] = 0u;
    __syncthreads();
    XcdBarrier bar; bar.bar = (unsigned*)(F.ws + WS_CTL) + CW_BAR; bar.x = 0; bar.st = misc;
    if (hi - lo > 1) bar = xcd_barrier_post((unsigned*)(F.ws + WS_CTL) + CW_BAR, misc, threadIdx.x == 0);
    const int wave_s = __builtin_amdgcn_readfirstlane((int)(threadIdx.x >> 6));
#define IN(k) (lo <= (k) && (k) < hi)
#define SEAM(k) do { if (IN(k) && IN((k) + 1)) { XcdBarrier _b = bar; _b.bar = (unsigned*)opaque_ptr(bar.bar); xcd_barrier(_b, TIDNOW() == 0); } } while (0)
#define TIDNOW() ((wave_s << 6) | lane_now())
#define FRESH() do { int _t = TIDNOW(); int _g = gridDim.x; unsigned _l = (unsigned)(uintptr_t)lds_raw; asm volatile("" : "+v"(_t), "+v"(_g), "+v"(_l)); \
        const __attribute__((address_space(4))) unsigned char* _ka = opaque_ka(); \
        F.in = (in_tab_t)_ka; F.out = *(float* const __attribute__((address_space(4)))*)(_ka + 184); F.ws = *(unsigned char* const __attribute__((address_space(4)))*)(_ka + 192); \
        F.G = __builtin_amdgcn_readfirstlane(_g); F.lds = (LAS unsigned char*)(uintptr_t)__builtin_amdgcn_readfirstlane(_l); \
        F.tid = _t; F.lane = _t & 63; F.wave = __builtin_amdgcn_readfirstlane(_t >> 6); } while (0)
#if MK_DIAG
#define STAMP(k) do { if (blockIdx.x == 0 && TIDNOW() == 0) ((unsigned long long*)(args.ws + WS_CTL + 524288))[k] = __builtin_amdgcn_s_memrealtime(); } while (0)
#else
#define STAMP(k) do { } while (0)
#endif
    STAMP(0);
    if (IN(0)) { FRESH(); phase_pro(F); if (MK_REP == 9) { FRESH(); phase_pro(F); } } SEAM(0); STAMP(1);
    if (IN(1)) { FRESH(); phase_norm1_l0(F); if (MK_REP == 10) { FRESH(); phase_norm1_l0(F); } } SEAM(1); STAMP(2);
#define LAYER_PHASES(LAYER) do { const int pb = 2 + 10 * (LAYER); \
        if (IN(pb + 0)) { FRESH(); phase_inproj(F, LAYER); if (MK_REP == 0) { FRESH(); phase_inproj(F, LAYER); } } SEAM(pb + 0); STAMP(pb + 1); \
        if (IN(pb + 1)) { FRESH(); phase_retkv(F, LAYER); if (MK_REP == 1) { FRESH(); phase_retkv(F, LAYER); } } SEAM(pb + 1); STAMP(pb + 2); \
        if (IN(pb + 3)) { FRESH(); phase_mixers(F, LAYER); if (MK_REP == 3) { FRESH(); phase_mixers(F, LAYER); } } SEAM(pb + 3); STAMP(pb + 4); \
        if (IN(pb + 4)) { FRESH(); phase_merge(F, LAYER); if (MK_REP == 4) { FRESH(); phase_merge(F, LAYER); } } SEAM(pb + 4); STAMP(pb + 5); \
        if (IN(pb + 5)) { FRESH(); phase_outproj(F, LAYER); if (MK_REP == 5 && LAYER == 0) { FRESH(); phase_outproj(F, LAYER); } } SEAM(pb + 5); STAMP(pb + 6); \
        if (IN(pb + 6)) { FRESH(); phase_norm2route(F, LAYER); } SEAM(pb + 6); STAMP(pb + 7); \
        if (IN(pb + 7)) { FRESH(); phase_moeup(F, LAYER); if (MK_REP == 7) { FRESH(); phase_moeup(F, LAYER); } } SEAM(pb + 7); STAMP(pb + 8); \
        if (IN(pb + 8)) { FRESH(); phase_moedown(F, LAYER); if (MK_REP == 8) { FRESH(); phase_moedown(F, LAYER); } } SEAM(pb + 8); STAMP(pb + 9); \
        if (IN(pb + 9)) { FRESH(); phase_combine(F, LAYER); } SEAM(pb + 9); STAMP(pb + 10); \
    } while (0)
    LAYER_PHASES(0);
    LAYER_PHASES(1);
#undef LAYER_PHASES
#undef IN
#undef SEAM
#if MK_DIAG
    if (blockIdx.x == 0 && threadIdx.x == 0) {
        asm volatile("s_waitcnt vmcnt(0)" ::: "memory");
        volatile unsigned long long* TS = (volatile unsigned long long*)(args.ws + WS_CTL + 524288);
        const float ms = (float)((TS[MK_DIAG_B0] - TS[MK_DIAG_A0]) + (TS[MK_DIAG_B1] - TS[MK_DIAG_A1])) * 1e-5f;
        args.out[0] = sqrtf(67108864.0f * ms);
    }
#endif
}

extern "C" void kernel_launch(void* const* d_in, const int* in_sizes, int n_in, void* d_out, int out_size, void* d_ws, size_t ws_size, hipStream_t stream) {
    static int grid = 0;
    if (grid == 0) {
        if (n_in != 23 || out_size != TLAT * D || ws_size < WS_END) { fprintf(stderr, "kernel_launch: unexpected shapes (n_in %d out %d ws %zu)\n", n_in, out_size, ws_size); grid = -1; return; }
        int dev = 0, cus = 0;
        if (hipGetDevice(&dev) != hipSuccess || hipDeviceGetAttribute(&cus, hipDeviceAttributeMultiprocessorCount, dev) != hipSuccess) { grid = -1; return; }
        if (hipFuncSetAttribute((const void*)mk_fwd, hipFuncAttributeMaxDynamicSharedMemorySize, LDS_BYTES) != hipSuccess) { fprintf(stderr, "kernel_launch: hipFuncSetAttribute failed\n"); grid = -1; return; }
        int per_cu = 0;
        if (hipOccupancyMaxActiveBlocksPerMultiprocessor(&per_cu, (const void*)mk_fwd, 512, LDS_BYTES) != hipSuccess || per_cu < 1) { fprintf(stderr, "kernel_launch: occupancy query says %d\n", per_cu); }
        (void)hipGetLastError();
        grid = cus;
    }
    if (grid < 0) return;
    (void)hipMemsetAsync((char*)d_ws + WS_CTL, 0, CTL_BYTES, stream);
    Args a{};
    for (int i = 0; i < 23; ++i) a.in[i] = (const float*)d_in[i];
    a.out = (float*)d_out; a.ws = (unsigned char*)d_ws;
#if MK_ONE_LAUNCH
    a.ph_lo = 0; a.ph_hi = N_PHASES;
    hipLaunchKernelGGL(mk_fwd, dim3(grid), dim3(512), LDS_BYTES, stream, a);
#else
    for (int p = 0; p < N_PHASES; ++p) { a.ph_lo = p; a.ph_hi = p + 1; hipLaunchKernelGGL(mk_fwd, dim3(grid), dim3(512), LDS_BYTES, stream, a); }
#endif
}
```

```cpp
#include <hip/hip_runtime.h>
#include <stdint.h>
#include <stdio.h>
#include <math.h>
#include <stddef.h>

#ifndef MK_DIAG
#define MK_DIAG 0
#endif
#ifndef MK_DIAG_A0
#define MK_DIAG_A0 0
#define MK_DIAG_B0 1
#define MK_DIAG_A1 0
#define MK_DIAG_B1 0
#endif
#ifndef MK_REP
#define MK_REP -1
#endif
#ifndef MK_REP_MIX
#define MK_REP_MIX -1
#endif
#ifndef MK_ONE_LAUNCH
#define MK_ONE_LAUNCH 1
#endif

#define LAS __attribute__((address_space(3)))
typedef unsigned short bf16_t;
typedef short bf16x8 __attribute__((ext_vector_type(8)));
typedef short s16x4 __attribute__((ext_vector_type(4)));
typedef float f32x4 __attribute__((ext_vector_type(4)));
typedef float f32x2 __attribute__((ext_vector_type(2)));
typedef float f32x16 __attribute__((ext_vector_type(16)));
typedef unsigned u32x4 __attribute__((ext_vector_type(4)));
typedef unsigned u32x2 __attribute__((ext_vector_type(2)));

constexpr int D = 1024, NBATCH = 32, SEQ = 2048, CTXL = 256, GRIDW = 64;
constexpr int TLAT = NBATCH * SEQ;
constexpr int TCTX = NBATCH * CTXL;
constexpr int T = TLAT + TCTX;
constexpr int PW = 3072;
constexpr int INW = 7168;
constexpr int NE = 16, DE = 512;
constexpr int SLOTS_MAX = 2 * T + NE * 256;
constexpr int NCHUNK = 18;
constexpr float EPS = 1e-6f;
constexpr float LOG2E = 1.4426950408889634f;
constexpr int C_NAQ = 0, C_NAK = 256, C_NAV = 512, C_RQ = 768, C_RK = 1024, C_RV = 1280, C_RG = 1536, C_GQ = 1792, C_GK = 2048, C_GV = 2176, C_DQ = 2304, C_DK = 2560, C_DV = 2816;

constexpr size_t MiB = 1u << 20;
constexpr size_t WS_CTL = 0, CTL_BYTES = 1 * MiB;
constexpr size_t WS_MOD = 1 * MiB;
constexpr size_t WS_TAB = 3 * MiB;
constexpr size_t WS_TOKLIST = 4 * MiB;
constexpr size_t WS_TOKSLOT = 9 * MiB;
constexpr size_t WS_TOKW = 10 * MiB;
constexpr size_t WS_RETKV = 12 * MiB;
constexpr size_t WS_WIN = 88 * MiB;
constexpr size_t WS_WBR = 116 * MiB;
constexpr size_t WS_WOUT = 120 * MiB;
constexpr size_t WS_WGU = 124 * MiB;
constexpr size_t WS_WD = 188 * MiB;
constexpr size_t WS_X1CTX = 220 * MiB;
constexpr size_t WS_XH = 252 * MiB;
constexpr size_t WS_Y = 396 * MiB;
constexpr size_t WS_P = 540 * MiB;
constexpr size_t WS_U = WS_P;
constexpr size_t WS_DN = WS_P + 148 * MiB;
constexpr size_t WS_WIN8 = 988 * MiB;
constexpr size_t WS_END = 1002 * MiB;
constexpr size_t OUT_XH8 = 128 * MiB;
static_assert((size_t)SLOTS_MAX * DE * 2 <= 148 * MiB && (size_t)SLOTS_MAX * D * 2 <= 296 * MiB, "moe buffers");
constexpr int CW_ECNT = 64;
constexpr int CW_BAR = 4096;
constexpr int TB_R64C = 0, TB_R64S = 1024, TB_R32C = 2048, TB_R32S = 2560, TB_SC = 3072;

constexpr int LDS_BYTES = 163840;
constexpr int LDS_MISC = 161792;
constexpr int LDS_GOFF = 131072;
constexpr int HTB = 16384;

__device__ __forceinline__ unsigned cvt_pk_bf16(float lo, float hi) { unsigned r; asm volatile("v_cvt_pk_bf16_f32 %0, %1, %2" : "=v"(r) : "v"(lo), "v"(hi)); return r; }
__device__ __forceinline__ float bf_lo(unsigned u) { return __uint_as_float(u << 16); }
__device__ __forceinline__ float bf_hi(unsigned u) { return __uint_as_float(u & 0xffff0000u); }
__device__ __forceinline__ float bf2f(bf16_t b) { return __uint_as_float(((unsigned)b) << 16); }
__device__ __forceinline__ float sat8(float v) { return __builtin_amdgcn_fmed3f(v, -448.0f, 448.0f); }
__device__ __forceinline__ unsigned cvt_pk4_fp8(float a, float b, float c, float d) { int w = __builtin_amdgcn_cvt_pk_fp8_f32(sat8(a), sat8(b), 0, false); w = __builtin_amdgcn_cvt_pk_fp8_f32(sat8(c), sat8(d), w, true); return (unsigned)w; }
template <int CTRL> __device__ __forceinline__ float dppf(float v) { return __int_as_float(__builtin_amdgcn_update_dpp(0, __float_as_int(v), CTRL, 0xF, 0xF, true)); }
constexpr int DPP_XOR1 = 0xB1, DPP_XOR2 = 0x4E, DPP_HMIRROR = 0x141, DPP_MIRROR = 0x140, DPP_ROR8 = 0x128;
__device__ __forceinline__ float swapsum16(float a, float b) { auto r = __builtin_amdgcn_permlane16_swap(__float_as_uint(a), __float_as_uint(b), false, false); return __uint_as_float(r[0]) + __uint_as_float(r[1]); }
__device__ __forceinline__ float swapsum32(float a, float b) { auto r = __builtin_amdgcn_permlane32_swap(__float_as_uint(a), __float_as_uint(b), false, false); return __uint_as_float(r[0]) + __uint_as_float(r[1]); }
__device__ __forceinline__ float wave_sum(float v) {
    v += dppf<DPP_XOR1>(v); v += dppf<DPP_XOR2>(v); v += dppf<DPP_HMIRROR>(v); v += dppf<DPP_MIRROR>(v);
    v = swapsum16(v, v); v = swapsum32(v, v);
    return v;
}
__device__ __forceinline__ float sigmoidf_(float x) { return __builtin_amdgcn_rcpf(1.0f + __builtin_amdgcn_exp2f(x * -1.4426950408889634f)); }
__device__ __forceinline__ float siluf_(float x) { return x * sigmoidf_(x); }
__device__ __forceinline__ float sig64(float x) { return __builtin_amdgcn_rcpf(1.0f + __builtin_amdgcn_exp2f(x * (-1.4426950408889634f / 64.0f))); }
#define VG(x) asm volatile("" : "+v"(x))
__device__ __forceinline__ int lane_now() { int l; asm volatile("v_mbcnt_lo_u32_b32 %0, -1, 0\n\tv_mbcnt_hi_u32_b32 %0, -1, %0" : "=v"(l)); return l; }
#define WAIT_V(n) asm volatile("s_waitcnt vmcnt(" #n ")" ::: "memory")
#define WAIT_L(n) asm volatile("s_waitcnt lgkmcnt(" #n ")" ::: "memory")
#define BAR() __builtin_amdgcn_s_barrier()
#define SYNC() do { asm volatile("s_waitcnt vmcnt(0) lgkmcnt(0)" ::: "memory"); __builtin_amdgcn_s_barrier(); asm volatile("" ::: "memory"); } while (0)

#define XB_TMO      128
#define XB_XCNT(j)  (256  + 64 * (j))
#define XB_XSUB(j)  (1280 + 64 * (j))
#define XB_XGEN(j)  (2304 + 64 * (j))
#define XB_TOP      3328
#define XB_TOPGEN   3392
#define XCD_BAR_WORDS 3456
#define XB_SPIN_CAP (1u << 18)
__device__ __forceinline__ unsigned xb_ld(unsigned* p)              { return __hip_atomic_load(p, __ATOMIC_RELAXED, __HIP_MEMORY_SCOPE_AGENT); }
__device__ __forceinline__ unsigned xb_add(unsigned* p, unsigned v) { return __hip_atomic_fetch_add(p, v, __ATOMIC_RELAXED, __HIP_MEMORY_SCOPE_AGENT); }
__device__ __forceinline__ unsigned xb_xcc_id() { return (unsigned)__builtin_amdgcn_s_getreg((3 << 11) | 20) & 0xFu; }
#define XB_SPIN(cond, bar) do { unsigned _sp = 0; while (cond) { __builtin_amdgcn_s_sleep(1); \
    if ((++_sp & 255u) == 0u) { if (xb_ld(&(bar)[XB_TMO])) break; if (_sp > XB_SPIN_CAP) { atomicAdd(&(bar)[XB_TMO], 1u); break; } } } } while (0)
struct XcdBarrier { unsigned* bar; unsigned x; volatile LAS unsigned* st; };
__device__ __forceinline__ XcdBarrier xcd_barrier_post(unsigned* bar, volatile LAS unsigned* st, bool leader) {
    XcdBarrier b; b.bar = bar; b.x = xb_xcc_id(); b.st = st;
    if (leader) (void)xb_add(&bar[XB_XCNT(b.x)], 1u);
    return b;
}
__device__ __forceinline__ void xcd_barrier_complete(unsigned* bar, unsigned x, unsigned& nloc, unsigned& nx) {
    const unsigned G = gridDim.x * gridDim.y * gridDim.z;
    unsigned sum, cnt, mine, sp = 0u;
    for (;;) {
        sum = 0u; cnt = 0u; mine = 0u;
#pragma unroll
        for (unsigned j = 0; j < 16; ++j) { const unsigned c = xb_ld(&bar[XB_XCNT(j)]); sum += c; cnt += (c > 0u) ? 1u : 0u; mine = (j == x) ? c : mine; }
        if (sum == G) break;
        __builtin_amdgcn_s_sleep(1);
        if ((++sp & 255u) == 0u) { if (xb_ld(&bar[XB_TMO])) break; if (sp > XB_SPIN_CAP) { atomicAdd(&bar[XB_TMO], 1u); break; } }
    }
    nloc = mine > 0u ? mine : 1u; nx = cnt > 0u ? cnt : 1u;
}
__device__ __forceinline__ void xcd_barrier(const XcdBarrier& b, bool leader) {
    asm volatile("s_waitcnt vmcnt(0)" ::: "memory");
    __syncthreads();
    if (leader) {
        unsigned* bar = b.bar;
        __builtin_amdgcn_s_waitcnt(0);
        unsigned nloc = b.st[0], nx = b.st[1];
        if (nloc == 0u) { xcd_barrier_complete(bar, b.x, nloc, nx); b.st[0] = nloc; b.st[1] = nx; }
        const unsigned old = xb_add(&bar[XB_XSUB(b.x)], 1u);
        const unsigned gen = old / nloc;
        if (old + 1u == (gen + 1u) * nloc) {
            __builtin_amdgcn_fence(__ATOMIC_RELEASE, "agent");
            asm volatile("s_waitcnt vmcnt(0)" ::: "memory");
            const unsigned og = xb_add(&bar[XB_TOP], 1u);
            const unsigned tg = og / nx;
            if (og + 1u == (tg + 1u) * nx) xb_add(&bar[XB_TOPGEN], 1u);
            else XB_SPIN(xb_ld(&bar[XB_TOPGEN]) == tg, bar);
            __builtin_amdgcn_fence(__ATOMIC_ACQUIRE, "agent");
            xb_add(&bar[XB_XGEN(b.x)], 1u);
            asm volatile("s_waitcnt vmcnt(0)" ::: "memory");
        } else {
            XB_SPIN(xb_ld(&bar[XB_XGEN(b.x)]) == gen, bar);
            __builtin_amdgcn_fence(__ATOMIC_ACQUIRE, "agent");
            asm volatile("s_waitcnt vmcnt(0)" ::: "memory");
        }
    }
    __syncthreads();
}

struct Args { const float* in[23]; float* out; unsigned char* ws; int ph_lo, ph_hi; };
typedef const float* cfptr_t;
typedef const __attribute__((address_space(4))) cfptr_t* in_tab_t;
struct Frame {
    LAS unsigned char* lds;
    int tid, lane, wave, G;
    in_tab_t in; float* out; unsigned char* ws;
};
enum { I_X = 0, I_C, I_CTX, I_CCTX, I_WMOD, I_BMOD, I_G1, I_G2, I_WIN, I_RPB, I_RLD, I_QG, I_KG, I_DLAM, I_DSUB, I_WBR, I_WOUT, I_WR, I_RB, I_WG, I_WU, I_WD, I_GF };

__device__ __forceinline__ int lds_byte(int r, int c) { const int st = (r >> 4) * 2 + (c >> 5), rr = r & 15, cc = c & 31, ob = rr * 64 + cc * 2; return st * 1024 + (ob ^ (((ob >> 9) & 1) << 5)); }
__device__ __forceinline__ void stage_rc(int b, int& R, int& C) { const int st = b / 1024, sb = b % 1024, swz = sb ^ (((sb >> 9) & 1) << 5); R = (st >> 1) * 16 + swz / 64; C = (st & 1) * 32 + (swz % 64) / 2; }

template <int NBH>
__device__ __forceinline__ void gemm_kloop(LAS unsigned char* lds, const char* aBase, const unsigned (&aoff)[2][2], const char* bBase, const unsigned (&boff)[2][2], int nk,
                                           f32x4 (&acc)[2][NBH][4][2], int wid, int aoffl, int boffl) {
    const unsigned ldsw = (unsigned)wid * 1024u;
#define GE_STAGE(buf, kt) do { const unsigned _ko = (unsigned)(kt) * 128u; \
        _Pragma("unroll") for (int _h = 0; _h < 2; ++_h) _Pragma("unroll") for (int _i = 0; _i < 2; ++_i) \
            __builtin_amdgcn_global_load_lds((const unsigned*)(aBase + aoff[_h][_i] + _ko), (LAS unsigned*)(lds + (buf) * 65536 + _h * HTB + ldsw + _i * 8192), 16, 0, 0); \
        _Pragma("unroll") for (int _h = 0; _h < NBH; ++_h) _Pragma("unroll") for (int _i = 0; _i < 2; ++_i) \
            __builtin_amdgcn_global_load_lds((const unsigned*)(bBase + boff[_h][_i] + _ko), (LAS unsigned*)(lds + (buf) * 65536 + 32768 + _h * HTB + ldsw + _i * 8192), 16, 0, 0); } while (0)
    GE_STAGE(0, 0);
#pragma unroll 1
    for (int kt = 0; kt < nk; ++kt) {
        const int buf = kt & 1;
        WAIT_V(0); BAR();
        if (kt + 1 < nk) GE_STAGE(buf ^ 1, kt + 1);
        const LAS unsigned char* la = lds + buf * 65536 + aoffl;
        const LAS unsigned char* lb = lds + buf * 65536 + 32768 + boffl;
        bf16x8 Bf[NBH][2][2];
#pragma unroll
        for (int bj = 0; bj < NBH; ++bj)
#pragma unroll
            for (int n = 0; n < 2; ++n)
#pragma unroll
                for (int k = 0; k < 2; ++k) Bf[bj][n][k] = *(const LAS bf16x8*)(lb + bj * HTB + n * 2048 + k * 1024);
#pragma unroll
        for (int ai = 0; ai < 2; ++ai)
#pragma unroll
            for (int mh = 0; mh < 2; ++mh) {
                bf16x8 Af[2][2];
#pragma unroll
                for (int mm = 0; mm < 2; ++mm)
#pragma unroll
                    for (int k = 0; k < 2; ++k) Af[mm][k] = *(const LAS bf16x8*)(la + ai * HTB + (2 * mh + mm) * 2048 + k * 1024);
#pragma unroll
                for (int bj = 0; bj < NBH; ++bj)
#pragma unroll
                    for (int mm = 0; mm < 2; ++mm)
#pragma unroll
                        for (int n = 0; n < 2; ++n)
#pragma unroll
                            for (int k = 0; k < 2; ++k)
                                acc[ai][bj][2 * mh + mm][n] = __builtin_amdgcn_mfma_f32_16x16x32_bf16(Bf[bj][n][k], Af[mm][k], acc[ai][bj][2 * mh + mm][n], 0, 0, 0);
            }
    }
    WAIT_L(0); BAR();
#undef GE_STAGE
}
template <int NBH> __device__ __forceinline__ void acc_zero(f32x4 (&acc)[2][NBH][4][2]) {
#pragma unroll
    for (int a = 0; a < 2; ++a)
#pragma unroll
        for (int b = 0; b < NBH; ++b)
#pragma unroll
            for (int m = 0; m < 4; ++m)
#pragma unroll
                for (int n = 0; n < 2; ++n) acc[a][b][m][n] = (f32x4){0.f, 0.f, 0.f, 0.f};
}
struct GeoT { int wid, lane, wr, wc, fr, fq, aoffl, boffl; int R[2], C[2]; };
__device__ __forceinline__ GeoT make_geo(int tid) {
    GeoT g; asm volatile("" : "+v"(tid)); g.wid = __builtin_amdgcn_readfirstlane(tid >> 6); g.lane = tid & 63; g.wr = g.wid >> 2; g.wc = g.wid & 3; g.fr = g.lane & 15; g.fq = g.lane >> 4;
    g.aoffl = lds_byte(g.wr * 64 + g.fr, g.fq * 8); g.boffl = lds_byte(g.wc * 32 + g.fr, g.fq * 8);
#pragma unroll
    for (int i = 0; i < 2; ++i) stage_rc(tid * 16 + i * 8192, g.R[i], g.C[i]);
    return g;
}
__device__ __forceinline__ void rows_contig(unsigned (&off)[2][2], const GeoT& g, int row0, unsigned pitch_bytes) {
#pragma unroll
    for (int h = 0; h < 2; ++h)
#pragma unroll
        for (int i = 0; i < 2; ++i) off[h][i] = (unsigned)(row0 + 128 * h + g.R[i]) * pitch_bytes + (unsigned)g.C[i] * 2u;
}

__device__ __forceinline__ bool unit_order(int L, int nM, int nN, int& pm, int& pn) {
    const int nwg = nM * nN; if (L >= nwg) return false;
    int wgid = L; { const int q = nwg / 8, r = nwg % 8, xcd = wgid % 8, off = wgid / 8; wgid = (xcd < r ? xcd * (q + 1) : r * (q + 1) + (xcd - r) * q) + off; }
    const int nig = 8 * nN, gid = wgid / nig, fm = gid * 8, gsz = (nM - fm) < 8 ? (nM - fm) : 8;
    pm = fm + ((wgid % nig) % gsz); pn = (wgid % nig) / gsz; return true;
}


typedef int i32x4_t __attribute__((ext_vector_type(4)));
typedef int i32x8_t __attribute__((ext_vector_type(8)));
template <class T>
__device__ __forceinline__ i32x8_t cat16(const T& lo, const T& hi) { return __builtin_shufflevector(__builtin_bit_cast(i32x4_t, lo), __builtin_bit_cast(i32x4_t, hi), 0, 1, 2, 3, 4, 5, 6, 7); }
__device__ __forceinline__ f32x4 mfma_f8k128(i32x8_t a, i32x8_t b, f32x4 c) { return __builtin_amdgcn_mfma_scale_f32_16x16x128_f8f6f4(a, b, c, 0, 0, 0, 0x7F7F7F7F, 0, 0x7F7F7F7F); }

template <bool GATHER, bool F8, class Sched, class Epi>
__device__ __forceinline__ void gemm_stream(LAS unsigned char* lds, const Sched& S, const Epi& E, const int nt, const unsigned (&voffA)[2], const unsigned hstepA,
                                            const unsigned (&voffB)[2], const unsigned hstepB, const GeoT& g) {
    typedef typename Sched::Unit Unit;
    const int wr = g.wr;
    const unsigned ldsw = (unsigned)g.wid * 1024u;
    const int aoff = g.aoffl, boff = g.boffl;
    const unsigned kstep = 128u;
#define GS_SA(b, h) (((b) * 2 + (h)) * HTB)
#define GS_SB(b, h) ((4 + (b) * 2 + (h)) * HTB)
#define GS_STAGE(bufoff, gbase, v0, v1) do { \
        __builtin_amdgcn_global_load_lds((const unsigned*)((gbase) + (v0)), (LAS unsigned*)(lds + (bufoff) + ldsw), 16, 0, 0); \
        __builtin_amdgcn_global_load_lds((const unsigned*)((gbase) + (v1)), (LAS unsigned*)(lds + (bufoff) + ldsw + 8192), 16, 0, 0); } while (0)
#define GS_STAGE_B(bufoff, gbase, vb) GS_STAGE(bufoff, gbase, vb[0], vb[1])
#define GS_STAGE_A(bufoff, gbase, h, sl) do { if (GATHER) { const unsigned _v0 = goff[(((sl) * 2 + (h)) * 2 + 0) * 512], _v1 = goff[(((sl) * 2 + (h)) * 2 + 1) * 512]; GS_STAGE(bufoff, gbase, _v0, _v1); } \
        else GS_STAGE(bufoff, (gbase) + (h) * (size_t)hstepA, voffA[0], voffA[1]); } while (0)
#define GS_LDA(dst, b, h) do { _Pragma("unroll") for (int m = 0; m < 4; ++m) _Pragma("unroll") for (int k = 0; k < 2; ++k) dst[m][k] = *(const LAS bf16x8*)(lds + GS_SA(b, h) + aoff + m * 2048 + k * 1024); } while (0)
#define GS_LDB(dst, b, h) do { _Pragma("unroll") for (int n = 0; n < 2; ++n) _Pragma("unroll") for (int k = 0; k < 2; ++k) dst[n][k] = *(const LAS bf16x8*)(lds + GS_SB(b, h) + boff + n * 2048 + k * 1024); } while (0)
#define GS_MMA(ai, bj, At, Bt) do { __builtin_amdgcn_s_setprio(1); _Pragma("unroll") for (int m = 0; m < 4; ++m) _Pragma("unroll") for (int n = 0; n < 2; ++n) { \
        if (F8) { acc[ai][bj][m][n] = mfma_f8k128(cat16(Bt[n][0], Bt[n][1]), cat16(At[m][0], At[m][1]), acc[ai][bj][m][n]); asm volatile("" : "+v"(acc[ai][bj][m][n])); } \
        else { _Pragma("unroll") for (int k = 0; k < 2; ++k) acc[ai][bj][m][n] = __builtin_amdgcn_mfma_f32_16x16x32_bf16(Bt[n][k], At[m][k], acc[ai][bj][m][n], 0, 0, 0); } } __builtin_amdgcn_s_setprio(0); } while (0)
#define GS_SCHED __builtin_amdgcn_sched_barrier(0)
    Unit cur, nxt; int ui = 0;
    if (!S.next(0, cur)) return;
    f32x4 acc[2][2][4][2]; acc_zero<2>(acc);
    bf16x8 At[4][2], B0[2][2], B1[2][2];
    LAS unsigned* goff = (LAS unsigned*)(lds + LDS_GOFF) + (g.wid * 64 + g.lane);
    int oc = 0;
    if (GATHER) { unsigned v[2][2]; S.gather(cur, v); goff[0] = v[0][0]; goff[512] = v[0][1]; goff[1024] = v[1][0]; goff[1536] = v[1][1]; }
    const char* cA = cur.a; const char* cB = cur.b;
    unsigned vbc[2], vbn[2];
    S.boff(cur, voffB, vbc); vbn[0] = vbc[0]; vbn[1] = vbc[1];
    GS_STAGE_B(GS_SB(0, 0), cB, vbc); GS_STAGE_B(GS_SB(0, 1), cB + hstepB, vbc); GS_STAGE_A(GS_SA(0, 0), cA, 0, oc); GS_STAGE_A(GS_SA(0, 1), cA, 1, oc);
    if (wr == 1) BAR();
    WAIT_V(2); BAR();
    GS_STAGE_B(GS_SB(1, 0), cB + kstep, vbc); GS_STAGE_A(GS_SA(1, 0), cA + kstep, 0, oc); GS_STAGE_B(GS_SB(1, 1), cB + hstepB + kstep, vbc);
    WAIT_V(6); BAR();
    for (;;) {
        const bool has_next = S.next(ui + 1, nxt);
        const char* nA = has_next ? nxt.a : cA; const char* nB = has_next ? nxt.b : cB;
        if (has_next) S.boff(nxt, voffB, vbn);
#pragma unroll 1
        for (int t = 0; t < nt; t += 2) {
            const bool last = (t == nt - 2);
            if (GATHER && last) { unsigned v[2][2]; S.gather(has_next ? nxt : cur, v); LAS unsigned* gn = goff + (oc ^ 1) * 2048; gn[0] = v[0][0]; gn[512] = v[0][1]; gn[1024] = v[1][0]; gn[1536] = v[1][1]; }
            const char* a1 = cA + (size_t)(t + 1) * kstep;
            const char* a2 = last ? nA : cA + (size_t)(t + 2) * kstep; const char* b2 = last ? nB : cB + (size_t)(t + 2) * kstep;
            const char* a3 = a2 + kstep; const char* b3 = b2 + kstep;
            const int o2 = last ? (oc ^ 1) : oc;
            unsigned vb2[2]; vb2[0] = last ? vbn[0] : vbc[0]; vb2[1] = last ? vbn[1] : vbc[1];
            GS_LDB(B0, 0, 0); GS_LDB(B1, 0, 1); GS_SCHED; GS_LDA(At, 0, 0); GS_STAGE_A(GS_SA(1, 1), a1, 1, oc);
            WAIT_V(8); WAIT_L(0); BAR(); GS_MMA(0, 0, At, B0); GS_MMA(0, 1, At, B1); BAR(); GS_SCHED;
            GS_LDA(At, 0, 1); GS_STAGE_B(GS_SB(0, 0), b2, vb2); GS_STAGE_B(GS_SB(0, 1), b2 + hstepB, vb2); GS_STAGE_A(GS_SA(0, 0), a2, 0, o2);
            WAIT_V(8); WAIT_L(0); BAR(); GS_MMA(1, 0, At, B0); GS_MMA(1, 1, At, B1); BAR(); GS_SCHED;
            GS_LDB(B0, 1, 0); GS_LDB(B1, 1, 1); GS_SCHED; GS_LDA(At, 1, 0); GS_STAGE_A(GS_SA(0, 1), a2, 1, o2);
            WAIT_V(8); WAIT_L(0); BAR(); GS_MMA(0, 0, At, B0); GS_MMA(0, 1, At, B1); BAR(); GS_SCHED;
            GS_LDA(At, 1, 1); GS_STAGE_B(GS_SB(1, 0), b3, vb2); GS_STAGE_B(GS_SB(1, 1), b3 + hstepB, vb2); GS_STAGE_A(GS_SA(1, 0), a3, 0, o2);
            WAIT_V(8); WAIT_L(0); BAR(); GS_MMA(1, 0, At, B0); GS_MMA(1, 1, At, B1); BAR(); GS_SCHED;
        }
        if (wr == 0) BAR();
        E(acc, cur, g);
        if (!has_next) break;
        acc_zero<2>(acc);
        cur = nxt; cA = nA; cB = nB; ++ui; vbc[0] = vbn[0]; vbc[1] = vbn[1];
        oc ^= 1;
        if (wr == 1) BAR();
    }
    WAIT_V(0);
    BAR();
#undef GS_SA
#undef GS_SB
#undef GS_STAGE
#undef GS_STAGE_B
#undef GS_STAGE_A
#undef GS_LDA
#undef GS_LDB
#undef GS_MMA
#undef GS_SCHED
}

__device__ __forceinline__ void tr_item(const float* W, int N, bf16_t* WT, int Kd, int k0, int n0, int mode, LAS float* scr, int lane, unsigned char* W8 = nullptr) {
    float tv[32];
#pragma unroll
    for (int i = 0; i < 32; ++i) tv[i] = W[(size_t)(k0 + 2 * i + (lane >> 5)) * N + n0 + (lane & 31)];
#pragma unroll
    for (int i = 0; i < 32; ++i) scr[(2 * i + (lane >> 5)) * 33 + (lane & 31)] = tv[i];
    WAIT_L(0); asm volatile("" ::: "memory");
    const int c = lane & 7;
#pragma unroll
    for (int j = 0; j < 4; ++j) {
        const int nl = (lane >> 3) + 8 * j; const LAS float* s = scr + (8 * c) * 33 + nl;
        u32x4 o; o.x = cvt_pk_bf16(s[0 * 33], s[1 * 33]); o.y = cvt_pk_bf16(s[2 * 33], s[3 * 33]); o.z = cvt_pk_bf16(s[4 * 33], s[5 * 33]); o.w = cvt_pk_bf16(s[6 * 33], s[7 * 33]);
        const int n = n0 + nl;
        const int cs = n & 127, sl = (cs >> 5) * 32 + ((cs >> 2) & 1) * 16 + ((cs >> 3) & 3) * 4 + (cs & 3);
        const int drow = (mode == 0) ? n : ((mode == 3) ? ((n & ~127) + sl) : (256 * (n >> 7) + sl + (mode == 2 ? 128 : 0)));
        if (WT != nullptr) *(u32x4*)(WT + (size_t)drow * Kd + k0 + 8 * c) = o;
        if (W8 != nullptr) { u32x2 q; q.x = cvt_pk4_fp8(64.f * s[0 * 33], 64.f * s[1 * 33], 64.f * s[2 * 33], 64.f * s[3 * 33]); q.y = cvt_pk4_fp8(64.f * s[4 * 33], 64.f * s[5 * 33], 64.f * s[6 * 33], 64.f * s[7 * 33]);
            *(u32x2*)(W8 + (size_t)drow * Kd + k0 + 8 * c) = q; }
    }
    WAIT_L(0); asm volatile("" ::: "memory");
}
__device__ __forceinline__ void mod_unit(Frame& F, int u) {
    const int l = u / 96, cb = u % 96;
    LAS float* sl = (LAS float*)F.lds;
    const float* c = F.in[I_C]; const float* cc = F.in[I_CCTX];
    for (int idx = F.tid; idx < 33 * 1024; idx += 512) { const int r = idx >> 10, k = idx & 1023; const float cv = (r < 32) ? c[r * 1024 + k] : cc[k]; sl[idx] = cv / (1.0f + expf(-cv)); }
    SYNC();
    float acc[33];
#pragma unroll
    for (int r = 0; r < 33; ++r) acc[r] = 0.f;
    const float* W = F.in[I_WMOD] + (size_t)l * 1024 * 6144 + 64 * cb + F.lane;
    const int kb = F.wave * 128;
    for (int k0 = 0; k0 < 128; k0 += 16) {
        float wv[16];
#pragma unroll
        for (int kk = 0; kk < 16; ++kk) wv[kk] = W[(size_t)(kb + k0 + kk) * 6144];
#pragma unroll
        for (int kk = 0; kk < 16; ++kk)
#pragma unroll
            for (int r = 0; r < 33; ++r) acc[r] += sl[r * 1024 + kb + k0 + kk] * wv[kk];
    }
    SYNC();
#pragma unroll
    for (int r = 0; r < 33; ++r) sl[(F.wave * 33 + r) * 64 + F.lane] = acc[r];
    SYNC();
    float* MOD = (float*)(F.ws + WS_MOD);
    for (int idx = F.tid; idx < 33 * 64; idx += 512) {
        const int r = idx >> 6, cl = idx & 63; float s = 0.f;
#pragma unroll
        for (int w = 0; w < 8; ++w) s += sl[(w * 33 + r) * 64 + cl];
        MOD[(size_t)(l * 33 + r) * 6144 + 64 * cb + cl] = s + F.in[I_BMOD][l * 6144 + 64 * cb + cl];
    }
    SYNC();
}
__device__ __forceinline__ void phase_pro(Frame& F) {
    for (int u = blockIdx.x; u < 192; u += F.G) mod_unit(F, u);
    if (blockIdx.x == F.G - 1) {
        float* TB = (float*)(F.ws + WS_TAB);
        for (int idx = F.tid; idx < 1024; idx += 512) { const int pos = idx >> 4, i = idx & 15; const float inv = 1.0f / powf(10000.0f, (float)i / 16.0f); const float a = (float)pos * inv; TB[TB_R64C + idx] = cosf(a); TB[TB_R64S + idx] = sinf(a); }
        for (int idx = F.tid; idx < 512; idx += 512) { const int pos = idx >> 3, i = idx & 7; const float inv = 1.0f / powf(10000.0f, (float)i / 8.0f); const float a = (float)pos * inv; TB[TB_R32C + idx] = cosf(a); TB[TB_R32S + idx] = sinf(a); }
        if (F.tid < 2) {
            const int l = F.tid; const float* lp = F.in[I_DLAM] + l * 128; float s1 = 0.f, s2 = 0.f;
            for (int i = 0; i < 32; ++i) { s1 += lp[i] * lp[32 + i]; s2 += lp[64 + i] * lp[96 + i]; }
            const float lam_init = 0.8f - 0.6f * expf(-0.3f * (float)l);
            float* sc = TB + TB_SC + 16 * l;
            sc[0] = expf(s1) - expf(s2) + lam_init; sc[1] = 1.0f - lam_init;
            for (int d = 0; d < 2; ++d) for (int h = 0; h < 4; ++h) sc[2 + 4 * d + h] = log1pf(-expf(F.in[I_RLD][l * 8 + d * 4 + h])) * LOG2E;
        }
    }
    LAS float* scr = (LAS float*)(F.lds + F.wave * 16384);
    const int gw = blockIdx.x * 8 + F.wave, NGW = F.G * 8;
    constexpr int I_IN = 16 * 224, I_BRN = 4 * 32, I_OUT = 16 * 32, I_GE = 16 * 16, I_DE = 8 * 32;
    constexpr int PER_LAYER = I_IN + 4 * I_BRN + I_OUT + 16 * (2 * I_GE + I_DE);
    for (int it = gw; it < 2 * PER_LAYER; it += NGW) {
        const int l = it / PER_LAYER; int r = it % PER_LAYER;
        if (r < I_IN) { tr_item(F.in[I_WIN] + (size_t)l * 1024 * INW, INW, (bf16_t*)nullptr, 1024, 64 * (r / 224), 32 * (r % 224), (32 * (r % 224) >= 3072) ? 3 : 0, scr, F.lane, F.ws + WS_WIN8 + (size_t)l * INW * 1024); continue; } r -= I_IN;
        if (r < 4 * I_BRN) { const int n = r / I_BRN; r %= I_BRN; tr_item(F.in[I_WBR] + (size_t)(l * 4 + n) * 256 * 1024, 1024, (bf16_t*)nullptr, 256, 64 * (r / 32), 32 * (r % 32), 3, scr, F.lane, F.ws + WS_WBR + (size_t)(l * 4 + n) * 1024 * 256); continue; } r -= 4 * I_BRN;
        if (r < I_OUT) { tr_item(F.in[I_WOUT] + (size_t)l * 1024 * 1024, 1024, (bf16_t*)nullptr, 1024, 64 * (r / 32), 32 * (r % 32), 0, scr, F.lane, F.ws + WS_WOUT + (size_t)l * 1024 * 1024); continue; } r -= I_OUT;
        const int e = r / (2 * I_GE + I_DE); r %= (2 * I_GE + I_DE);
        const size_t le = (size_t)(l * 16 + e);
        if (r < I_GE) { tr_item(F.in[I_WG] + le * 1024 * 512, 512, (bf16_t*)nullptr, 1024, 64 * (r / 16), 32 * (r % 16), 1, scr, F.lane, F.ws + WS_WGU + le * 1024 * 1024); continue; } r -= I_GE;
        if (r < I_GE) { tr_item(F.in[I_WU] + le * 1024 * 512, 512, (bf16_t*)nullptr, 1024, 64 * (r / 16), 32 * (r % 16), 2, scr, F.lane, F.ws + WS_WGU + le * 1024 * 1024); continue; } r -= I_GE;
        tr_item(F.in[I_WD] + le * 512 * 1024, 1024, (bf16_t*)nullptr, 512, 64 * (r / 32), 32 * (r % 32), 3, scr, F.lane, F.ws + WS_WD + le * 1024 * 512);
    }
    SYNC();
}

__device__ __forceinline__ void row_load(const float* xrow, int lane, f32x4 (&v)[4]) {
    const f32x4* xr = (const f32x4*)xrow + lane;
#pragma unroll
    for (int j = 0; j < 4; ++j) v[j] = xr[64 * j];
}
__device__ __forceinline__ float row_rstd(const f32x4 (&v)[4]) {
    float s = 0.f;
#pragma unroll
    for (int j = 0; j < 4; ++j) s += (v[j].x * v[j].x + v[j].y * v[j].y) + (v[j].z * v[j].z + v[j].w * v[j].w);
    return 1.0f / sqrtf(wave_sum(s) * (1.0f / D) + EPS);
}
__device__ __forceinline__ void row_modulate(f32x4 (&v)[4], float rstd, const float* g, const float* shift, const float* scale, int lane) {
#pragma unroll
    for (int j = 0; j < 4; ++j) {
        const f32x4 gg = ((const f32x4*)g)[lane + 64 * j], sh = ((const f32x4*)shift)[lane + 64 * j], sc = ((const f32x4*)scale)[lane + 64 * j];
        v[j] = v[j] * rstd * gg * (sc + 1.0f) + sh;
    }
}
__device__ __forceinline__ void row_store_bf16(bf16_t* orow, int lane, const f32x4 (&v)[4]) {
    u32x2* o8 = (u32x2*)orow + lane;
#pragma unroll
    for (int j = 0; j < 4; ++j) { u32x2 w; w.x = cvt_pk_bf16(v[j].x, v[j].y); w.y = cvt_pk_bf16(v[j].z, v[j].w); o8[64 * j] = w; }
}
__device__ __forceinline__ void row_store_fp8(unsigned char* orow, int lane, const f32x4 (&v)[4]) {
    unsigned* o4 = (unsigned*)orow + lane;
#pragma unroll
    for (int j = 0; j < 4; ++j) o4[64 * j] = cvt_pk4_fp8(v[j].x, v[j].y, v[j].z, v[j].w);
}
__device__ __forceinline__ const float* mod_ptr(Frame& F, int layer, int row) {
    const int b = (row < TLAT) ? (row >> 11) : 32;
    return (const float*)(F.ws + WS_MOD) + (size_t)(layer * 33 + b) * 6144;
}
__device__ __forceinline__ void phase_norm1_l0(Frame& F) {
    const int gw = blockIdx.x * 8 + F.wave, NGW = F.G * 8;
    bf16_t* XH = (bf16_t*)(F.ws + WS_XH);
    for (int row = gw; row < T; row += NGW) {
        const float* xrow = (row < TLAT) ? F.in[I_X] + (size_t)row * D : F.in[I_CTX] + (size_t)(row - TLAT) * D;
        f32x4 v[4]; row_load(xrow, F.lane, v);
        const float rstd = row_rstd(v);
        const float* mp = mod_ptr(F, 0, row);
        row_modulate(v, rstd, F.in[I_G1], mp, mp + 1024, F.lane);
        row_store_fp8((unsigned char*)F.out + OUT_XH8 + (size_t)row * D, F.lane, v);
    }
}

__device__ __forceinline__ bool inproj_is_m8(int pn, int wc) { return pn == 3 || pn == 4 || pn == 7 || (pn == 8 && wc < 2); }
__device__ __forceinline__ void epi_inproj(Frame& F, const f32x4 (&acc)[2][2][4][2], const GeoT& g, int pm, int pn, int layer) {
    bf16_t* P = (bf16_t*)(F.ws + WS_P);
    const LAS float* TB = (const LAS float*)(F.lds + 147456);
    const bool lat = pm < 256;
    const bool m8 = inproj_is_m8(pn, g.wc);
    int mode = 0; float scale = 1.0f; const LAS float* gain = nullptr;
    switch (pn) {
        case 0: scale = 0.125f * LOG2E; break;
        case 3: mode = 2; break;
        case 4: mode = 2; scale = 0.125f; break;
        case 6: mode = 4; break;
        case 7: mode = 5; scale = 0.125f * LOG2E; gain = TB + 3072; break;
        case 8: if (g.wc < 2) { mode = 5; gain = TB + 3136; } break;
        case 9: mode = 7; scale = 0.17677669529663687f * LOG2E; break;
        case 10: mode = 7; break;
        default: break;
    }
    const int c0 = m8 ? (32 * (g.fq >> 1) + 8 * (g.fq & 1)) : 16 * g.fq;
    const int cstep = m8 ? 16 : 8;
#pragma unroll
    for (int ai = 0; ai < 2; ++ai)
#pragma unroll
        for (int m = 0; m < 4; ++m) {
            const int row = pm * 256 + ai * 128 + g.wr * 64 + m * 16 + g.fr;
            const int t = row & 2047, gr = t >> 6, gc = t & 63;
            float x[2][8];
#pragma unroll
            for (int n = 0; n < 2; ++n)
#pragma unroll
                for (int bj = 0; bj < 2; ++bj)
#pragma unroll
                    for (int j = 0; j < 4; ++j) x[n][4 * bj + j] = acc[ai][bj][m][n][j] * 0.015625f;
            if (mode == 5) {
                float ss = 0.f;
#pragma unroll
                for (int n = 0; n < 2; ++n)
#pragma unroll
                    for (int e = 0; e < 8; ++e) ss += x[n][e] * x[n][e];
                ss = swapsum16(ss, ss); ss = swapsum32(ss, ss);
                const float r = 1.0f / sqrtf(ss * (1.0f / 64.0f) + EPS);
#pragma unroll
                for (int n = 0; n < 2; ++n) { const f32x4 g0 = *(const LAS f32x4*)(gain + c0 + cstep * n), g1 = *(const LAS f32x4*)(gain + c0 + cstep * n + 4);
#pragma unroll
                    for (int e = 0; e < 4; ++e) { x[n][e] *= r * g0[e]; x[n][4 + e] *= r * g1[e]; } }
            }
            if ((mode == 2 || mode == 5) && lat) {
                const int pos = (g.fq >> 1) ? gc : gr; const int fo = pos * 16 + 8 * (g.fq & 1);
                const f32x4 ca = *(const LAS f32x4*)(TB + TB_R64C + fo), cb = *(const LAS f32x4*)(TB + TB_R64C + fo + 4), sa = *(const LAS f32x4*)(TB + TB_R64S + fo), sb = *(const LAS f32x4*)(TB + TB_R64S + fo + 4);
#pragma unroll
                for (int e = 0; e < 8; ++e) { const float cs = e < 4 ? ca[e & 3] : cb[e & 3], sn = e < 4 ? sa[e & 3] : sb[e & 3]; const float x1 = x[0][e], x2 = x[1][e]; x[0][e] = x1 * cs - x2 * sn; x[1][e] = x2 * cs + x1 * sn; }
            }
            if (mode == 7 && lat) {
                const int pos = (g.fq & 1) ? gc : gr; const int fo = pos * 8;
                const f32x4 ca = *(const LAS f32x4*)(TB + TB_R32C + fo), cb = *(const LAS f32x4*)(TB + TB_R32C + fo + 4), sa = *(const LAS f32x4*)(TB + TB_R32S + fo), sb = *(const LAS f32x4*)(TB + TB_R32S + fo + 4);
#pragma unroll
                for (int e = 0; e < 8; ++e) { const float cs = e < 4 ? ca[e & 3] : cb[e & 3], sn = e < 4 ? sa[e & 3] : sb[e & 3]; const float x1 = x[0][e], x2 = x[1][e]; x[0][e] = x1 * cs - x2 * sn; x[1][e] = x2 * cs + x1 * sn; }
            }
            LAS unsigned char* stg = F.lds + 131072 + g.wid * 2048;
#pragma unroll
            for (int n = 0; n < 2; ++n) {
                float o[8];
#pragma unroll
                for (int e = 0; e < 8; ++e) o[e] = x[n][e] * scale;
                if (mode == 4) { asm volatile("" ::: "memory");
#pragma unroll
                    for (int e = 0; e < 8; ++e) o[e] = siluf_(o[e]); }
                u32x4 w; w.x = cvt_pk_bf16(o[0], o[1]); w.y = cvt_pk_bf16(o[2], o[3]); w.z = cvt_pk_bf16(o[4], o[5]); w.w = cvt_pk_bf16(o[6], o[7]);
                *(LAS u32x4*)(stg + g.fr * 128 + (c0 + cstep * n) * 2) = w;
            }
            const int ln = g.fq * 16 + g.fr, srow = ln >> 3, spc = ln & 7;
            const u32x4 r0 = *(const LAS u32x4*)(stg + srow * 128 + spc * 16), r1 = *(const LAS u32x4*)(stg + (srow + 8) * 128 + spc * 16);
            bf16_t* pout = P + (size_t)(row - g.fr + srow) * PW + pn * 256 + g.wc * 64 + spc * 8;
            *(u32x4*)pout = r0; *(u32x4*)(pout + (size_t)8 * PW) = r1;
        }
}
struct SchedInproj {
    struct Unit { const char* a; const char* b; int pm, pn; };
    const char* A; const char* B; int G, c, layer;
    __device__ __forceinline__ bool next(int i, Unit& u) const {
        int pm, pn; const int L = i * G + c;
        if (L < 256 * 12) { (void)unit_order(L, 256, 12, pm, pn); }
        else { const int idx = L - 256 * 12, npn = (layer == 0) ? 12 : 7; if (idx >= 32 * npn) return false;
               const int q = idx / npn, r = idx - q * npn; pm = 256 + q;
               pn = (layer == 0) ? r : (r < 2 ? r + 1 : (r < 4 ? r + 2 : (r == 4 ? 8 : r + 5))); }
        u.pm = pm; u.pn = pn; u.a = A + (size_t)pm * 256 * 1024; u.b = B + (size_t)pn * 256 * 1024; return true; }
    __device__ __forceinline__ void gather(const Unit&, unsigned (&)[2][2]) const {}
    int R0, R1, C0, C1;
    __device__ __forceinline__ unsigned slot_off(int pn, int rho, int C) const {
        const int wc = rho >> 5, n = (rho >> 4) & 1, fq = (rho >> 2) & 3, j = rho & 3;
        const int hc = inproj_is_m8(pn, wc) ? (32 * (fq >> 1) + 8 * (fq & 1) + 16 * n + j) : (16 * fq + 8 * n + j);
        return (unsigned)(64 * wc + hc) * 1024u + (unsigned)C * 2u; }
    __device__ __forceinline__ void boff(const Unit& u, const unsigned (&)[2], unsigned (&v)[2]) const { v[0] = slot_off(u.pn, R0, C0); v[1] = slot_off(u.pn, R1, C1); }
};
struct EpiInproj { Frame F; int layer;
    __device__ __forceinline__ void operator()(const f32x4 (&acc)[2][2][4][2], const SchedInproj::Unit& u, const GeoT& g_) const { GeoT g = g_; asm volatile("" : "+v"(g.fr), "+v"(g.fq)); Frame f = F; epi_inproj(f, acc, g, u.pm, u.pn, layer); } };
__device__ __forceinline__ void phase_inproj(Frame& F, int layer) {
    const GeoT g = make_geo(F.tid);
    { LAS float* tl = (LAS float*)(F.lds + 147456); const float* tg = (const float*)(F.ws + WS_TAB);
      for (int i = F.tid; i < 3072; i += 512) tl[i] = tg[i];
      if (F.tid < 64) { tl[3072 + F.tid] = F.in[I_QG][layer * 64 + F.tid]; tl[3136 + F.tid] = F.in[I_KG][layer * 64 + F.tid]; }
      SYNC(); }
    SchedInproj S; S.A = (const char*)F.out + OUT_XH8; S.B = (const char*)(F.ws + WS_WIN8) + (size_t)layer * INW * 1024; S.G = F.G; S.c = blockIdx.x; S.layer = layer;
    S.R0 = g.R[0]; S.R1 = g.R[1]; S.C0 = g.C[0]; S.C1 = g.C[1];
    EpiInproj E; E.F = F; E.layer = layer;
    unsigned voffA[2], voffB[2] = {0u, 0u};
#pragma unroll
    for (int i = 0; i < 2; ++i) voffA[i] = (unsigned)g.R[i] * 1024u + (unsigned)g.C[i] * 2u;
    gemm_stream<false, true>(F.lds, S, E, 8, voffA, 128u * 1024u, voffB, 4u * 1024u, g);
}

constexpr int AL_K = 0, AL_V = 16384, AL_WSF = 32768, AL_OST = 36864, AL_TAB = 102400, AL_TABP = 137216;
typedef short v4i16_t __attribute__((ext_vector_type(4)));
__device__ __forceinline__ int crow(int r, int hi) { return (r & 3) + 8 * (r >> 2) + 4 * hi; }
__device__ __forceinline__ f32x16 mfma32(bf16x8 a, bf16x8 b, f32x16 c) { return __builtin_amdgcn_mfma_f32_32x32x16_bf16(a, b, c, 0, 0, 0); }
__device__ __forceinline__ s16x4 vtr(const LAS unsigned char* p) { return __builtin_bit_cast(s16x4, __builtin_amdgcn_ds_read_tr16_b64_v4i16((LAS v4i16_t*)p)); }
__device__ __forceinline__ f32x16 f16zero() { f32x16 z;
#pragma unroll
    for (int r = 0; r < 16; ++r) z[r] = 0.f;
    return z; }

template <int D0LO, int D0HI>
__device__ __forceinline__ void qk_tile(f32x16& p0, f32x16& p1, const LAS unsigned char* Kb, const bf16x8 (&qr)[4], int r32, int hi, float cm) {
    const LAS unsigned char* kb = Kb + hi * 1024 + r32 * 16;
    f32x16 cinit;
#pragma unroll
    for (int r = 0; r < 16; ++r) cinit[r] = cm;
    p0 = cinit; p1 = cinit;
#pragma unroll
    for (int d0 = D0LO; d0 < D0HI; ++d0) {
        const bf16x8 b0 = *(const LAS bf16x8*)(kb + d0 * 2048), b1 = *(const LAS bf16x8*)(kb + d0 * 2048 + 512);
        p0 = mfma32(b0, qr[d0], p0); p1 = mfma32(b1, qr[d0], p1);
    }
}
__device__ __forceinline__ float sm_tile(f32x16& p0, f32x16& p1, float& m, float& l) {
    float mx = fmaxf(p0[0], p1[0]);
#pragma unroll
    for (int r = 1; r < 16; ++r) mx = fmaxf(mx, fmaxf(p0[r], p1[r]));
    mx = fmaxf(mx, __shfl_xor(mx, 32));
    const float mn = fmaxf(m, mx), alpha = __builtin_amdgcn_exp2f(m - mn);
    m = mn; float s = 0.f;
#pragma unroll
    for (int r = 0; r < 16; ++r) { p0[r] = __builtin_amdgcn_exp2f(p0[r] - mn); p1[r] = __builtin_amdgcn_exp2f(p1[r] - mn); s += p0[r] + p1[r]; }
    l = l * alpha + s;
    return alpha;
}
__device__ __forceinline__ float max3f(float a, float b, float c) { float d; asm("v_max3_f32 %0, %1, %2, %3" : "=v"(d) : "v"(a), "v"(b), "v"(c)); return d; }
__device__ __forceinline__ float tile_rowmax(const f32x16& p0, const f32x16& p1) {
    float ma = max3f(p0[0], p0[1], p0[2]), mb = max3f(p1[0], p1[1], p1[2]);
#pragma unroll
    for (int r = 3; r < 15; r += 2) { ma = max3f(ma, p0[r], p0[r + 1]); mb = max3f(mb, p1[r], p1[r + 1]); }
    float mx = max3f(ma, mb, p0[15]);
    mx = max3f(mx, p1[15], p1[15]);
    { auto rr = __builtin_amdgcn_permlane32_swap(__float_as_uint(mx), __float_as_uint(mx), false, false); mx = max3f(__uint_as_float(rr[0]), __uint_as_float(rr[1]), __uint_as_float(rr[1])); }
    return mx;
}
__device__ __forceinline__ void v_frags(bf16x8 (&vf)[2][4], const LAS unsigned char* Vb, int lane, int hi) {
    const LAS unsigned char* vp = Vb + ((lane >> 4) & 1) * 32 + (lane & 3) * 8 + (4 * hi + ((lane & 15) >> 2)) * 64;
#pragma unroll
    for (int ks = 0; ks < 4; ++ks)
#pragma unroll
        for (int d0 = 0; d0 < 2; ++d0) {
            const s16x4 lo = vtr(vp + d0 * 4096 + ks * 1024), hh = vtr(vp + d0 * 4096 + ks * 1024 + 512);
            vf[d0][ks] = (bf16x8){lo[0], lo[1], lo[2], lo[3], hh[0], hh[1], hh[2], hh[3]};
        }
}
__device__ __forceinline__ void k_frags(bf16x8 (&kf)[4][2], const LAS unsigned char* Kb, int r32, int hi) {
    const LAS unsigned char* kb = Kb + hi * 1024 + r32 * 16;
#pragma unroll
    for (int d0 = 0; d0 < 4; ++d0) { kf[d0][0] = *(const LAS bf16x8*)(kb + d0 * 2048); kf[d0][1] = *(const LAS bf16x8*)(kb + d0 * 2048 + 512); }
}
__device__ __forceinline__ void pv_mma(f32x16 (&o)[2], const bf16x8 (&pw)[4], const bf16x8 (&vf)[2][4]) {
#pragma unroll
    for (int ks = 0; ks < 4; ++ks) { o[0] = mfma32(pw[ks], vf[0][ks], o[0]); o[1] = mfma32(pw[ks], vf[1][ks], o[1]); }
}
template <int D0LO, int D0HI>
__device__ __forceinline__ void qk_mma(f32x16& p0, f32x16& p1, const bf16x8 (&kf)[4][2], const bf16x8 (&qr)[4], float cm) {
    f32x16 cinit;
#pragma unroll
    for (int r = 0; r < 16; ++r) cinit[r] = cm;
    p0 = cinit; p1 = cinit;
#pragma unroll
    for (int d0 = D0LO; d0 < D0HI; ++d0) { p0 = mfma32(kf[d0][0], qr[d0], p0); p1 = mfma32(kf[d0][1], qr[d0], p1); }
}
__device__ __forceinline__ void qk_mma_c2(f32x16& p0, f32x16& p1, const bf16x8 (&kf)[4][2], const bf16x8 (&qr)[4], const f32x16& c0, const f32x16& c1) {
    p0 = mfma32(kf[0][0], qr[0], c0); p1 = mfma32(kf[0][1], qr[0], c1);
#pragma unroll
    for (int d0 = 1; d0 < 4; ++d0) { p0 = mfma32(kf[d0][0], qr[d0], p0); p1 = mfma32(kf[d0][1], qr[d0], p1); }
}
#ifndef MK_FORCE_SAFE
#define MK_FORCE_SAFE 0
#endif
__device__ __forceinline__ float sm_tile_fast(f32x16& p0, f32x16& p1, float& l) {
    float s = 0.f;
#pragma unroll
    for (int r = 0; r < 16; ++r) { p0[r] = __builtin_amdgcn_exp2f(p0[r]); p1[r] = __builtin_amdgcn_exp2f(p1[r]); s += p0[r] + p1[r]; }
    l += s;
    asm volatile("" : "+v"(l));
    return s;
}
__device__ __forceinline__ bool wg_any(LAS unsigned char* lds, int wid, int lane, bool bad) {
    LAS int* fl = (LAS int*)(lds + 102400);
    const bool wbad = __any(bad) != 0;
    if (lane == 0) fl[wid] = wbad ? 1 : 0;
    SYNC();
    int acc = 0;
#pragma unroll
    for (int i = 0; i < 8; ++i) acc |= fl[i];
    SYNC();
    return __builtin_amdgcn_readfirstlane(acc) != 0;
}
__device__ __forceinline__ bool sm_tile2(f32x16& p0, f32x16& p1, float& m, float& l, float& f, bool first) {
    const float mx = tile_rowmax(p0, p1);
    bool resc = false; f = 1.0f;
    if (first || __any(mx > 8.0f)) {
        const float dl = first ? mx : fmaxf(mx, 0.0f);
        m += dl;
#pragma unroll
        for (int r = 0; r < 16; ++r) { p0[r] -= dl; p1[r] -= dl; }
        f = __builtin_amdgcn_exp2f(-dl); l *= f; resc = true;
    }
    float s = 0.f;
#pragma unroll
    for (int r = 0; r < 16; ++r) { p0[r] = __builtin_amdgcn_exp2f(p0[r]); p1[r] = __builtin_amdgcn_exp2f(p1[r]); s += p0[r] + p1[r]; }
    l += s;
    asm volatile("" : "+v"(l));
    return resc;
}
__device__ __forceinline__ void o_scale(f32x16 (&o)[2], float f, LAS float* wsf, int r32, int hi) {
    asm volatile("" ::: "memory");
    if (hi == 0) wsf[r32] = f;
    asm volatile("s_waitcnt lgkmcnt(0)" ::: "memory");
#pragma unroll
    for (int r = 0; r < 16; ++r) { const float g = wsf[crow(r, hi)]; o[0][r] *= g; o[1][r] *= g; }
    asm volatile("s_waitcnt lgkmcnt(0)" ::: "memory");
}
__device__ __forceinline__ void pack_p(const f32x16& p0, const f32x16& p1, bf16x8 (&pw)[4]) {
    u32x4 w;
    w.x = cvt_pk_bf16(p0[0], p0[1]); w.y = cvt_pk_bf16(p0[2], p0[3]); w.z = cvt_pk_bf16(p0[4], p0[5]); w.w = cvt_pk_bf16(p0[6], p0[7]); pw[0] = __builtin_bit_cast(bf16x8, w);
    w.x = cvt_pk_bf16(p0[8], p0[9]); w.y = cvt_pk_bf16(p0[10], p0[11]); w.z = cvt_pk_bf16(p0[12], p0[13]); w.w = cvt_pk_bf16(p0[14], p0[15]); pw[1] = __builtin_bit_cast(bf16x8, w);
    w.x = cvt_pk_bf16(p1[0], p1[1]); w.y = cvt_pk_bf16(p1[2], p1[3]); w.z = cvt_pk_bf16(p1[4], p1[5]); w.w = cvt_pk_bf16(p1[6], p1[7]); pw[2] = __builtin_bit_cast(bf16x8, w);
    w.x = cvt_pk_bf16(p1[8], p1[9]); w.y = cvt_pk_bf16(p1[10], p1[11]); w.z = cvt_pk_bf16(p1[12], p1[13]); w.w = cvt_pk_bf16(p1[14], p1[15]); pw[3] = __builtin_bit_cast(bf16x8, w);
}
__device__ __forceinline__ void pv_tile(f32x16 (&o)[2], const LAS unsigned char* Vb, const bf16x8 (&pw)[4], int lane, int hi) {
    const LAS unsigned char* vp = Vb + ((lane >> 4) & 1) * 32 + (lane & 3) * 8 + (4 * hi + ((lane & 15) >> 2)) * 64;
#pragma unroll
    for (int d0 = 0; d0 < 2; ++d0)
#pragma unroll
        for (int ks = 0; ks < 4; ++ks) {
            const s16x4 lo = vtr(vp + d0 * 4096 + ks * 1024), hh = vtr(vp + d0 * 4096 + ks * 1024 + 512);
            const bf16x8 vf = (bf16x8){lo[0], lo[1], lo[2], lo[3], hh[0], hh[1], hh[2], hh[3]};
            o[d0] = mfma32(pw[ks], vf, o[d0]);
        }
}
__device__ __forceinline__ void o_stage(const f32x16 (&o)[2], LAS float* ost, int r32, int hi) {
#pragma unroll
    for (int r = 0; r < 16; ++r) { const int q = crow(r, hi); ost[q * 64 + r32] = o[0][r]; ost[q * 64 + 32 + r32] = o[1][r]; }
    asm volatile("s_waitcnt lgkmcnt(0)" ::: "memory");
}
__device__ __forceinline__ void stage_row_read(const LAS float* ost, int lane, float (&x)[32]) {
    const LAS f32x4* s = (const LAS f32x4*)(ost + (lane >> 1) * 64 + (lane & 1) * 32);
#pragma unroll
    for (int i = 0; i < 8; ++i) { const f32x4 v = s[i]; x[4 * i] = v.x; x[4 * i + 1] = v.y; x[4 * i + 2] = v.z; x[4 * i + 3] = v.w; }
    asm volatile("s_waitcnt lgkmcnt(0)" ::: "memory");
}
__device__ __forceinline__ void store_row32_f8(unsigned char* dst, const float (&x)[32]) {
#pragma unroll
    for (int i = 0; i < 2; ++i) { u32x4 w;
        w.x = cvt_pk4_fp8(8.f * x[16 * i], 8.f * x[16 * i + 1], 8.f * x[16 * i + 2], 8.f * x[16 * i + 3]); w.y = cvt_pk4_fp8(8.f * x[16 * i + 4], 8.f * x[16 * i + 5], 8.f * x[16 * i + 6], 8.f * x[16 * i + 7]);
        w.z = cvt_pk4_fp8(8.f * x[16 * i + 8], 8.f * x[16 * i + 9], 8.f * x[16 * i + 10], 8.f * x[16 * i + 11]); w.w = cvt_pk4_fp8(8.f * x[16 * i + 12], 8.f * x[16 * i + 13], 8.f * x[16 * i + 14], 8.f * x[16 * i + 15]);
        ((u32x4*)dst)[i] = w; }
}
__device__ __forceinline__ void store_row32(bf16_t* dst, const float (&x)[32]) {
#pragma unroll
    for (int i = 0; i < 4; ++i) { u32x4 w; w.x = cvt_pk_bf16(x[8 * i], x[8 * i + 1]); w.y = cvt_pk_bf16(x[8 * i + 2], x[8 * i + 3]); w.z = cvt_pk_bf16(x[8 * i + 4], x[8 * i + 5]); w.w = cvt_pk_bf16(x[8 * i + 6], x[8 * i + 7]); ((u32x4*)dst)[i] = w; }
}

struct SmUnit {
    int qrow, qcol, kcol, vcol, ycol;
    int n1, row1, n2, row2;
    int na_r, na_c, na_kr0;
};
#define AT_LOADKV(t) do { const int _r0 = ((t) < U.n1) ? U.row1 + 64 * (t) : U.row2 + 64 * ((t) - U.n1); \
        kreg = *(const u32x4*)(Pb + (size_t)(_r0 + lane) * (PW * 2) + (U.kcol + 8 * wid) * 2); \
        vreg = *(const u32x4*)(Pb + (size_t)(_r0 + 16 * (wid & 3) + (lane >> 2)) * (PW * 2) + (U.vcol + 32 * (wid >> 2) + 8 * (lane & 3)) * 2); } while (0)
#define AT_COMMIT(buf) do { *(LAS u32x4*)(lds + AL_K + (buf) * 8192 + wid * 1024 + lane * 16) = kreg; *(LAS u32x4*)(lds + AL_V + (buf) * 8192 + wid * 1024 + lane * 16) = vreg; } while (0)

constexpr int AL_K3 = 0, AL_V3 = 104448;
__device__ __forceinline__ void dma16(const void* gptr, unsigned ldsoff) {
    unsigned tmp; ldsoff = __builtin_amdgcn_readfirstlane(ldsoff);
    asm volatile("s_mov_b32 %0, m0\n\ts_mov_b32 m0, %1\n\ts_nop 0\n\tglobal_load_lds_dwordx4 %2, off\n\ts_mov_b32 m0, %0" : "=&s"(tmp) : "s"(ldsoff), "v"(gptr) : "memory");
}
#define AT_TROW(tt) (((tt) < U.n1) ? U.row1 + 64 * (tt) : U.row2 + 64 * ((tt) - U.n1))
#define AT_DMAK(tt) do { const int _r0 = AT_TROW(tt); dma16(Pb + (size_t)(_r0 + lane) * (PW * 2) + (U.kcol + 8 * wid) * 2, \
        (unsigned)(size_t)(lds + AL_K3 + ((tt) & 3) * 8192 + wid * 1024)); } while (0)
#define AT_DMAV(tt) do { const int _r0 = AT_TROW(tt); dma16(Pb + (size_t)(_r0 + 16 * (wid & 3) + (lane >> 2)) * (PW * 2) + (U.vcol + 32 * (wid >> 2) + 8 * (lane & 3)) * 2, \
        (unsigned)(size_t)(lds + AL_V3 + ((tt) & 3) * 8192 + wid * 1024)); } while (0)
#define AT_PROLOGUE() do { AT_DMAK(0); AT_DMAV(0); if (NT > 1) { AT_DMAK(1); AT_DMAV(1); } if (NT > 2) { AT_DMAK(2); AT_DMAV(2); } if (NT > 3) AT_DMAK(3); } while (0)
#define AT_WAIT_BAR2(t) do { if ((t) + 3 < NT) asm volatile("s_waitcnt vmcnt(2) lgkmcnt(0)" ::: "memory"); else asm volatile("s_waitcnt vmcnt(0) lgkmcnt(0)" ::: "memory"); \
        __builtin_amdgcn_s_barrier(); asm volatile("" ::: "memory"); } while (0)
#define AT_WAIT_BAR(t) do { if ((t) + 3 < NT) asm volatile("s_waitcnt vmcnt(4) lgkmcnt(0)" ::: "memory"); else asm volatile("s_waitcnt vmcnt(0) lgkmcnt(0)" ::: "memory"); \
        __builtin_amdgcn_s_barrier(); asm volatile("" ::: "memory"); } while (0)
#define BAR_L() do { asm volatile("s_waitcnt lgkmcnt(0)" ::: "memory"); __builtin_amdgcn_s_barrier(); asm volatile("" ::: "memory"); } while (0)
#define A3_COMMIT(sl) do { *(LAS u32x4*)(lds + AL_K3 + (sl) * 8192 + wid * 1024 + lane * 16) = kreg; *(LAS u32x4*)(lds + AL_V3 + (sl) * 8192 + wid * 1024 + lane * 16) = vreg; } while (0)
template <bool NA, bool FAST>
__device__ __forceinline__ bool sm_unit_x(Frame& F, const SmUnit& U_) {
    SmUnit U = U_; VG(U.qcol); VG(U.kcol); VG(U.vcol); VG(U.ycol); VG(U.row1); VG(U.row2);
    const char* Pb = (const char*)(F.ws + WS_P);
    LAS unsigned char* lds = F.lds;
    const int lane_ = lane_now();
    const int lane = lane_, r32 = lane & 31, hi = lane >> 5, wid = F.wave;
    const bool trail = wid >= 4;
    bf16x8 qr[4];
    { const char* qp = Pb + (size_t)U.qrow * (PW * 2) + (U.qcol + 8 * hi) * 2;
#pragma unroll
      for (int d0 = 0; d0 < 4; ++d0) qr[d0] = *(const bf16x8*)(qp + d0 * 32); }
    const int NT = U.n1 + U.n2;
    AT_PROLOGUE();
    SYNC();
    float m = 0.f, l = 0.f; f32x16 o[2]; o[0] = f16zero(); o[1] = f16zero();
    f32x16 p0 = f16zero(), p1 = f16zero();
    LAS float* wsf = (LAS float*)(lds + AL_WSF) + wid * 128;
    const LAS float* tab = (const LAS float*)(lds + AL_TAB);
    const int na_r0 = min(max(U.na_r - 4, 0), 24), na_ws = min(max(U.na_c - 8, 0), 48);
#define SM_ACTIVE(tt) (!(NA && (tt) >= U.n1) || ((U.na_kr0 + ((tt) - U.n1)) >= na_r0 && (U.na_kr0 + ((tt) - U.n1)) < na_r0 + 8))
    bool act = SM_ACTIVE(0);
    if (act) qk_tile<0, 4>(p0, p1, lds + AL_K3, qr, r32, hi, 0.0f);
    bool seen = false, bad = false;
    f32x16 cw0 = f16zero(), cw1 = f16zero();
#define NA_CW() do { _Pragma("unroll") for (int r = 0; r < 16; ++r) { const int kc0 = crow(r, hi); \
        cw0[r] = ((unsigned)(kc0 - na_ws) < 16u) ? -m : -1e30f; cw1[r] = ((unsigned)(kc0 + 32 - na_ws) < 16u) ? -m : -1e30f; } } while (0)
    if (NA) NA_CW();
    bf16x8 vf[2][4], kf[4][2];
    bool actn = (NT > 1) && SM_ACTIVE(1);
    if (act) v_frags(vf, lds + AL_V3, lane, hi);
    if (actn) k_frags(kf, lds + AL_K3 + 8192, r32, hi);
    if (trail) BAR_L();
    for (int t = 0; t < NT; ++t) {
        bf16x8 pw[4];
        if (act) {
            if (NA && t >= U.n1) { const int _kr = U.na_kr0 + (t - U.n1); const LAS float* trow = (const LAS float*)(lds + AL_TABP) + (_kr - U.na_r + 7) * 128 + (63 + 4 * hi - U.na_c);
#pragma unroll
                for (int r = 0; r < 16; ++r) { p0[r] += trow[(r & 3) + 8 * (r >> 2)]; p1[r] += trow[(r & 3) + 8 * (r >> 2) + 32]; } }
            if (FAST) { const float st = sm_tile_fast(p0, p1, l); bad |= !(st < 1.0e21f); }
            else { float fsc; const bool resc = sm_tile2(p0, p1, m, l, fsc, !seen); seen = true;
                   if (resc) { o_scale(o, fsc, wsf, r32, hi); if (NA) NA_CW(); } }
            pack_p(p0, p1, pw);
        }
        AT_WAIT_BAR2(t);
        if (t + 4 < NT) AT_DMAK(t + 4);
        if (t + 3 < NT) AT_DMAV(t + 3);
        if (act) pv_mma(o, pw, vf);
        if (actn) { if (NA && t + 1 >= U.n1) qk_mma_c2(p0, p1, kf, qr, cw0, cw1); else if (FAST) qk_mma<0, 4>(p0, p1, kf, qr, 0.0f); else qk_mma<0, 4>(p0, p1, kf, qr, -m); }
        __builtin_amdgcn_sched_barrier(0);
        const bool actnn = (t + 2 < NT) && SM_ACTIVE(t + 2);
        if (actn) v_frags(vf, lds + AL_V3 + ((t + 1) & 3) * 8192, lane, hi);
        if (actnn) k_frags(kf, lds + AL_K3 + ((t + 2) & 3) * 8192, r32, hi);
        act = actn; actn = actnn;
        __builtin_amdgcn_s_barrier();
        asm volatile("" ::: "memory");
    }
    if (!trail) BAR_L();
#undef SM_ACTIVE
    l += __shfl_xor(l, 32);
    if (FAST) { bad |= !(l > 1.0e-21f && l < 1.0e24f); if (MK_FORCE_SAFE) bad = true;
                if (wg_any(lds, wid, lane, bad)) return true; }
    o_scale(o, 1.0f / l, wsf, r32, hi);
    LAS float* ost = (LAS float*)(lds + AL_OST) + wid * 2048;
    o_stage(o, ost, r32, hi);
    float x[32]; stage_row_read(ost, lane, x);
    const int trow_q = __shfl(U.qrow, lane >> 1);
    store_row32_f8(F.ws + WS_Y + (size_t)trow_q * D + U.ycol + 32 * (lane & 1), x);
    return false;
}


__device__ __forceinline__ bool sm_unit_pipe(Frame& F, const SmUnit& U_) {
    SmUnit U = U_; VG(U.qcol); VG(U.kcol); VG(U.vcol); VG(U.ycol); VG(U.row1); VG(U.row2);
    const char* Pb = (const char*)(F.ws + WS_P);
    LAS unsigned char* lds = F.lds;
    const int lane_ = lane_now();
    const int lane = lane_, r32 = lane & 31, hi = lane >> 5, wid = F.wave;
    bf16x8 qr[4];
    { const char* qp = Pb + (size_t)U.qrow * (PW * 2) + (U.qcol + 8 * hi) * 2;
#pragma unroll
      for (int d0 = 0; d0 < 4; ++d0) qr[d0] = *(const bf16x8*)(qp + d0 * 32); }
    const int NT = U.n1 + U.n2;
    AT_PROLOGUE();
    SYNC();
    float l = 0.f; bool bad = false;
    f32x16 o[2]; o[0] = f16zero(); o[1] = f16zero();
    f32x16 pa0, pa1, pb0 = f16zero(), pb1 = f16zero();
    bf16x8 vf[2][4], kf[4][2], pwA[4], pwB[4];
    LAS float* wsf = (LAS float*)(lds + AL_WSF) + wid * 128;
    k_frags(kf, lds + AL_K3, r32, hi);
    qk_mma<0, 4>(pa0, pa1, kf, qr, 0.0f);
    BAR_L();
#define PSTEP(t_, HV, HQ, HS, PC0, PC1, PN0, PN1, PWP, PWC) do { const int t = (t_); \
        if (t + 4 < NT) AT_DMAK(t + 4); \
        if (t >= 1 && t + 2 < NT) AT_DMAV(t + 2); \
        if (HV) v_frags(vf, lds + AL_V3 + ((t - 1) & 3) * 8192, lane, hi); \
        if (HQ) k_frags(kf, lds + AL_K3 + ((t + 1) & 3) * 8192, r32, hi); \
        __builtin_amdgcn_sched_barrier(0); \
        if (HV) pv_mma(o, PWP, vf); \
        if (HQ) qk_mma<0, 4>(PN0, PN1, kf, qr, 0.0f); \
        if (HS) { const float s_ = sm_tile_fast(PC0, PC1, l); bad |= !(s_ < 1.0e21f); pack_p(PC0, PC1, PWC); } \
        if (t >= 2 && t + 4 < NT) asm volatile("s_waitcnt vmcnt(4) lgkmcnt(0)" ::: "memory"); else asm volatile("s_waitcnt vmcnt(0) lgkmcnt(0)" ::: "memory"); \
        __builtin_amdgcn_s_barrier(); asm volatile("" ::: "memory"); } while (0)
    PSTEP(0, false, true, true, pa0, pa1, pb0, pb1, pwB, pwA);
    for (int tt = 1; tt < NT - 1; tt += 2) {
        PSTEP(tt, true, true, true, pb0, pb1, pa0, pa1, pwA, pwB);
        PSTEP(tt + 1, true, true, true, pa0, pa1, pb0, pb1, pwB, pwA);
    }
    PSTEP(NT - 1, true, false, true, pb0, pb1, pa0, pa1, pwA, pwB);
    PSTEP(NT, true, false, false, pa0, pa1, pb0, pb1, pwB, pwA);
#undef PSTEP
    asm volatile("s_waitcnt lgkmcnt(0)" ::: "memory");
    l += __shfl_xor(l, 32);
    bad |= !(l > 1.0e-21f && l < 1.0e24f); if (MK_FORCE_SAFE) bad = true;
    if (wg_any(lds, wid, lane, bad)) return true;
    o_scale(o, 1.0f / l, wsf, r32, hi);
    LAS float* ost = (LAS float*)(lds + AL_OST) + wid * 2048;
    o_stage(o, ost, r32, hi);
    float x[32]; stage_row_read(ost, lane, x);
    const int trow_q = __shfl(U.qrow, lane >> 1);
    store_row32_f8(F.ws + WS_Y + (size_t)trow_q * D + U.ycol + 32 * (lane & 1), x);
    return false;
}

__device__ __forceinline__ bool na_unit_pipe(Frame& F, const SmUnit& U_) {
    SmUnit U = U_;
    const char* Pb = (const char*)(F.ws + WS_P);
    LAS unsigned char* lds = F.lds;
    const int lane_ = lane_now();
    const int lane = lane_, r32 = lane & 31, hi = lane >> 5, wid = F.wave;
    bf16x8 qr[4];
    { const char* qp = Pb + (size_t)U.qrow * (PW * 2) + (U.qcol + 8 * hi) * 2;
#pragma unroll
      for (int d0 = 0; d0 < 4; ++d0) qr[d0] = *(const bf16x8*)(qp + d0 * 32); }
    const int NT = U.n1 + U.n2;
    AT_PROLOGUE();
    SYNC();
    float l = 0.f; bool bad = false;
    f32x16 o[2]; o[0] = f16zero(); o[1] = f16zero();
    f32x16 pa0, pa1, pb0 = f16zero(), pb1 = f16zero();
    bf16x8 kf[4][2], pwA[4], pwB[4];
    LAS float* wsf = (LAS float*)(lds + AL_WSF) + wid * 128;
    const int na_r0 = min(max(U.na_r - 4, 0), 24), na_ws = min(max(U.na_c - 8, 0), 48);
#define PACT(tt) (((tt) < U.n1) || ((U.na_kr0 + ((tt) - U.n1)) >= na_r0 && (U.na_kr0 + ((tt) - U.n1)) < na_r0 + 8))
    LAS f32x4* cwl = (LAS f32x4*)(lds + AL_OST + wid * 8192) + lane;
#pragma unroll
    for (int k = 0; k < 8; ++k) { f32x4 w;
#pragma unroll
        for (int j = 0; j < 4; ++j) { const int r = 4 * (k & 3) + j, kc = crow(r, hi) + 32 * (k >> 2); w[j] = ((unsigned)(kc - na_ws) < 16u) ? 0.0f : -1e30f; }
        cwl[64 * k] = w; }
    k_frags(kf, lds + AL_K3, r32, hi);
    qk_mma<0, 4>(pa0, pa1, kf, qr, 0.0f);
    BAR_L();
#define PSTEP(t_, HV, HQ, HS, PC0, PC1, PN0, PN1, PWP, PWC) do { const int t = (t_); \
        if (t + 4 < NT) AT_DMAK(t + 4); \
        if (t >= 1 && t + 2 < NT) AT_DMAV(t + 2); \
        const bool av_ = HV && PACT(t - 1), aq_ = HQ && PACT(t + 1), as_ = HS && PACT(t); \
        if (av_) { const LAS unsigned char* vp_ = lds + AL_V3 + ((t - 1) & 3) * 8192 + ((lane >> 4) & 1) * 32 + (lane & 3) * 8 + (4 * hi + ((lane & 15) >> 2)) * 64; \
            _Pragma("unroll") for (int hf = 0; hf < 2; ++hf) { bf16x8 vh_[2][2]; \
                _Pragma("unroll") for (int kk = 0; kk < 2; ++kk) _Pragma("unroll") for (int d0 = 0; d0 < 2; ++d0) { const int ks = 2 * hf + kk; \
                    const s16x4 lo = vtr(vp_ + d0 * 4096 + ks * 1024), hh = vtr(vp_ + d0 * 4096 + ks * 1024 + 512); vh_[d0][kk] = (bf16x8){lo[0], lo[1], lo[2], lo[3], hh[0], hh[1], hh[2], hh[3]}; } \
                __builtin_amdgcn_sched_barrier(0); \
                _Pragma("unroll") for (int kk = 0; kk < 2; ++kk) { o[0] = mfma32(PWP[2 * hf + kk], vh_[0][kk], o[0]); o[1] = mfma32(PWP[2 * hf + kk], vh_[1][kk], o[1]); } \
                __builtin_amdgcn_sched_barrier(0); } } \
        if (aq_) { const LAS unsigned char* kb_ = lds + AL_K3 + ((t + 1) & 3) * 8192 + hi * 1024 + r32 * 16; \
            if (t + 1 >= U.n1) { _Pragma("unroll") for (int k = 0; k < 4; ++k) { const f32x4 wa = cwl[64 * k], wb = cwl[64 * (k + 4)]; \
                    PN0[4 * k] = wa.x; PN0[4 * k + 1] = wa.y; PN0[4 * k + 2] = wa.z; PN0[4 * k + 3] = wa.w; PN1[4 * k] = wb.x; PN1[4 * k + 1] = wb.y; PN1[4 * k + 2] = wb.z; PN1[4 * k + 3] = wb.w; } } \
            else { PN0 = f16zero(); PN1 = f16zero(); } \
            _Pragma("unroll") for (int hf = 0; hf < 2; ++hf) { bf16x8 kh_[2][2]; \
                _Pragma("unroll") for (int dd = 0; dd < 2; ++dd) { kh_[dd][0] = *(const LAS bf16x8*)(kb_ + (2 * hf + dd) * 2048); kh_[dd][1] = *(const LAS bf16x8*)(kb_ + (2 * hf + dd) * 2048 + 512); } \
                __builtin_amdgcn_sched_barrier(0); \
                _Pragma("unroll") for (int dd = 0; dd < 2; ++dd) { PN0 = mfma32(kh_[dd][0], qr[2 * hf + dd], PN0); PN1 = mfma32(kh_[dd][1], qr[2 * hf + dd], PN1); } \
                __builtin_amdgcn_sched_barrier(0); } } \
        if (as_) { if (t >= U.n1) { const LAS float* trow = (const LAS float*)(lds + AL_TABP) + (U.na_kr0 + (t - U.n1) - U.na_r + 7) * 128 + (63 + 4 * hi - U.na_c); \
                _Pragma("unroll") for (int r = 0; r < 16; ++r) { PC0[r] += trow[(r & 3) + 8 * (r >> 2)]; PC1[r] += trow[(r & 3) + 8 * (r >> 2) + 32]; } } \
            const float s_ = sm_tile_fast(PC0, PC1, l); bad |= !(s_ < 1.0e21f); pack_p(PC0, PC1, PWC); } \
        if (t >= 2 && t + 4 < NT) asm volatile("s_waitcnt vmcnt(4) lgkmcnt(0)" ::: "memory"); else asm volatile("s_waitcnt vmcnt(0) lgkmcnt(0)" ::: "memory"); \
        __builtin_amdgcn_s_barrier(); asm volatile("" ::: "memory"); } while (0)
    PSTEP(0, false, true, true, pa0, pa1, pb0, pb1, pwB, pwA);
    for (int tt = 1; tt < NT - 1; tt += 2) {
        PSTEP(tt, true, true, true, pb0, pb1, pa0, pa1, pwA, pwB);
        PSTEP(tt + 1, true, true, true, pa0, pa1, pb0, pb1, pwB, pwA);
    }
    PSTEP(NT - 1, true, false, true, pb0, pb1, pa0, pa1, pwA, pwB);
    PSTEP(NT, true, false, false, pa0, pa1, pb0, pb1, pwB, pwA);
#undef PSTEP
#undef PACT
    asm volatile("s_waitcnt lgkmcnt(0)" ::: "memory");
    l += __shfl_xor(l, 32);
    bad |= !(l > 1.0e-21f && l < 1.0e24f); if (MK_FORCE_SAFE) bad = true;
    if (wg_any(lds, wid, lane, bad)) return true;
    o_scale(o, 1.0f / l, wsf, r32, hi);
    LAS float* ost = (LAS float*)(lds + AL_OST) + wid * 2048;
    o_stage(o, ost, r32, hi);
    float x[32]; stage_row_read(ost, lane, x);
    const int trow_q = __shfl(U.qrow, lane >> 1);
    store_row32_f8(F.ws + WS_Y + (size_t)trow_q * D + U.ycol + 32 * (lane & 1), x);
    return false;
}

template <int D0LO, int D0HI>
__device__ __forceinline__ void qk_tile_l(f32x16& p0, f32x16& p1, const LAS unsigned char* Kb, const LAS unsigned char* ql, int lane, float cm) {
    const int r32 = lane & 31, hi = lane >> 5;
    const LAS unsigned char* kb = Kb + hi * 1024 + r32 * 16;
    f32x16 cinit;
#pragma unroll
    for (int r = 0; r < 16; ++r) cinit[r] = cm;
    p0 = cinit; p1 = cinit;
#pragma unroll
    for (int d0 = D0LO; d0 < D0HI; ++d0) {
        const bf16x8 q = *(const LAS bf16x8*)(ql + d0 * 1024 + lane * 16);
        const bf16x8 b0 = *(const LAS bf16x8*)(kb + d0 * 2048), b1 = *(const LAS bf16x8*)(kb + d0 * 2048 + 512);
        p0 = mfma32(b0, q, p0); p1 = mfma32(b1, q, p1);
    }
}
template <bool FAST>
__device__ __forceinline__ bool diff_unit_x(Frame& F, const SmUnit& U_, int layer) {
    SmUnit U = U_; VG(U.qcol); VG(U.kcol); VG(U.vcol); VG(U.ycol); VG(U.row1); VG(U.row2);
    const char* Pb = (const char*)(F.ws + WS_P);
    LAS unsigned char* lds = F.lds;
    const int lane_ = lane_now();
    const int lane = lane_, r32 = lane & 31, hi = lane >> 5, wid = F.wave;
    const bool trail = wid >= 4;
    LAS float* ost = (LAS float*)(lds + AL_OST) + wid * 2048;
    LAS unsigned char* ql = (LAS unsigned char*)ost;
    { const char* qp = Pb + (size_t)U.qrow * (PW * 2) + (U.qcol + 8 * hi) * 2;
#pragma unroll
      for (int d0 = 0; d0 < 4; ++d0) *(LAS bf16x8*)(ql + d0 * 1024 + lane * 16) = *(const bf16x8*)(qp + d0 * 32); }
    const int NT = U.n1 + U.n2;
    AT_PROLOGUE();
    SYNC();
    bool bad = false;
    float m0 = 0.f, l0 = 0.f, m1 = 0.f, l1 = 0.f; f32x16 oa[2], ob[2]; oa[0] = f16zero(); oa[1] = f16zero(); ob[0] = f16zero(); ob[1] = f16zero();
    f32x16 pa0, pa1, pb0, pb1;
    qk_tile_l<0, 2>(pa0, pa1, lds + AL_K3, ql, lane, 0.0f);
    qk_tile_l<2, 4>(pb0, pb1, lds + AL_K3, ql, lane, 0.0f);
    LAS float* wsf = (LAS float*)(lds + AL_WSF) + wid * 128;
    if (trail) BAR_L();
    for (int t = 0; t < NT; ++t) {
        bf16x8 pwa[4], pwb[4];
        if (FAST) { const float sa = sm_tile_fast(pa0, pa1, l0); pack_p(pa0, pa1, pwa); const float sb = sm_tile_fast(pb0, pb1, l1); pack_p(pb0, pb1, pwb); bad |= !(sa < 1.0e21f) || !(sb < 1.0e21f); }
        else {
        { float fsc; if (sm_tile2(pa0, pa1, m0, l0, fsc, t == 0)) o_scale(oa, fsc, wsf, r32, hi); pack_p(pa0, pa1, pwa); }
        { float fsc; if (sm_tile2(pb0, pb1, m1, l1, fsc, t == 0)) o_scale(ob, fsc, wsf, r32, hi); pack_p(pb0, pb1, pwb); }
        }
        AT_WAIT_BAR(t);
        if (t + 4 < NT) AT_DMAK(t + 4);
        if (t + 3 < NT) AT_DMAV(t + 3);
        pv_tile(oa, lds + AL_V3 + (t & 3) * 8192, pwa, lane, hi);
        pv_tile(ob, lds + AL_V3 + (t & 3) * 8192, pwb, lane, hi);
        if (t + 1 < NT) { qk_tile_l<0, 2>(pa0, pa1, lds + AL_K3 + ((t + 1) & 3) * 8192, ql, lane, FAST ? 0.0f : -m0); qk_tile_l<2, 4>(pb0, pb1, lds + AL_K3 + ((t + 1) & 3) * 8192, ql, lane, FAST ? 0.0f : -m1); }
        BAR_L();
    }
    if (!trail) BAR_L();
    const float* SC = (const float*)(F.ws + WS_TAB) + TB_SC + 16 * layer;
    const float lam = SC[0], post = SC[1];
    l0 += __shfl_xor(l0, 32); l1 += __shfl_xor(l1, 32);
    if (FAST) { bad |= !(l0 > 1.0e-21f && l0 < 1.0e24f) || !(l1 > 1.0e-21f && l1 < 1.0e24f); if (MK_FORCE_SAFE) bad = true;
                if (wg_any(lds, wid, lane, bad)) return true; }
    o_scale(oa, 1.0f / l0, wsf, r32, hi);
    o_scale(ob, -lam / l1, wsf, r32, hi);
#pragma unroll
    for (int r = 0; r < 16; ++r) { oa[0][r] += ob[0][r]; oa[1][r] += ob[1][r]; }
    o_stage(oa, ost, r32, hi);
    float x[32]; stage_row_read(ost, lane, x);
    float ss = 0.f;
#pragma unroll
    for (int i = 0; i < 32; ++i) ss += x[i] * x[i];
    ss += __shfl_xor(ss, 1);
    const float rn = post / sqrtf(ss * (1.0f / 64.0f) + EPS);
    const float* gain = F.in[I_DSUB] + layer * 64 + 32 * (lane & 1);
#pragma unroll
    for (int i = 0; i < 32; ++i) x[i] = x[i] * rn * gain[i];
    const int trow_q = __shfl(U.qrow, lane >> 1);
    store_row32_f8(F.ws + WS_Y + (size_t)trow_q * D + U.ycol + 32 * (lane & 1), x);
    return false;
}


__device__ __forceinline__ int ret_chunk_row(int b, int ci) { return (ci < 2) ? TLAT + b * 256 + 128 * ci : b * 2048 + 128 * (ci - 2); }
__device__ __forceinline__ int ret_bpos(int ci) { return ci == 0 ? 1 : (ci == 1 ? 0 : 19 - ci); }
__device__ __forceinline__ void ret_unit(Frame& F, int layer, int b, int h, int cp) {
    const char* Pb = (const char*)(F.ws + WS_P);
    LAS unsigned char* lds = F.lds;
    const int lane_ = lane_now();
    const int lane = lane_, r32 = lane & 31, hi = lane >> 5, wid = F.wave;
    const float* SC = (const float*)(F.ws + WS_TAB) + TB_SC + 16 * layer;
    const float lgf = SC[2 + h], lgb = SC[6 + h];
    const int ccw = wid >> 2, ciw = 2 * cp + ccw, tq = 32 * (wid & 3) + r32;
    const int qrow = ret_chunk_row(b, ciw) + tq;
    bf16x8 qr[4];
    { const char* qp = Pb + (size_t)qrow * (PW * 2) + (C_RQ + 64 * h + 8 * hi) * 2;
#pragma unroll
      for (int d0 = 0; d0 < 4; ++d0) qr[d0] = *(const bf16x8*)(qp + d0 * 32); }
    const float* KV = (const float*)(F.ws + WS_RETKV) + (size_t)((b * 4 + h) * NCHUNK) * 2 * 4096;
    const int sd = 16 * (wid & 3) + (lane >> 2), se = 32 * (wid >> 2) + 8 * (lane & 3);
#define RT_LOAD1(kind_, cc_, KR, VR) do { const int _kind = (kind_), _c2 = 2 * cp + (cc_); \
        if (_kind < 2) { const int _r0 = ret_chunk_row(b, _c2) + 64 * _kind; \
            KR = *(const u32x4*)(Pb + (size_t)(_r0 + lane) * (PW * 2) + (C_RK + 64 * h + 8 * wid) * 2); \
            VR = *(const u32x4*)(Pb + (size_t)(_r0 + sd) * (PW * 2) + (C_RV + 64 * h + se) * 2); \
        } else { \
            const int _e = lane - 8 * wid; KR = (u32x4){0u, 0u, 0u, 0u}; \
            if (_e >= 0 && _e < 8) { const unsigned _one = (_e & 1) ? 0x3F800000u : 0x00003F80u; if ((_e >> 1) == 0) KR.x = _one; else if ((_e >> 1) == 1) KR.y = _one; else if ((_e >> 1) == 2) KR.z = _one; else KR.w = _one; } \
            const int _dir = _kind - 2; const f32x4* _p = (const f32x4*)(KV + (size_t)(_c2 * 2 + _dir) * 4096 + sd * 64 + se); const f32x4 _a = _p[0], _b = _p[1]; \
            const float _s[8] = {_a.x, _a.y, _a.z, _a.w, _b.x, _b.y, _b.z, _b.w}; \
            VR.x = cvt_pk_bf16(_s[0], _s[1]); VR.y = cvt_pk_bf16(_s[2], _s[3]); VR.z = cvt_pk_bf16(_s[4], _s[5]); VR.w = cvt_pk_bf16(_s[6], _s[7]); } } while (0)
#define RT_COMMIT2(bf_) do { \
        *(LAS u32x4*)(lds + ((bf_) * 2 + 0) * 8192 + wid * 1024 + lane * 16) = kr0; *(LAS u32x4*)(lds + AL_V3 + ((bf_) * 2 + 0) * 8192 + wid * 1024 + lane * 16) = vr0; \
        *(LAS u32x4*)(lds + ((bf_) * 2 + 1) * 8192 + wid * 1024 + lane * 16) = kr1; *(LAS u32x4*)(lds + AL_V3 + ((bf_) * 2 + 1) * 8192 + wid * 1024 + lane * 16) = vr1; } while (0)
    u32x4 kr0, vr0, kr1, vr1;
    RT_LOAD1(0, 0, kr0, vr0); RT_LOAD1(0, 1, kr1, vr1); RT_COMMIT2(0); SYNC();
    f32x16 o[2]; o[0] = f16zero(); o[1] = f16zero();
    for (int kind = 0; kind < 4; ++kind) {
        const int buf = kind & 1;
        if (kind + 1 < 4) { RT_LOAD1(kind + 1, 0, kr0, vr0); RT_LOAD1(kind + 1, 1, kr1, vr1); }
        {
            f32x16 p0, p1; qk_tile<0, 4>(p0, p1, lds + (buf * 2 + ccw) * 8192, qr, r32, hi, 0.0f);
            if (kind < 2) {
                const int Dq = tq - 64 * kind - 4 * hi;
                const float ef0 = __builtin_amdgcn_exp2f(lgf * (float)Dq), eb0 = __builtin_amdgcn_exp2f(-lgb * (float)Dq);
                const float ef1 = __builtin_amdgcn_exp2f(lgf * (float)(Dq - 32)), eb1 = __builtin_amdgcn_exp2f(-lgb * (float)(Dq - 32));
#pragma unroll
                for (int r = 0; r < 16; ++r) {
                    const int cr = (r & 3) + 8 * (r >> 2), d0 = Dq - cr, d1 = d0 - 32;
                    const float gf = __builtin_amdgcn_exp2f(-lgf * (float)cr), gb = __builtin_amdgcn_exp2f(lgb * (float)cr);
                    const float f0 = d0 > 0 ? ef0 * gf : (d0 < 0 ? eb0 * gb : 2.0f);
                    const float f1 = d1 > 0 ? ef1 * gf : (d1 < 0 ? eb1 * gb : 2.0f);
                    p0[r] *= f0; p1[r] *= f1;
                }
            } else {
                const float f = (kind == 2) ? __builtin_amdgcn_exp2f(lgf * (float)(tq + 1)) : __builtin_amdgcn_exp2f(lgb * (float)(128 - tq));
#pragma unroll
                for (int r = 0; r < 16; ++r) { p0[r] *= f; p1[r] *= f; }
            }
            bf16x8 pw[4]; pack_p(p0, p1, pw);
            pv_tile(o, lds + AL_V3 + (buf * 2 + ccw) * 8192, pw, lane, hi);
        }
        if (kind + 1 < 4) RT_COMMIT2(buf ^ 1);
        SYNC();
    }
#undef RT_LOAD1
#undef RT_COMMIT2
    LAS float* ost = (LAS float*)(lds + AL_OST) + wid * 2048;
    o_stage(o, ost, r32, hi);
    float x[32]; stage_row_read(ost, lane, x);
    float s = 0.f;
#pragma unroll
    for (int i = 0; i < 32; ++i) s += x[i];
    s += __shfl_xor(s, 1);
    const float mu = s * (1.0f / 64.0f); float q = 0.f;
#pragma unroll
    for (int i = 0; i < 32; ++i) { x[i] -= mu; q += x[i] * x[i]; }
    q += __shfl_xor(q, 1);
    const float rs = 1.0f / sqrtf(q * (1.0f / 64.0f) + EPS);
    const int trow_q = __shfl(qrow, lane >> 1);
    const bf16_t* gp = (const bf16_t*)Pb + (size_t)trow_q * PW + C_RG + 64 * h + 32 * (lane & 1);
#pragma unroll
    for (int i = 0; i < 4; ++i) { const u32x4 gw = ((const u32x4*)gp)[i];
        x[8 * i + 0] *= rs * bf_lo(gw.x); x[8 * i + 1] *= rs * bf_hi(gw.x); x[8 * i + 2] *= rs * bf_lo(gw.y); x[8 * i + 3] *= rs * bf_hi(gw.y);
        x[8 * i + 4] *= rs * bf_lo(gw.z); x[8 * i + 5] *= rs * bf_hi(gw.z); x[8 * i + 6] *= rs * bf_lo(gw.w); x[8 * i + 7] *= rs * bf_hi(gw.w); }
    store_row32_f8(F.ws + WS_Y + (size_t)trow_q * D + 256 + 64 * h + 32 * (lane & 1), x);
}

__device__ __forceinline__ void phase_retkv(Frame& F, int layer) {
    const char* Pb = (const char*)(F.ws + WS_P);
    const float* SC = (const float*)(F.ws + WS_TAB) + TB_SC + 16 * layer;
    LAS unsigned char* lds = F.lds;
    const int lane = lane_now(), wid = F.wave, tid = wid * 64 + lane, hi = lane >> 5;
    const int d0 = (wid >> 1) & 1, e0 = wid & 1;
    for (int u = (int)(blockIdx.x & 7u) * (F.G >> 3) + (int)(blockIdx.x >> 3); u < NBATCH * 4 * 2; u += F.G) {
        const int dir = u & 1, bh = u >> 1, h = bh & 3, b = bh >> 2;
        const float lg = SC[2 + 4 * dir + h];
        const float dec = __builtin_amdgcn_exp2f(lg * 128.0f);
        f32x16 S = f16zero();
        u32x4 kk[2], vv[2];
#define RK_CHUNK(p) (dir ? ((p) == 0 ? 1 : ((p) == 1 ? 0 : 19 - (p))) : (p))
#define RK_LOAD(p) do { const int _r0 = ret_chunk_row(b, RK_CHUNK(p)); \
            _Pragma("unroll") for (int it = 0; it < 2; ++it) { const int i = tid + 512 * it, s = i >> 3, c = i & 7; \
                kk[it] = *(const u32x4*)(Pb + (size_t)(_r0 + s) * (PW * 2) + (C_RK + 64 * h + 8 * c) * 2); vv[it] = *(const u32x4*)(Pb + (size_t)(_r0 + s) * (PW * 2) + (C_RV + 64 * h + 8 * c) * 2); } } while (0)
        RK_LOAD(0);
        for (int p = 0; p < NCHUNK; ++p) {
            const int j = RK_CHUNK(p);
            LAS unsigned char* buf = lds + (p & 1) * 32768;
#pragma unroll
            for (int it = 0; it < 2; ++it) {
                const int i = tid + 512 * it, s = i >> 3, c = i & 7;
                const float w = __builtin_amdgcn_exp2f(lg * (float)(dir ? s : 127 - s));
                u32x4 kw;
                kw.x = cvt_pk_bf16(bf_lo(kk[it].x) * w, bf_hi(kk[it].x) * w); kw.y = cvt_pk_bf16(bf_lo(kk[it].y) * w, bf_hi(kk[it].y) * w);
                kw.z = cvt_pk_bf16(bf_lo(kk[it].z) * w, bf_hi(kk[it].z) * w); kw.w = cvt_pk_bf16(bf_lo(kk[it].w) * w, bf_hi(kk[it].w) * w);
                const int off = (c >> 2) * 8192 + s * 64 + (c & 3) * 16;
                *(LAS u32x4*)(buf + off) = kw; *(LAS u32x4*)(buf + 16384 + off) = vv[it];
            }
            if (p + 1 < NCHUNK) RK_LOAD(p + 1);
            asm volatile("s_waitcnt lgkmcnt(0)" ::: "memory"); __builtin_amdgcn_s_barrier(); asm volatile("" ::: "memory");
            if (wid < 4) {
                float* KV = (float*)(F.ws + WS_RETKV) + (size_t)(bh * NCHUNK + j) * 2 * 4096 + dir * 4096 + (32 * d0) * 64 + 32 * e0 + (lane & 31);
#pragma unroll
                for (int r = 0; r < 16; ++r) KV[crow(r, hi) * 64] = S[r];
                const LAS unsigned char* ap = buf + d0 * 8192 + ((lane >> 4) & 1) * 32 + (lane & 3) * 8 + (4 * hi + ((lane & 15) >> 2)) * 64;
                const LAS unsigned char* bp = buf + 16384 + e0 * 8192 + ((lane >> 4) & 1) * 32 + (lane & 3) * 8 + (4 * hi + ((lane & 15) >> 2)) * 64;
#pragma unroll
                for (int r = 0; r < 16; ++r) S[r] *= dec;
#pragma unroll
                for (int ks = 0; ks < 8; ++ks) {
                    const s16x4 alo = vtr(ap + ks * 1024), ahi = vtr(ap + ks * 1024 + 512), blo = vtr(bp + ks * 1024), bhi = vtr(bp + ks * 1024 + 512);
                    const bf16x8 af = (bf16x8){alo[0], alo[1], alo[2], alo[3], ahi[0], ahi[1], ahi[2], ahi[3]};
                    const bf16x8 bf = (bf16x8){blo[0], blo[1], blo[2], blo[3], bhi[0], bhi[1], bhi[2], bhi[3]};
                    S = mfma32(af, bf, S);
                }
            }
        }
        SYNC();
#undef RK_LOAD
#undef RK_CHUNK
    }
}

__device__ __forceinline__ void phase_mixers(Frame& F, int layer) {
    const bool ctx = (layer == 0);
    const int wid = F.wave;
    const int vblk = (int)(blockIdx.x & 7u) * (F.G >> 3) + (int)(blockIdx.x >> 3);
    { unsigned badm = 0u; int it = 0;
    for (int u = vblk; u < 1024 + (ctx ? 128 : 0); u += F.G, ++it) {
        const int r32 = lane_now() & 31;
        SmUnit U{};
        if (u < 1024) { const int qb = u & 7, h = (u >> 3) & 3, b = u >> 5;
            U.qrow = b * 2048 + 256 * qb + 32 * wid + r32; U.qcol = C_DQ + 64 * h; U.kcol = C_DK + 64 * h; U.vcol = C_DV + 64 * h; U.ycol = 768 + 64 * h;
            U.n1 = 32; U.row1 = b * 2048; U.n2 = 4; U.row2 = TLAT + b * 256;
        } else { const int v = u - 1024, h = v & 3, b = v >> 2;
            U.qrow = TLAT + b * 256 + 32 * wid + r32; U.qcol = C_DQ + 64 * h; U.kcol = C_DK + 64 * h; U.vcol = C_DV + 64 * h; U.ycol = 768 + 64 * h;
            U.n1 = 4; U.row1 = TLAT + b * 256; U.n2 = 0; U.row2 = 0; }
        if (diff_unit_x<true>(F, U, layer)) badm |= 1u << it;
    }
    it = 0;
    for (int u = vblk; u < 1024 + (ctx ? 128 : 0); u += F.G, ++it) { if (!((badm >> it) & 1u)) continue;
        const int r32 = lane_now() & 31;
        SmUnit U{};
        if (u < 1024) { const int qb = u & 7, h = (u >> 3) & 3, b = u >> 5;
            U.qrow = b * 2048 + 256 * qb + 32 * wid + r32; U.qcol = C_DQ + 64 * h; U.kcol = C_DK + 64 * h; U.vcol = C_DV + 64 * h; U.ycol = 768 + 64 * h;
            U.n1 = 32; U.row1 = b * 2048; U.n2 = 4; U.row2 = TLAT + b * 256;
        } else { const int v = u - 1024, h = v & 3, b = v >> 2;
            U.qrow = TLAT + b * 256 + 32 * wid + r32; U.qcol = C_DQ + 64 * h; U.kcol = C_DK + 64 * h; U.vcol = C_DV + 64 * h; U.ycol = 768 + 64 * h;
            U.n1 = 4; U.row1 = TLAT + b * 256; U.n2 = 0; U.row2 = 0; }
        (void)diff_unit_x<false>(F, U, layer);
    } }
#if MK_DIAG
    if (blockIdx.x == 0 && threadIdx.x == 0) ((unsigned long long*)(F.ws + WS_CTL + 524288))[32 + 4 * layer + 0] = __builtin_amdgcn_s_memrealtime();
#endif
    { unsigned badm = 0u; int it = 0;
    for (int u = vblk; u < 1024 + (ctx ? 256 : 0); u += F.G, ++it) {
        const int r32 = lane_now() & 31;
        SmUnit U{};
        if (u < 1024) { const int qb = u & 15, kvh = (u >> 4) & 1, b = u >> 5, head = 2 * kvh + (wid >> 2);
            U.qrow = b * 2048 + 128 * qb + 32 * (wid & 3) + r32; U.qcol = C_GQ + 64 * head; U.kcol = C_GK + 64 * kvh; U.vcol = C_GV + 64 * kvh; U.ycol = 512 + 64 * head;
            U.n1 = 32; U.row1 = b * 2048; U.n2 = 4; U.row2 = TLAT + b * 256;
        } else if (u < 1152) { const int v = u - 1024, qb = v & 1, kvh = (v >> 1) & 1, b = v >> 2, head = 2 * kvh + (wid >> 2);
            U.qrow = TLAT + b * 256 + 128 * qb + 32 * (wid & 3) + r32; U.qcol = C_GQ + 64 * head; U.kcol = C_GK + 64 * kvh; U.vcol = C_GV + 64 * kvh; U.ycol = 512 + 64 * head;
            U.n1 = 4; U.row1 = TLAT + b * 256; U.n2 = 0; U.row2 = 0;
        } else { const int v = u - 1152, h = v & 3, b = v >> 2;
            U.qrow = TLAT + b * 256 + 32 * wid + r32; U.qcol = C_NAQ + 64 * h; U.kcol = C_NAK + 64 * h; U.vcol = C_NAV + 64 * h; U.ycol = 64 * h;
            U.n1 = 4; U.row1 = TLAT + b * 256; U.n2 = 0; U.row2 = 0; }
        if (sm_unit_pipe(F, U)) badm |= 1u << it;
    }
    it = 0;
    for (int u = vblk; u < 1024 + (ctx ? 256 : 0); u += F.G, ++it) { if (!((badm >> it) & 1u)) continue;
        const int r32 = lane_now() & 31;
        SmUnit U{};
        if (u < 1024) { const int qb = u & 15, kvh = (u >> 4) & 1, b = u >> 5, head = 2 * kvh + (wid >> 2);
            U.qrow = b * 2048 + 128 * qb + 32 * (wid & 3) + r32; U.qcol = C_GQ + 64 * head; U.kcol = C_GK + 64 * kvh; U.vcol = C_GV + 64 * kvh; U.ycol = 512 + 64 * head;
            U.n1 = 32; U.row1 = b * 2048; U.n2 = 4; U.row2 = TLAT + b * 256;
        } else if (u < 1152) { const int v = u - 1024, qb = v & 1, kvh = (v >> 1) & 1, b = v >> 2, head = 2 * kvh + (wid >> 2);
            U.qrow = TLAT + b * 256 + 128 * qb + 32 * (wid & 3) + r32; U.qcol = C_GQ + 64 * head; U.kcol = C_GK + 64 * kvh; U.vcol = C_GV + 64 * kvh; U.ycol = 512 + 64 * head;
            U.n1 = 4; U.row1 = TLAT + b * 256; U.n2 = 0; U.row2 = 0;
        } else { const int v = u - 1152, h = v & 3, b = v >> 2;
            U.qrow = TLAT + b * 256 + 32 * wid + r32; U.qcol = C_NAQ + 64 * h; U.kcol = C_NAK + 64 * h; U.vcol = C_NAV + 64 * h; U.ycol = 64 * h;
            U.n1 = 4; U.row1 = TLAT + b * 256; U.n2 = 0; U.row2 = 0; }
        (void)sm_unit_x<false, false>(F, U);
    } }
#if MK_DIAG
    if (blockIdx.x == 0 && threadIdx.x == 0) ((unsigned long long*)(F.ws + WS_CTL + 524288))[32 + 4 * layer + 1] = __builtin_amdgcn_s_memrealtime();
#endif
    { unsigned badm = 0u; int it = 0;
    for (int u = vblk; u < 1024; u += F.G, ++it) {
        const int r32 = lane_now() & 31;
        const int g = u & 7, h = (u >> 3) & 3, b = u >> 5;
        { LAS float* tabp = (LAS float*)(F.lds + AL_TABP); const float* rpb = F.in[I_RPB] + (size_t)(layer * 4 + h) * 465;
          for (int i = wid * 64 + lane_now(); i < 15 * 128; i += 512) { const int dr = i >> 7, d = (i & 127) - 63; tabp[i] = ((unsigned)(d + 15) < 31u) ? rpb[dr * 31 + d + 15] * LOG2E : 0.0f; } }
        SmUnit U{}; U.na_r = 4 * g + (wid >> 1); U.na_c = 32 * (wid & 1) + r32;
        U.qrow = b * 2048 + 64 * U.na_r + U.na_c; U.qcol = C_NAQ + 64 * h; U.kcol = C_NAK + 64 * h; U.vcol = C_NAV + 64 * h; U.ycol = 64 * h;
        U.n1 = 4; U.row1 = TLAT + b * 256;
        const int kr0 = min(max(4 * g - 4, 0), 24), krl = min(max(4 * g + 3 - 4, 0), 24) + 7;
        U.na_kr0 = kr0; U.n2 = krl - kr0 + 1; U.n2 += (U.n1 + U.n2) & 1; U.row2 = b * 2048 + 64 * kr0;
        if (na_unit_pipe(F, U)) badm |= 1u << it;
    }
    it = 0;
    for (int u = vblk; u < 1024; u += F.G, ++it) { if (!((badm >> it) & 1u)) continue;
        const int r32 = lane_now() & 31;
        const int g = u & 7, h = (u >> 3) & 3, b = u >> 5;
        { LAS float* tabp = (LAS float*)(F.lds + AL_TABP); const float* rpb = F.in[I_RPB] + (size_t)(layer * 4 + h) * 465;
          for (int i = wid * 64 + lane_now(); i < 15 * 128; i += 512) { const int dr = i >> 7, d = (i & 127) - 63; tabp[i] = ((unsigned)(d + 15) < 31u) ? rpb[dr * 31 + d + 15] * LOG2E : 0.0f; } }
        SmUnit U{}; U.na_r = 4 * g + (wid >> 1); U.na_c = 32 * (wid & 1) + r32;
        U.qrow = b * 2048 + 64 * U.na_r + U.na_c; U.qcol = C_NAQ + 64 * h; U.kcol = C_NAK + 64 * h; U.vcol = C_NAV + 64 * h; U.ycol = 64 * h;
        U.n1 = 4; U.row1 = TLAT + b * 256;
        const int kr0 = min(max(4 * g - 4, 0), 24), krl = min(max(4 * g + 3 - 4, 0), 24) + 7;
        U.na_kr0 = kr0; U.n2 = krl - kr0 + 1; U.n2 += (U.n1 + U.n2) & 1; U.row2 = b * 2048 + 64 * kr0;
        (void)sm_unit_x<true, false>(F, U);
    } }
#if MK_DIAG
    if (blockIdx.x == 0 && threadIdx.x == 0) ((unsigned long long*)(F.ws + WS_CTL + 524288))[32 + 4 * layer + 2] = __builtin_amdgcn_s_memrealtime();
#endif
    { const int npair = ctx ? 9 : 8;
      for (int rep = 0; rep < (MK_REP_MIX == 3 ? 2 : 1); ++rep)
      for (int u = vblk; u < NBATCH * 4 * npair; u += F.G) { const int cp = (u % npair) + (ctx ? 0 : 1), bh = u / npair; ret_unit(F, layer, bh >> 2, bh & 3, cp); } }
}


struct MergeState { int i, s, kt, pm, jt; bool valid; };
__device__ __forceinline__ void phase_merge(Frame& F, int layer) {
    const GeoT g = make_geo(F.tid);
    LAS unsigned char* lds = F.lds;
    const char* XH8 = (const char*)F.out + OUT_XH8;
    const char* Yb = (const char*)(F.ws + WS_Y);
    const char* Wg8 = (const char*)(F.ws + WS_WIN8) + ((size_t)layer * INW + PW) * 1024;
    const char* Wb = (const char*)(F.ws + WS_WBR) + (size_t)layer * 4 * 1024 * 256;
    bf16_t* ACC = (bf16_t*)(F.ws + WS_P);
    const int nM = (layer == 0) ? T / 256 : TLAT / 256;
    const int G = F.G, c = blockIdx.x;
    const bool trail = g.wr == 1;
    const unsigned ldsw = (unsigned)g.wid * 1024u;
    unsigned voffA[2], voffBb[2], voff8[2];
#pragma unroll
    for (int i = 0; i < 2; ++i) { voffA[i] = (unsigned)g.R[i] * 2048u + (unsigned)g.C[i] * 2u; voffBb[i] = (unsigned)g.R[i] * 256u + (unsigned)g.C[i] * 2u; voff8[i] = (unsigned)g.R[i] * 1024u + (unsigned)g.C[i] * 2u; }
    MergeState is; is.i = 0; is.s = 0; is.kt = 0; is.valid = unit_order(c, nM, 8, is.pm, is.jt);
    if (!is.valid) return;
    MergeState cs = is;
    const char* la_ptr = nullptr; const char* lb_ptr = nullptr; bool l_isg = false; unsigned vb0 = 0u, vb1 = 0u;
#define MG_ADV(st) do { (st).kt++; if ((st).kt == (((st).s & 1) ? 8 : 2)) { (st).kt = 0; (st).s++; if ((st).s == 8) { (st).s = 0; (st).i++; (st).valid = unit_order((st).i * G + c, nM, 8, (st).pm, (st).jt); } } } while (0)
#define MG_ISSUE(slot) do { if (is.valid) { if (is.kt == 0) { const int _n = is.s >> 1; l_isg = (is.s & 1) != 0;                  \
            la_ptr = l_isg ? XH8 + (size_t)is.pm * (256 * 1024) : Yb + _n * 256 + (size_t)is.pm * (256 * 1024); \
            lb_ptr = l_isg ? Wg8 + (size_t)(_n * 1024 + is.jt * 128) * 1024 : Wb + (size_t)(_n * 1024 + is.jt * 128) * 256; \
            vb0 = l_isg ? voff8[0] : voffBb[0]; vb1 = l_isg ? voff8[1] : voffBb[1]; } else { la_ptr += 128; lb_ptr += 128; } } \
        LAS unsigned char* _d = lds + (slot) * 49152 + ldsw; const size_t _hs = (size_t)(128 * 1024); \
        _Pragma("unroll") for (int _h = 0; _h < 2; ++_h) _Pragma("unroll") for (int _i = 0; _i < 2; ++_i) \
            __builtin_amdgcn_global_load_lds((const unsigned*)(la_ptr + (size_t)_h * _hs + voff8[_i]), (LAS unsigned*)(_d + _h * 16384 + _i * 8192), 16, 0, 0); \
        _Pragma("unroll") for (int _i = 0; _i < 2; ++_i) \
            __builtin_amdgcn_global_load_lds((const unsigned*)(lb_ptr + (_i ? vb1 : vb0)), (LAS unsigned*)(_d + 32768 + _i * 8192), 16, 0, 0); \
        if (is.valid) MG_ADV(is); } while (0)
    MG_ISSUE(0); MG_ISSUE(1);
    WAIT_V(6); BAR();
    if (trail) BAR();
    f32x4 acc[2][1][4][2]; acc_zero<1>(acc);
    unsigned yb[2][4][2][2], outp[2][4][2][2];
#pragma unroll
    for (int a2 = 0; a2 < 2; ++a2)
#pragma unroll
        for (int m = 0; m < 4; ++m)
#pragma unroll
            for (int nn = 0; nn < 2; ++nn) { outp[a2][m][nn][0] = 0u; outp[a2][m][nn][1] = 0u; }
    int sc = 0, si = 2;
    typedef long l64x2 __attribute__((ext_vector_type(2)));
#define MG_STEP(ISG) do { \
        const LAS unsigned char* tb = lds + sc * 49152; \
        l64x2 Bf[2][2], A0[4][2], A1[4][2]; \
        _Pragma("unroll") for (int n = 0; n < 2; ++n) _Pragma("unroll") for (int k = 0; k < 2; ++k) Bf[n][k] = *(const LAS l64x2*)(tb + 32768 + g.boffl + n * 2048 + k * 1024); \
        _Pragma("unroll") for (int m = 0; m < 4; ++m) _Pragma("unroll") for (int k = 0; k < 2; ++k) { A0[m][k] = *(const LAS l64x2*)(tb + g.aoffl + m * 2048 + k * 1024); A1[m][k] = *(const LAS l64x2*)(tb + 16384 + g.aoffl + m * 2048 + k * 1024); } \
        MG_ISSUE(si); \
        WAIT_V(6); WAIT_L(0); BAR(); \
        __builtin_amdgcn_s_setprio(1); \
        _Pragma("unroll") for (int m = 0; m < 4; ++m) _Pragma("unroll") for (int n = 0; n < 2; ++n) { \
            if (ISG) { \
                acc[0][0][m][n] = mfma_f8k128(cat16(Bf[n][0], Bf[n][1]), cat16(A0[m][0], A0[m][1]), acc[0][0][m][n]); asm volatile("" : "+v"(acc[0][0][m][n])); \
                acc[1][0][m][n] = mfma_f8k128(cat16(Bf[n][0], Bf[n][1]), cat16(A1[m][0], A1[m][1]), acc[1][0][m][n]); asm volatile("" : "+v"(acc[1][0][m][n])); \
            } else { _Pragma("unroll") for (int k = 0; k < 2; ++k) { \
                acc[0][0][m][n] = __builtin_amdgcn_mfma_f32_16x16x32_bf16(__builtin_bit_cast(bf16x8, Bf[n][k]), __builtin_bit_cast(bf16x8, A0[m][k]), acc[0][0][m][n], 0, 0, 0); \
                acc[1][0][m][n] = __builtin_amdgcn_mfma_f32_16x16x32_bf16(__builtin_bit_cast(bf16x8, Bf[n][k]), __builtin_bit_cast(bf16x8, A1[m][k]), acc[1][0][m][n], 0, 0, 0); } } } \
        __builtin_amdgcn_s_setprio(0); \
        BAR(); \
        sc = (sc == 2) ? 0 : sc + 1; si = (si == 2) ? 0 : si + 1; } while (0)
    for (;;) {
#pragma unroll 1
        for (int k2 = 0; k2 < 2; ++k2) MG_STEP(true);
#pragma unroll
        for (int a2 = 0; a2 < 2; ++a2)
#pragma unroll
            for (int m = 0; m < 4; ++m)
#pragma unroll
                for (int nn = 0; nn < 2; ++nn) { yb[a2][m][nn][0] = cvt_pk_bf16(acc[a2][0][m][nn][0] * (1.0f / 512.0f), acc[a2][0][m][nn][1] * (1.0f / 512.0f)); yb[a2][m][nn][1] = cvt_pk_bf16(acc[a2][0][m][nn][2] * (1.0f / 512.0f), acc[a2][0][m][nn][3] * (1.0f / 512.0f)); }
        acc_zero<1>(acc);
#pragma unroll 1
        for (int k8 = 0; k8 < 8; ++k8) MG_STEP(true);
#pragma unroll
        for (int a2 = 0; a2 < 2; ++a2)
#pragma unroll
            for (int m = 0; m < 4; ++m)
#pragma unroll
                for (int nn = 0; nn < 2; ++nn) {
                    const float o0 = bf_lo(outp[a2][m][nn][0]) + sig64(acc[a2][0][m][nn][0]) * bf_lo(yb[a2][m][nn][0]);
                    const float o1 = bf_hi(outp[a2][m][nn][0]) + sig64(acc[a2][0][m][nn][1]) * bf_hi(yb[a2][m][nn][0]);
                    const float o2 = bf_lo(outp[a2][m][nn][1]) + sig64(acc[a2][0][m][nn][2]) * bf_lo(yb[a2][m][nn][1]);
                    const float o3 = bf_hi(outp[a2][m][nn][1]) + sig64(acc[a2][0][m][nn][3]) * bf_hi(yb[a2][m][nn][1]);
                    outp[a2][m][nn][0] = cvt_pk_bf16(o0, o1); outp[a2][m][nn][1] = cvt_pk_bf16(o2, o3);
                }
        acc_zero<1>(acc);
        cs.s += 2;
        if (cs.s == 8) {
            int fr = g.fr, fq = g.fq; asm volatile("" : "+v"(fr), "+v"(fq));
#pragma unroll
            for (int a2 = 0; a2 < 2; ++a2)
#pragma unroll
                for (int m = 0; m < 4; ++m) {
                    const int row = cs.pm * 256 + a2 * 128 + g.wr * 64 + m * 16 + fr;
                    unsigned char* op = (unsigned char*)ACC + (size_t)row * D + 128 * cs.jt + 32 * g.wc + 8 * fq;
                    u32x2 w;
#pragma unroll
                    for (int nn = 0; nn < 2; ++nn) { const unsigned q = cvt_pk4_fp8(16.f * bf_lo(outp[a2][m][nn][0]), 16.f * bf_hi(outp[a2][m][nn][0]), 16.f * bf_lo(outp[a2][m][nn][1]), 16.f * bf_hi(outp[a2][m][nn][1]));
                        if (nn == 0) w.x = q; else w.y = q; outp[a2][m][nn][0] = 0u; outp[a2][m][nn][1] = 0u; }
                    *(u32x2*)op = w;
                }
            cs.s = 0; cs.i++; cs.valid = unit_order(cs.i * G + c, nM, 8, cs.pm, cs.jt);
            if (!cs.valid) break;
        }
    }
    WAIT_V(0);
    if (!trail) BAR();
    BAR();
#undef MG_STEP
#undef MG_ADV
#undef MG_ISSUE
}

__device__ __forceinline__ bf16_t* x1row_ptr(Frame& F, int row) { return (bf16_t*)(F.ws + WS_Y) + (size_t)row * D; }
__device__ __forceinline__ bf16_t* x2row_ptr(Frame& F, int row) { return (row < TLAT) ? (bf16_t*)F.out + (size_t)row * D : (bf16_t*)(F.ws + WS_X1CTX) + (size_t)(row - TLAT) * D; }
__device__ __forceinline__ void row_load_bf16(const bf16_t* xrow, int lane, f32x4 (&v)[4]) {
    const u32x2* xr = (const u32x2*)xrow + lane;
#pragma unroll
    for (int j = 0; j < 4; ++j) { const u32x2 w = xr[64 * j]; v[j] = (f32x4){bf_lo(w.x), bf_hi(w.x), bf_lo(w.y), bf_hi(w.y)}; }
}
struct SchedOut {
    struct Unit { const char* a; const char* b; int pm, pn; };
    const char* A; const char* B; int G, c, nM;
    __device__ __forceinline__ bool next(int i, Unit& u) const {
        int pm, pn; if (!unit_order(i * G + c, nM, 4, pm, pn)) return false;
        u.pm = pm; u.pn = pn; u.a = A + (size_t)pm * 256 * 1024; u.b = B + (size_t)pn * 256 * 1024; return true; }
    __device__ __forceinline__ void gather(const Unit&, unsigned (&)[2][2]) const {}
    __device__ __forceinline__ void boff(const Unit&, const unsigned (&d)[2], unsigned (&v)[2]) const { v[0] = d[0]; v[1] = d[1]; }
};
struct EpiOut { Frame F; int layer;
    __device__ __forceinline__ void operator()(const f32x4 (&acc)[2][2][4][2], const SchedOut::Unit& u, const GeoT& g_) const {
        GeoT g = g_; asm volatile("" : "+v"(g.fr), "+v"(g.fq));
        Frame f = F; const int pm = u.pm, pn = u.pn;
        const int row0 = pm * 256 + g.wr * 64 + g.fr;
        const float* gt = mod_ptr(f, layer, pm * 256) + 2048;
        f32x4 gv[2][2];
#pragma unroll
        for (int bj = 0; bj < 2; ++bj)
#pragma unroll
            for (int n = 0; n < 2; ++n) gv[bj][n] = *(const f32x4*)(gt + pn * 256 + bj * 128 + g.wc * 32 + n * 16 + 4 * g.fq);
#pragma unroll
        for (int ai = 0; ai < 2; ++ai) {
            f32x4 xv[4][2][2];
#pragma unroll
            for (int m = 0; m < 4; ++m) {
                const int row = row0 + ai * 128 + m * 16;
                const float* xin = (row < TLAT) ? f.in[I_X] + (size_t)row * D : f.in[I_CTX] + (size_t)(row - TLAT) * D;
                const bf16_t* xin2 = x2row_ptr(f, row);
#pragma unroll
                for (int bj = 0; bj < 2; ++bj)
#pragma unroll
                    for (int n = 0; n < 2; ++n) {
                        const int col = pn * 256 + bj * 128 + g.wc * 32 + n * 16 + 4 * g.fq;
                        if (layer == 0) xv[m][bj][n] = *(const f32x4*)(xin + col);
                        else { const u32x2 w = *(const u32x2*)(xin2 + col); xv[m][bj][n] = (f32x4){bf_lo(w.x), bf_hi(w.x), bf_lo(w.y), bf_hi(w.y)}; }
                    }
            }
#pragma unroll
            for (int m = 0; m < 4; ++m) {
                const int row = row0 + ai * 128 + m * 16;
                bf16_t* xo = x1row_ptr(f, row);
#pragma unroll
                for (int bj = 0; bj < 2; ++bj)
#pragma unroll
                    for (int n = 0; n < 2; ++n) {
                        const int col = pn * 256 + bj * 128 + g.wc * 32 + n * 16 + 4 * g.fq;
                        const f32x4 r = xv[m][bj][n] + gv[bj][n] * (acc[ai][bj][m][n] * (1.0f / 1024.0f));
                        u32x2 o; o.x = cvt_pk_bf16(r.x, r.y); o.y = cvt_pk_bf16(r.z, r.w);
                        *(u32x2*)(xo + col) = o;
                    }
            }
        }
    } };
__device__ __forceinline__ void phase_outproj(Frame& F, int layer) {
    const GeoT g = make_geo(F.tid);
    SchedOut S; S.A = (const char*)(F.ws + WS_P); S.B = (const char*)(F.ws + WS_WOUT) + (size_t)layer * 1024 * 1024; S.G = F.G; S.c = blockIdx.x; S.nM = (layer == 0) ? T / 256 : TLAT / 256;
    EpiOut E; E.F = F; E.layer = layer;
    unsigned voff[2];
#pragma unroll
    for (int i = 0; i < 2; ++i) voff[i] = (unsigned)g.R[i] * 1024u + (unsigned)g.C[i] * 2u;
    gemm_stream<false, true>(F.lds, S, E, 8, voff, 128u * 1024u, voff, 128u * 1024u, g);
}

__device__ __forceinline__ void phase_norm2route(Frame& F, int layer) {
    LAS float* wrl = (LAS float*)F.lds;
    LAS unsigned* rowE = (LAS unsigned*)(F.lds + 81920);
    LAS float* rowW = (LAS float*)(F.lds + 81920 + 1024);
    for (int i = F.tid; i < 4096; i += 512) { const int k = i >> 2, q = i & 3; const int R = ((k >> 8) * 4 + (k & 3)) * 64 + ((k & 255) >> 2);
        *(LAS f32x4*)(wrl + R * 20 + 4 * q) = ((const f32x4*)F.in[I_WR])[i]; }
    SYNC();
    const int nrows = (layer == 0) ? T : TLAT;
    bf16_t* XM = (bf16_t*)(F.ws + WS_XH);
    unsigned* ecnt = (unsigned*)(F.ws + WS_CTL) + CW_ECNT + 64 * layer;
    unsigned* toklist = (unsigned*)(F.ws + WS_TOKLIST);
    unsigned* tokslot = (unsigned*)(F.ws + WS_TOKSLOT);
    float* tokw = (float*)(F.ws + WS_TOKW);
    const float* rb = F.in[I_RB];
    for (int ch = blockIdx.x; ch < nrows / 256; ch += F.G) {
        f32x4 vn[4]; row_load_bf16(x1row_ptr(F, ch * 256 + F.wave * 32), F.lane, vn);
        for (int rr = 0; rr < 32; ++rr) {
            const int rl = F.wave * 32 + rr, row = ch * 256 + rl;
            f32x4 v[4];
#pragma unroll
            for (int j = 0; j < 4; ++j) v[j] = vn[j];
            if (rr + 1 < 32) row_load_bf16(x1row_ptr(F, row + 1), F.lane, vn);
            const float rstd = row_rstd(v);
            const float* mp = mod_ptr(F, layer, row);
            row_modulate(v, rstd, F.in[I_G2] + layer * D, mp + 3072, mp + 4096, F.lane);
            row_store_fp8((unsigned char*)F.out + OUT_XH8 + (size_t)row * D, F.lane, v);
            f32x2 lg2[8];
#pragma unroll
            for (int e = 0; e < 8; ++e) lg2[e] = (f32x2){0.f, 0.f};
#pragma unroll
            for (int j = 0; j < 4; ++j)
#pragma unroll
                for (int c = 0; c < 4; ++c) {
                    const float xv = v[j][c];
                    const LAS f32x4* wp = (const LAS f32x4*)(wrl + ((4 * j + c) * 64 + F.lane) * 20);
                    const f32x2 xv2 = (f32x2){xv, xv};
#pragma unroll
                    for (int q = 0; q < 4; ++q) { const f32x4 w4 = wp[q]; lg2[2 * q] = __builtin_elementwise_fma(xv2, (f32x2){w4.x, w4.y}, lg2[2 * q]); lg2[2 * q + 1] = __builtin_elementwise_fma(xv2, (f32x2){w4.z, w4.w}, lg2[2 * q + 1]); }
                }
            float lg[16];
#pragma unroll
            for (int e = 0; e < 8; ++e) { lg[2 * e] = lg2[e].x; lg[2 * e + 1] = lg2[e].y; }
            float r8[8];
#pragma unroll
            for (int i = 0; i < 8; ++i) r8[i] = swapsum32(lg[i], lg[8 + i]);
            float r4[4];
#pragma unroll
            for (int i = 0; i < 4; ++i) r4[i] = swapsum16(r8[i], r8[4 + i]);
            float r2[2];
#pragma unroll
            for (int i = 0; i < 2; ++i) { const float y0 = r4[i] + dppf<DPP_ROR8>(r4[i]), y1 = r4[2 + i] + dppf<DPP_ROR8>(r4[2 + i]); r2[i] = (F.lane & 8) ? y1 : y0; }
            float r1; { const bool up = (F.lane & 4) != 0; const float keep = up ? r2[1] : r2[0], send = up ? r2[0] : r2[1]; r1 = keep + __shfl_xor(send, 4); }
            r1 += dppf<DPP_XOR2>(r1); r1 += dppf<DPP_XOR1>(r1);
            float s[16], sel[16];
#pragma unroll
            for (int e = 0; e < 16; ++e) { const float lgv = __int_as_float(__builtin_amdgcn_readlane(__float_as_int(r1), 32 * (e >> 3) + 16 * ((e >> 2) & 1) + 8 * ((e >> 1) & 1) + 4 * (e & 1))); s[e] = sigmoidf_(lgv); sel[e] = s[e] + rb[e]; }
            float gs[4];
#pragma unroll
            for (int gi = 0; gi < 4; ++gi) { const float x0 = sel[4 * gi], x1 = sel[4 * gi + 1], x2 = sel[4 * gi + 2], x3 = sel[4 * gi + 3];
                const float m01 = fmaxf(x0, x1), n01 = fminf(x0, x1), m23 = fmaxf(x2, x3), n23 = fminf(x2, x3);
                gs[gi] = fmaxf(m01, m23) + fmaxf(fminf(m01, m23), fmaxf(n01, n23)); }
            int gbest = 0; float gs_best = gs[0];
#pragma unroll
            for (int gi = 1; gi < 4; ++gi) { const bool gt = gs[gi] > gs_best; gs_best = gt ? gs[gi] : gs_best; gbest = gt ? gi : gbest; }
            float xg[4], sg[4];
#pragma unroll
            for (int i = 0; i < 4; ++i) { xg[i] = sel[i]; sg[i] = s[i];
#pragma unroll
                for (int gi = 1; gi < 4; ++gi) { xg[i] = (gbest == gi) ? sel[4 * gi + i] : xg[i]; sg[i] = (gbest == gi) ? s[4 * gi + i] : sg[i]; } }
            int i0 = 0, i1 = 0; float a = -1e30f, b2 = -1e30f, w0 = 0.f, w1 = 0.f;
#pragma unroll
            for (int i = 0; i < 4; ++i) { const float x = xg[i]; const bool ga = x > a, gb = x > b2;
                b2 = ga ? a : (gb ? x : b2); i1 = ga ? i0 : (gb ? i : i1); w1 = ga ? w0 : (gb ? sg[i] : w1);
                a = ga ? x : a; i0 = ga ? i : i0; w0 = ga ? sg[i] : w0; }
            const int e0 = 4 * gbest + i0, e1 = 4 * gbest + i1;
            const float inv = __builtin_amdgcn_rcpf(w0 + w1);
            if (F.lane == 0) { rowE[rl] = (unsigned)e0 | ((unsigned)e1 << 8); rowW[2 * rl] = w0 * inv; rowW[2 * rl + 1] = w1 * inv; }
        }
        SYNC();
        LAS unsigned* lcnt = (LAS unsigned*)(F.lds + 81920 + 4096);
        if (F.tid < 16) lcnt[F.tid] = 0u;
        SYNC();
        unsigned my_e0 = 0, my_e1 = 0, my_r0 = 0, my_r1 = 0;
        if (F.tid < 256) { const unsigned pe = rowE[F.tid]; my_e0 = pe & 255u; my_e1 = pe >> 8; my_r0 = atomicAdd((unsigned*)(lcnt + my_e0), 1u); my_r1 = atomicAdd((unsigned*)(lcnt + my_e1), 1u); }
        SYNC();
        if (F.tid < 16) { const unsigned cnt = lcnt[F.tid]; lcnt[16 + F.tid] = cnt ? atomicAdd(ecnt + F.tid, cnt) : 0u; }
        SYNC();
        if (F.tid < 256) {
            const int row = ch * 256 + F.tid; const unsigned p0 = lcnt[16 + my_e0] + my_r0, p1 = lcnt[16 + my_e1] + my_r1;
            toklist[my_e0 * T + p0] = row; toklist[my_e1 * T + p1] = row;
            *(u32x2*)(tokslot + 2 * row) = (u32x2){(my_e0 << 24) | p0, (my_e1 << 24) | p1};
            *(f32x2*)(tokw + 2 * row) = (f32x2){rowW[2 * F.tid], rowW[2 * F.tid + 1]};
        }
        SYNC();
    }
}

__device__ __forceinline__ int moe_segments(Frame& F, int layer) {
    const unsigned* ecnt = (const unsigned*)(F.ws + WS_CTL) + CW_ECNT + 64 * layer;
    LAS int* seg = (LAS int*)(F.lds + LDS_MISC + 256);
    LAS unsigned char* blk2e = (LAS unsigned char*)(F.lds + LDS_MISC + 512);
    if (F.tid == 0) { int acc = 0;
        for (int e = 0; e < 16; ++e) { seg[e] = acc; acc += (int)((__hip_atomic_load(ecnt + e, __ATOMIC_RELAXED, __HIP_MEMORY_SCOPE_AGENT) + 255u) >> 8); }
        seg[16] = acc; }
    SYNC();
    const int nblk = seg[16];
    for (int blk = F.tid; blk < nblk; blk += 512) { int e = 0; for (int i = 1; i < 16; ++i) e += (blk >= seg[i]) ? 1 : 0; blk2e[blk] = (unsigned char)e; }
    SYNC();
    return nblk;
}
struct SchedMoe {
    struct Unit { const char* a; const char* b; int blk, pn, e, rb, cnt; };
    const char* A; const char* B; int G, c, nblk; unsigned a_blk_bytes, b_exp_bytes, b_pn_bytes;
    const LAS int* seg; const LAS unsigned char* blk2e; const unsigned* ecnt; const unsigned* toklist; int R0, R1, C0, C1;
    __device__ __forceinline__ bool next(int i, Unit& u) const {
        int blk, pn; if (!unit_order(i * G + c, nblk, 4, blk, pn)) return false;
        const int e = __builtin_amdgcn_readfirstlane((int)blk2e[blk]);
        u.blk = blk; u.pn = pn; u.e = e; u.rb = blk - __builtin_amdgcn_readfirstlane(seg[e]);
        u.cnt = (int)__hip_atomic_load(ecnt + e, __ATOMIC_RELAXED, __HIP_MEMORY_SCOPE_AGENT);
        u.a = A + (size_t)blk * a_blk_bytes; u.b = B + (size_t)e * b_exp_bytes + (size_t)pn * b_pn_bytes; return true; }
    __device__ __forceinline__ void gather(const Unit& u, unsigned (&v)[2][2]) const {
#pragma unroll
        for (int h = 0; h < 2; ++h) {
            const int s0 = u.rb * 256 + 128 * h + R0, s1 = u.rb * 256 + 128 * h + R1;
            const unsigned t0 = (s0 < u.cnt) ? toklist[u.e * T + s0] : 0u, t1 = (s1 < u.cnt) ? toklist[u.e * T + s1] : 0u;
            v[h][0] = t0 * 1024u + (unsigned)C0 * 2u; v[h][1] = t1 * 1024u + (unsigned)C1 * 2u; } }
    __device__ __forceinline__ void boff(const Unit&, const unsigned (&d)[2], unsigned (&v)[2]) const { v[0] = d[0]; v[1] = d[1]; }
};
struct EpiMoeUp { unsigned char* U;
    __device__ __forceinline__ void operator()(const f32x4 (&acc)[2][2][4][2], const SchedMoe::Unit& u, const GeoT& g_) const {
        GeoT g = g_; asm volatile("" : "+v"(g.fr), "+v"(g.fq));
#pragma unroll
        for (int ai = 0; ai < 2; ++ai)
#pragma unroll
            for (int m = 0; m < 4; ++m) {
                const size_t slot = (size_t)u.blk * 256 + ai * 128 + g.wr * 64 + m * 16 + g.fr;
                unsigned char* up = U + slot * DE + u.pn * 128 + g.wc * 32 + 8 * g.fq;
                u32x2 w;
#pragma unroll
                for (int n = 0; n < 2; ++n) {
                    const f32x4 gv = acc[ai][0][m][n] * 0.015625f, uv = acc[ai][1][m][n] * 0.25f;
                    const unsigned q = cvt_pk4_fp8(siluf_(gv.x) * uv.x, siluf_(gv.y) * uv.y, siluf_(gv.z) * uv.z, siluf_(gv.w) * uv.w);
                    if (n == 0) w.x = q; else w.y = q;
                }
                *(u32x2*)up = w;
            }
    } };
__device__ __forceinline__ void phase_moeup(Frame& F, int layer) {
    const GeoT g = make_geo(F.tid);
    SchedMoe S; S.nblk = moe_segments(F, layer);
    S.A = (const char*)F.out + OUT_XH8; S.a_blk_bytes = 0u; S.B = (const char*)(F.ws + WS_WGU) + (size_t)layer * 16 * 1024 * 1024; S.b_exp_bytes = 1024u * 1024u; S.b_pn_bytes = 256u * 1024u;
    S.G = F.G; S.c = blockIdx.x; S.seg = (const LAS int*)(F.lds + LDS_MISC + 256); S.blk2e = (const LAS unsigned char*)(F.lds + LDS_MISC + 512);
    S.ecnt = (const unsigned*)(F.ws + WS_CTL) + CW_ECNT + 64 * layer; S.toklist = (const unsigned*)(F.ws + WS_TOKLIST); S.R0 = g.R[0]; S.R1 = g.R[1]; S.C0 = g.C[0]; S.C1 = g.C[1];
    EpiMoeUp E; E.U = F.ws + WS_U;
    unsigned voffA[2] = {0u, 0u}, voffB[2];
#pragma unroll
    for (int i = 0; i < 2; ++i) voffB[i] = (unsigned)g.R[i] * 1024u + (unsigned)g.C[i] * 2u;
    gemm_stream<true, true>(F.lds, S, E, 8, voffA, 0u, voffB, 128u * 1024u, g);
}
struct EpiMoeDown { unsigned char* DN;
    __device__ __forceinline__ void operator()(const f32x4 (&acc)[2][2][4][2], const SchedMoe::Unit& u, const GeoT& g_) const {
        GeoT g = g_; asm volatile("" : "+v"(g.fr), "+v"(g.fq));
#pragma unroll
        for (int ai = 0; ai < 2; ++ai)
#pragma unroll
            for (int m = 0; m < 4; ++m) {
                const size_t slot = (size_t)u.blk * 256 + ai * 128 + g.wr * 64 + m * 16 + g.fr;
                unsigned char* dp = DN + slot * D + u.pn * 256 + g.wc * 32 + 8 * g.fq;
#pragma unroll
                for (int bj = 0; bj < 2; ++bj) { u32x2 w;
#pragma unroll
                    for (int n = 0; n < 2; ++n) { const f32x4 v = acc[ai][bj][m][n] * (1.0f / 64.0f); const unsigned q = cvt_pk4_fp8(v.x, v.y, v.z, v.w); if (n == 0) w.x = q; else w.y = q; }
                    *(u32x2*)(dp + bj * 128) = w; }
            }
    } };
__device__ __forceinline__ void phase_moedown(Frame& F, int layer) {
    const GeoT g = make_geo(F.tid);
    SchedMoe S; S.nblk = moe_segments(F, layer);
    S.A = (const char*)(F.ws + WS_U); S.a_blk_bytes = 256u * 512u; S.B = (const char*)(F.ws + WS_WD) + (size_t)layer * 16 * 1024 * 512; S.b_exp_bytes = 1024u * 512u; S.b_pn_bytes = 256u * 512u;
    S.G = F.G; S.c = blockIdx.x; S.seg = (const LAS int*)(F.lds + LDS_MISC + 256); S.blk2e = (const LAS unsigned char*)(F.lds + LDS_MISC + 512);
    S.ecnt = (const unsigned*)(F.ws + WS_CTL) + CW_ECNT + 64 * layer; S.toklist = (const unsigned*)(F.ws + WS_TOKLIST); S.R0 = g.R[0]; S.R1 = g.R[1]; S.C0 = g.C[0]; S.C1 = g.C[1];
    EpiMoeDown E; E.DN = F.ws + WS_DN;
    unsigned voff[2];
#pragma unroll
    for (int i = 0; i < 2; ++i) voff[i] = (unsigned)g.R[i] * 512u + (unsigned)g.C[i] * 2u;
    gemm_stream<false, true>(F.lds, S, E, 4, voff, 128u * 512u, voff, 128u * 512u, g);
}
__device__ __forceinline__ void phase_combine(Frame& F, int layer) {
    const LAS int* seg = (const LAS int*)(F.lds + LDS_MISC + 256);
    (void)moe_segments(F, layer);
    const int nrows = (layer == 0) ? T : TLAT;
    const int gw = blockIdx.x * 8 + F.wave, NGW = F.G * 8;
    const unsigned* tokslot = (const unsigned*)(F.ws + WS_TOKSLOT);
    const float* tokw = (const float*)(F.ws + WS_TOKW);
    const unsigned char* DN = F.ws + WS_DN;
    const int RPW = nrows / NGW;
    int row = gw * RPW; const int row_end = row + RPW;
    u32x2 sl_n = (u32x2){0u, 0u}; f32x2 w_n = (f32x2){0.f, 0.f};
    if (row < row_end) { sl_n = *(const u32x2*)(tokslot + 2 * row); w_n = *(const f32x2*)(tokw + 2 * row); }
    f32x4 hg2[4], hmg[4], hsh[4]; int hb = -1;
    u32x2 xa[4]; unsigned da[4], db[4]; float w0c = 0.f, w1c = 0.f;
#define CB_ISSUE(r_, sl_) do { const size_t _s0 = (size_t)seg[(sl_).x >> 24] * 256 + ((sl_).x & 0xffffffu), _s1 = (size_t)seg[(sl_).y >> 24] * 256 + ((sl_).y & 0xffffffu); \
        const u32x2* _x = (const u32x2*)x1row_ptr(F, r_) + F.lane; const unsigned* _a = (const unsigned*)(DN + _s0 * D) + F.lane; const unsigned* _b = (const unsigned*)(DN + _s1 * D) + F.lane; \
        _Pragma("unroll") for (int j = 0; j < 4; ++j) { xa[j] = _x[64 * j]; da[j] = _a[64 * j]; db[j] = _b[64 * j]; } } while (0)
    if (row < row_end) { CB_ISSUE(row, sl_n); w0c = w_n.x; w1c = w_n.y; }
    if (row + 1 < row_end) { sl_n = *(const u32x2*)(tokslot + 2 * (row + 1)); w_n = *(const f32x2*)(tokw + 2 * (row + 1)); }
    for (; row < row_end; ++row) {
        f32x4 v[4], f[4];
        const float w0 = w0c * 0.0625f, w1 = w1c * 0.0625f;
#pragma unroll
        for (int j = 0; j < 4; ++j) {
            v[j] = (f32x4){bf_lo(xa[j].x), bf_hi(xa[j].x), bf_lo(xa[j].y), bf_hi(xa[j].y)};
            const f32x2 a01 = __builtin_amdgcn_cvt_pk_f32_fp8((int)da[j], false), a23 = __builtin_amdgcn_cvt_pk_f32_fp8((int)da[j], true);
            const f32x2 b01 = __builtin_amdgcn_cvt_pk_f32_fp8((int)db[j], false), b23 = __builtin_amdgcn_cvt_pk_f32_fp8((int)db[j], true);
            f[j].x = w0 * a01.x + w1 * b01.x; f[j].y = w0 * a01.y + w1 * b01.y; f[j].z = w0 * a23.x + w1 * b23.x; f[j].w = w0 * a23.y + w1 * b23.y;
        }
        const int rn = row + 1;
        if (rn < row_end) { CB_ISSUE(rn, sl_n); w0c = w_n.x; w1c = w_n.y; }
        if (rn + 1 < row_end) { sl_n = *(const u32x2*)(tokslot + 2 * (rn + 1)); w_n = *(const f32x2*)(tokw + 2 * (rn + 1)); }
        { const int bs = (row < TLAT) ? (row >> 11) : 32;
          if (bs != hb) { hb = bs;
              const float* gt2 = mod_ptr(F, layer, row) + 5120;
#pragma unroll
              for (int j = 0; j < 4; ++j) hg2[j] = ((const f32x4*)gt2)[F.lane + 64 * j];
              if (layer == 0) { const float* mp = mod_ptr(F, 1, row); const float* g1 = F.in[I_G1] + D;
#pragma unroll
                  for (int j = 0; j < 4; ++j) { hmg[j] = ((const f32x4*)g1)[F.lane + 64 * j] * (((const f32x4*)(mp + 1024))[F.lane + 64 * j] + 1.0f); hsh[j] = ((const f32x4*)mp)[F.lane + 64 * j]; }
              } else {
#pragma unroll
                  for (int j = 0; j < 4; ++j) hmg[j] = ((const f32x4*)F.in[I_GF])[F.lane + 64 * j];
              } } }
#pragma unroll
        for (int j = 0; j < 4; ++j) v[j] = v[j] + hg2[j] * f[j];
        const float rstd = row_rstd(v);
        if (layer == 0) {
            row_store_bf16(x2row_ptr(F, row), F.lane, v);
#pragma unroll
            for (int j = 0; j < 4; ++j) v[j] = v[j] * rstd * hmg[j] + hsh[j];
            row_store_fp8((unsigned char*)F.out + OUT_XH8 + (size_t)row * D, F.lane, v);
        } else {
#pragma unroll
            for (int j = 0; j < 4; ++j) ((f32x4*)(F.out + (size_t)row * D))[F.lane + 64 * j] = v[j] * rstd * hmg[j];
        }
    }
#undef CB_ISSUE
}

__device__ __forceinline__ const __attribute__((address_space(4))) unsigned char* opaque_ka() {
    unsigned long long w = (unsigned long long)__builtin_amdgcn_kernarg_segment_ptr(); unsigned lo = (unsigned)w, hi = (unsigned)(w >> 32);
    asm volatile("" : "+v"(lo), "+v"(hi));
    lo = __builtin_amdgcn_readfirstlane(lo); hi = __builtin_amdgcn_readfirstlane(hi);
    return (const __attribute__((address_space(4))) unsigned char*)(((unsigned long long)hi << 32) | lo);
}
__device__ __forceinline__ const void* opaque_ptr(const void* p) {
    unsigned long long w = (unsigned long long)p; unsigned lo = (unsigned)w, hi = (unsigned)(w >> 32);
    asm volatile("" : "+v"(lo), "+v"(hi));
    lo = __builtin_amdgcn_readfirstlane(lo); hi = __builtin_amdgcn_readfirstlane(hi);
    return (const void*)(((unsigned long long)hi << 32) | lo);
}
constexpr int N_PHASES = 2 + 2 * 10;
__global__ void __launch_bounds__(512, 2) mk_fwd(Args args) {
    extern __shared__ __attribute__((aligned(16))) unsigned char lds_raw[];
    Frame F; F.lds = (LAS unsigned char*)lds_raw; F.tid = threadIdx.x; F.lane = F.tid & 63; F.wave = __builtin_amdgcn_readfirstlane(F.tid >> 6); F.G = gridDim.x;
    static_assert(offsetof(Args, out) == 184 && offsetof(Args, ws) == 192, "kernarg layout");
    F.in = (in_tab_t)nullptr; F.out = nullptr; F.ws = args.ws;
    const int lo = args.ph_lo, hi = args.ph_hi;
    volatile LAS unsigned* misc = (volatile LAS unsigned*)(F.lds + LDS_MISC);
    if (F.tid < 64) misc[F.tid] = 0u;
    __syncthreads();
    XcdBarrier bar; bar.bar = (unsigned*)(F.ws + WS_CTL) + CW_BAR; bar.x = 0; bar.st = misc;
    if (hi - lo > 1) bar = xcd_barrier_post((unsigned*)(F.ws + WS_CTL) + CW_BAR, misc, threadIdx.x == 0);
    const int wave_s = __builtin_amdgcn_readfirstlane((int)(threadIdx.x >> 6));
#define IN(k) (lo <= (k) && (k) < hi)
#define SEAM(k) do { if (IN(k) && IN((k) + 1)) { XcdBarrier _b = bar; _b.bar = (unsigned*)opaque_ptr(bar.bar); xcd_barrier(_b, TIDNOW() == 0); } } while (0)
#define TIDNOW() ((wave_s << 6) | lane_now())
#define FRESH() do { int _t = TIDNOW(); int _g = gridDim.x; unsigned _l = (unsigned)(uintptr_t)lds_raw; asm volatile("" : "+v"(_t), "+v"(_g), "+v"(_l)); \
        const __attribute__((address_space(4))) unsigned char* _ka = opaque_ka(); \
        F.in = (in_tab_t)_ka; F.out = *(float* const __attribute__((address_space(4)))*)(_ka + 184); F.ws = *(unsigned char* const __attribute__((address_space(4)))*)(_ka + 192); \
        F.G = __builtin_amdgcn_readfirstlane(_g); F.lds = (LAS unsigned char*)(uintptr_t)__builtin_amdgcn_readfirstlane(_l); \
        F.tid = _t; F.lane = _t & 63; F.wave = __builtin_amdgcn_readfirstlane(_t >> 6); } while (0)
#if MK_DIAG
#define STAMP(k) do { if (blockIdx.x == 0 && TIDNOW() == 0) ((unsigned long long*)(args.ws + WS_CTL + 524288))[k] = __builtin_amdgcn_s_memrealtime(); } while (0)
#else
#define STAMP(k) do { } while (0)
#endif
    STAMP(0);
    if (IN(0)) { FRESH(); phase_pro(F); if (MK_REP == 9) { FRESH(); phase_pro(F); } } SEAM(0); STAMP(1);
    if (IN(1)) { FRESH(); phase_norm1_l0(F); if (MK_REP == 10) { FRESH(); phase_norm1_l0(F); } } SEAM(1); STAMP(2);
#define LAYER_PHASES(LAYER) do { const int pb = 2 + 10 * (LAYER); \
        if (IN(pb + 0)) { FRESH(); phase_inproj(F, LAYER); if (MK_REP == 0) { FRESH(); phase_inproj(F, LAYER); } } SEAM(pb + 0); STAMP(pb + 1); \
        if (IN(pb + 1)) { FRESH(); phase_retkv(F, LAYER); if (MK_REP == 1) { FRESH(); phase_retkv(F, LAYER); } } SEAM(pb + 1); STAMP(pb + 2); \
        if (IN(pb + 3)) { FRESH(); phase_mixers(F, LAYER); if (MK_REP == 3) { FRESH(); phase_mixers(F, LAYER); } } SEAM(pb + 3); STAMP(pb + 4); \
        if (IN(pb + 4)) { FRESH(); phase_merge(F, LAYER); if (MK_REP == 4) { FRESH(); phase_merge(F, LAYER); } } SEAM(pb + 4); STAMP(pb + 5); \
        if (IN(pb + 5)) { FRESH(); phase_outproj(F, LAYER); if (MK_REP == 5 && LAYER == 0) { FRESH(); phase_outproj(F, LAYER); } } SEAM(pb + 5); STAMP(pb + 6); \
        if (IN(pb + 6)) { FRESH(); phase_norm2route(F, LAYER); } SEAM(pb + 6); STAMP(pb + 7); \
        if (IN(pb + 7)) { FRESH(); phase_moeup(F, LAYER); if (MK_REP == 7) { FRESH(); phase_moeup(F, LAYER); } } SEAM(pb + 7); STAMP(pb + 8); \
        if (IN(pb + 8)) { FRESH(); phase_moedown(F, LAYER); if (MK_REP == 8) { FRESH(); phase_moedown(F, LAYER); } } SEAM(pb + 8); STAMP(pb + 9); \
        if (IN(pb + 9)) { FRESH(); phase_combine(F, LAYER); } SEAM(pb + 9); STAMP(pb + 10); \
    } while (0)
    LAYER_PHASES(0);
    LAYER_PHASES(1);
#undef LAYER_PHASES
#undef IN
#undef SEAM
#if MK_DIAG
    if (blockIdx.x == 0 && threadIdx.x == 0) {
        asm volatile("s_waitcnt vmcnt(0)" ::: "memory");
        volatile unsigned long long* TS = (volatile unsigned long long*)(args.ws + WS_CTL + 524288);
        const float ms = (float)((TS[MK_DIAG_B0] - TS[MK_DIAG_A0]) + (TS[MK_DIAG_B1] - TS[MK_DIAG_A1])) * 1e-5f;
        args.out[0] = sqrtf(67108864.0f * ms);
    }
#endif
}

extern "C" void kernel_launch(void* const* d_in, const int* in_sizes, int n_in, void* d_out, int out_size, void* d_ws, size_t ws_size, hipStream_t stream) {
    static int grid = 0;
    if (grid == 0) {
        if (n_in != 23 || out_size != TLAT * D || ws_size < WS_END) { fprintf(stderr, "kernel_launch: unexpected shapes (n_in %d out %d ws %zu)\n", n_in, out_size, ws_size); grid = -1; return; }
        int dev = 0, cus = 0;
        if (hipGetDevice(&dev) != hipSuccess || hipDeviceGetAttribute(&cus, hipDeviceAttributeMultiprocessorCount, dev) != hipSuccess) { grid = -1; return; }
        if (hipFuncSetAttribute((const void*)mk_fwd, hipFuncAttributeMaxDynamicSharedMemorySize, LDS_BYTES) != hipSuccess) { fprintf(stderr, "kernel_launch: hipFuncSetAttribute failed\n"); grid = -1; return; }
        int per_cu = 0;
        if (hipOccupancyMaxActiveBlocksPerMultiprocessor(&per_cu, (const void*)mk_fwd, 512, LDS_BYTES) != hipSuccess || per_cu < 1) { fprintf(stderr, "kernel_launch: occupancy query says %d\n", per_cu); }
        (void)hipGetLastError();
        grid = cus;
    }
    if (grid < 0) return;
    (void)hipMemsetAsync((char*)d_ws + WS_CTL, 0, CTL_BYTES, stream);
    Args a{};
    for (int i = 0; i < 23; ++i) a.in[i] = (const float*)d_in[i];
    a.out = (float*)d_out; a.ws = (unsigned char*)d_ws;
#if MK_ONE_LAUNCH
    a.ph_lo = 0; a.ph_hi = N_PHASES;
    hipLaunchKernelGGL(mk_fwd, dim3(grid), dim3(512), LDS_BYTES, stream, a);
#else
    for (int p = 0; p < N_PHASES; ++p) { a.ph_lo = p; a.ph_hi = p + 1; hipLaunchKernelGGL(mk_fwd, dim3(grid), dim3(512), LDS_BYTES, stream, a); }
#endif
}
```
